# Optimizing an MI355X kernel written in HIP

```python
import jax, jax.numpy as jnp
from jax import lax
import numpy as np

D_MODEL = 1024
BATCH = 16
SEQ = 2048
DEPTH = 4

RWKV_HEADS = 8
RWKV_HEAD_DIM = 64
RWKV_DIM = RWKV_HEADS * RWKV_HEAD_DIM
DECAY_LORA = 64
ICLR_LORA = 64
GATE_LORA = 128
RWKV_GN_EPS = 64e-5
FOX_HEADS = 8
FOX_HEAD_DIM = 64
FOX_DIM = FOX_HEADS * FOX_HEAD_DIM
Q_BLOCK = 128
SSM_HEADS = 16
SSM_HEAD_DIM = 64
SSM_DIM = SSM_HEADS * SSM_HEAD_DIM
SSM_GROUPS = 2
SSM_STATE = 128
CONV_WIDTH = 4
SSD_CHUNK = 128
SSM_CONV_DIM = SSM_DIM + 2 * SSM_GROUPS * SSM_STATE
NORM_EPS = 1e-5
N_BRANCHES = 3
RWKV_COLS = 3 * RWKV_DIM + DECAY_LORA + ICLR_LORA + GATE_LORA
FOX_COLS = 3 * FOX_DIM + FOX_HEADS
SSM_COLS = SSM_DIM + SSM_CONV_DIM + SSM_HEADS
GATE_COLS = N_BRANCHES * D_MODEL
OFF_FOX = RWKV_COLS
OFF_SSM = OFF_FOX + FOX_COLS
OFF_GATE = OFF_SSM + SSM_COLS
IN_COLS = OFF_GATE + GATE_COLS
N_EXPERTS = 32
N_EXPERT_GROUPS = 4
EXPERTS_PER_GROUP = N_EXPERTS // N_EXPERT_GROUPS
TOP_K = 2
D_EXPERT = 512
DISPATCH_BLOCK = 128
DEEPNORM_ALPHA = (2 * DEPTH) ** 0.25
DEEPNORM_BETA = (8 * DEPTH) ** -0.25
LN_EPS = 1e-5

kernel_name = "hybrid_rwkv7_fox_mamba2_groupmoe_deepnorm"


def layer_norm(x, g, b):
    xf = x.astype(jnp.float32)
    mu = jnp.mean(xf, axis=-1, keepdims=True)
    var = jnp.mean(jnp.square(xf - mu), axis=-1, keepdims=True)
    y = (xf - mu) * lax.rsqrt(var + LN_EPS) * g.astype(jnp.float32) + b.astype(jnp.float32)
    return y.astype(x.dtype)


def token_shift(p):
    return jnp.pad(p[:, :-1], ((0, 0), (1, 0), (0, 0)))


def rwkv7_recurrence(r, w, k, v, a, b):
    Bsz, S, H, N = r.shape

    def step(state, inp):
        r_t, w_t, k_t, v_t, a_t, b_t = inp
        sa = jnp.einsum('bhij,bhj->bhi', state, a_t)
        state = (state * w_t[:, :, None, :] + sa[..., None] * b_t[:, :, None, :]
                 + v_t[..., None] * k_t[:, :, None, :])
        return state, jnp.einsum('bhij,bhj->bhi', state, r_t)

    xs = tuple(t.transpose(1, 0, 2, 3) for t in (r, w, k, v, a, b))
    _, y = lax.scan(step, jnp.zeros((Bsz, H, N, N), jnp.float32), xs)
    return y.transpose(1, 0, 2, 3)


def rwkv7_mixer(p, mu, w0, w_up, a0, a_up, g_up, k_k, k_a, r_k, gn_g, gn_b):
    Bsz, S, _ = p.shape
    f32 = jnp.float32
    p = p + mu * (token_shift(p) - p)
    R = RWKV_DIM
    r, k, v, wd, ad, gd = jnp.split(p, [R, 2 * R, 3 * R, 3 * R + DECAY_LORA,
                                        3 * R + DECAY_LORA + ICLR_LORA], axis=-1)
    w_raw = -jax.nn.softplus(-(w0 + jnp.tanh(wd) @ w_up)) - 0.5
    decay = jnp.exp(-jnp.exp(w_raw.astype(f32)))
    a = jax.nn.sigmoid(a0 + ad @ a_up)
    g = jax.nn.sigmoid(gd) @ g_up
    hs = lambda t: t.astype(f32).reshape(Bsz, S, RWKV_HEADS, RWKV_HEAD_DIM)
    hv = lambda t: t.astype(f32).reshape(RWKV_HEADS, RWKV_HEAD_DIM)
    r, k, v, a, decay = hs(r), hs(k), hs(v), hs(a), hs(decay)
    kk = k * hv(k_k)
    kk = kk / jnp.maximum(jnp.sqrt(jnp.sum(kk * kk, axis=-1, keepdims=True)), 1e-12)
    k = k * (1.0 + (a - 1.0) * hv(k_a))
    y = rwkv7_recurrence(r, decay, k, v, -kk, kk * a)
    mean = jnp.mean(y, axis=-1, keepdims=True)
    var = jnp.mean(jnp.square(y - mean), axis=-1, keepdims=True)
    y = (y - mean) * lax.rsqrt(var + RWKV_GN_EPS)
    y = y * hv(gn_g) + hv(gn_b)
    y = y + jnp.sum(r * k * hv(r_k), axis=-1, keepdims=True) * v
    y = y.reshape(Bsz, S, RWKV_DIM) * g.astype(f32)
    return y.astype(p.dtype)


def fox_mixer(p, f_bias):
    Bsz, S, _ = p.shape
    f32 = jnp.float32
    q, k, v, f = jnp.split(p, [FOX_DIM, 2 * FOX_DIM, 3 * FOX_DIM], axis=-1)
    hs = lambda t: t.astype(f32).reshape(Bsz, S, FOX_HEADS, FOX_HEAD_DIM)
    q, k, v = hs(q), hs(k), hs(v)
    log_f = jax.nn.log_sigmoid(f.astype(f32) + f_bias.astype(f32))
    c = jnp.cumsum(log_f, axis=1)
    c_key = c.transpose(0, 2, 1)
    nb = S // Q_BLOCK
    qb = q.reshape(Bsz, nb, Q_BLOCK, FOX_HEADS, FOX_HEAD_DIM).transpose(1, 0, 2, 3, 4)
    cb = c.reshape(Bsz, nb, Q_BLOCK, FOX_HEADS).transpose(1, 0, 3, 2)
    kpos = jnp.arange(S)
    scale = FOX_HEAD_DIM ** -0.5

    def block(args):
        qi, ci, i = args
        s = jnp.einsum('bqhe,bkhe->bhqk', qi, k) * scale
        s = s + ci[..., None] - c_key[:, :, None, :]
        qpos = i * Q_BLOCK + jnp.arange(Q_BLOCK)
        s = jnp.where(kpos[None, :] <= qpos[:, None], s, -jnp.inf)
        return jnp.einsum('bhqk,bkhe->bqhe', jax.nn.softmax(s, axis=-1), v)

    o = lax.map(block, (qb, cb, jnp.arange(nb)))
    return o.transpose(1, 0, 2, 3, 4).reshape(Bsz, S, FOX_DIM).astype(p.dtype)


def causal_depthwise_conv(u, w, b):
    out = lax.conv_general_dilated(u, w[:, None, :], window_strides=(1,),
                                   padding=[(CONV_WIDTH - 1, 0)],
                                   dimension_numbers=('NWC', 'WIO', 'NWC'),
                                   feature_group_count=u.shape[-1])
    return out + b


def segsum(a):
    T = a.shape[-1]
    cs = jnp.cumsum(a, axis=-1)
    diff = cs[..., :, None] - cs[..., None, :]
    return jnp.where(jnp.tril(jnp.ones((T, T), bool)), diff, -jnp.inf)


def ssd(x, dt, A, Bm, Cm):
    Bsz, S, H, P = x.shape
    G, N = Bm.shape[2], Bm.shape[3]
    E = H // G
    L = SSD_CHUNK
    nc = S // L
    X = (x * dt[..., None]).reshape(Bsz, nc, L, G, E, P)
    dA = (dt * A).reshape(Bsz, nc, L, G, E).transpose(0, 3, 4, 1, 2)
    Bc = Bm.reshape(Bsz, nc, L, G, N)
    Cc = Cm.reshape(Bsz, nc, L, G, N)
    A_cs = jnp.cumsum(dA, axis=-1)
    Lmat = jnp.exp(segsum(dA))
    CB = jnp.einsum('bclgn,bcsgn->bcgls', Cc, Bc)
    y_diag = jnp.einsum('bcgls,bgecls,bcsgep->bclgep', CB, Lmat, X)
    decay_states = jnp.exp(A_cs[..., -1:] - A_cs)
    states = jnp.einsum('bclgn,bgecl,bclgep->bcgepn', Bc, decay_states, X)
    states = jnp.concatenate([jnp.zeros_like(states[:, :1]), states], axis=1)
    chunk_decay = jnp.exp(segsum(jnp.pad(A_cs[..., -1], ((0, 0), (0, 0), (0, 0), (1, 0)))))
    states = jnp.einsum('bgezc,bcgepn->bzgepn', chunk_decay, states)[:, :-1]
    y_off = jnp.einsum('bclgn,bcgepn,bgecl->bclgep', Cc, states, jnp.exp(A_cs))
    return (y_diag + y_off).reshape(Bsz, S, H, P)


def mamba2_mixer(p, conv_w, conv_b, dt_bias, a_log, d_skip, norm_g):
    Bsz, S, _ = p.shape
    f32 = jnp.float32
    z, xbc, dt = jnp.split(p, [SSM_DIM, SSM_DIM + SSM_CONV_DIM], axis=-1)
    xbc = jax.nn.silu(causal_depthwise_conv(xbc, conv_w, conv_b)).astype(f32)
    xs, Bm, Cm = jnp.split(xbc, [SSM_DIM, SSM_DIM + SSM_GROUPS * SSM_STATE], axis=-1)
    xs = xs.reshape(Bsz, S, SSM_HEADS, SSM_HEAD_DIM)
    Bm = Bm.reshape(Bsz, S, SSM_GROUPS, SSM_STATE)
    Cm = Cm.reshape(Bsz, S, SSM_GROUPS, SSM_STATE)
    dt = jax.nn.softplus(dt.astype(f32) + dt_bias.astype(f32))
    A = -jnp.exp(a_log.astype(f32))
    y = ssd(xs, dt, A, Bm, Cm) + d_skip.astype(f32)[:, None] * xs
    y = y.reshape(Bsz, S, SSM_DIM) * jax.nn.silu(z.astype(f32))
    y = y.reshape(Bsz, S, SSM_GROUPS, SSM_DIM // SSM_GROUPS)
    y = y * lax.rsqrt(jnp.mean(y * y, axis=-1, keepdims=True) + NORM_EPS)
    y = y.reshape(Bsz, S, SSM_DIM) * norm_g.astype(f32)
    return y.astype(p.dtype)


def hybrid_mixer(x, w_in, rwkv_mu, rwkv_w0, rwkv_w_up, rwkv_a0, rwkv_a_up, rwkv_g_up,
                 rwkv_k_k, rwkv_k_a, rwkv_r_k, rwkv_gn_g, rwkv_gn_b, fox_f_bias,
                 ssm_conv_w, ssm_conv_b, ssm_dt_bias, ssm_a_log, ssm_d, ssm_norm_g,
                 gate_bias, w_br_rwkv, w_br_fox, w_br_ssm, w_out):
    Bsz, S, D = x.shape
    proj = x @ w_in
    p_rwkv = proj[..., :OFF_FOX]
    p_fox = proj[..., OFF_FOX:OFF_SSM]
    p_ssm = proj[..., OFF_SSM:OFF_GATE]
    p_gate = proj[..., OFF_GATE:].reshape(Bsz, S, N_BRANCHES, D)
    o_r = rwkv7_mixer(p_rwkv, rwkv_mu, rwkv_w0, rwkv_w_up, rwkv_a0, rwkv_a_up, rwkv_g_up,
                      rwkv_k_k, rwkv_k_a, rwkv_r_k, rwkv_gn_g, rwkv_gn_b)
    o_f = fox_mixer(p_fox, fox_f_bias)
    o_m = mamba2_mixer(p_ssm, ssm_conv_w, ssm_conv_b, ssm_dt_bias, ssm_a_log, ssm_d, ssm_norm_g)
    gates = jax.nn.sigmoid(p_gate + gate_bias)
    merged = (gates[:, :, 0] * (o_r @ w_br_rwkv) + gates[:, :, 1] * (o_f @ w_br_fox)
              + gates[:, :, 2] * (o_m @ w_br_ssm))
    return merged @ w_out


def moe_ffn(x, router_w, router_bias, w_gate, w_up, w_down):
    Bsz, S, D = x.shape
    N = Bsz * S
    x2 = x.reshape(N, D)
    f32 = jnp.float32
    aff = jax.nn.sigmoid(x2.astype(f32) @ router_w.astype(f32))
    sel = aff + router_bias.astype(f32)
    grp_score = lax.top_k(sel.reshape(N, N_EXPERT_GROUPS, EXPERTS_PER_GROUP), TOP_K)[0].sum(-1)
    top_grp = jnp.argmax(grp_score, axis=-1)
    in_grp = (jnp.arange(N_EXPERTS) // EXPERTS_PER_GROUP)[None, :] == top_grp[:, None]
    _, idx = lax.top_k(jnp.where(in_grp, sel, -jnp.inf), TOP_K)
    w_sel = jnp.take_along_axis(aff, idx, axis=-1)
    gate = w_sel / jnp.sum(w_sel, axis=-1, keepdims=True)
    M = N * TOP_K
    BLK = DISPATCH_BLOCK
    flat_e = idx.reshape(M)
    flat_tok = jnp.broadcast_to(jnp.arange(N, dtype=jnp.int32)[:, None], (N, TOP_K)).reshape(M)
    flat_gate = gate.reshape(M)
    order = jnp.argsort(flat_e)
    e_sorted, tok_sorted, gate_sorted = flat_e[order], flat_tok[order], flat_gate[order]
    counts = jnp.bincount(flat_e, length=N_EXPERTS)
    padded = (counts + BLK - 1) // BLK * BLK
    pad_end = jnp.cumsum(padded)
    pad_start = pad_end - padded
    start = jnp.cumsum(counts) - counts
    dest = pad_start[e_sorted] + jnp.arange(M) - start[e_sorted]
    n_blocks = -(-M // BLK) + N_EXPERTS
    buf_tok = jnp.zeros((n_blocks * BLK,), jnp.int32).at[dest].set(tok_sorted)
    block_expert = jnp.minimum(jnp.searchsorted(pad_end, jnp.arange(n_blocks) * BLK, side='right'),
                               N_EXPERTS - 1)
    xb = x2[buf_tok].reshape(n_blocks, BLK, D)

    def expert_block(args):
        xblk, e = args
        h = jax.nn.silu(xblk @ w_gate[e]) * (xblk @ w_up[e])
        return h @ w_down[e]

    yb = lax.map(expert_block, (xb, block_expert)).reshape(n_blocks * BLK, D)
    y = jnp.zeros((N, D), x.dtype).at[tok_sorted].add(yb[dest] * gate_sorted[:, None].astype(x.dtype))
    return y.reshape(Bsz, S, D)


def setup_inputs(seed: int = 0) -> dict:
    key = jax.random.key(seed)
    keys = list(jax.random.split(key, 48))
    cnt = [0]
    f32 = jnp.float32

    def nk():
        cnt[0] += 1
        return keys[cnt[0] - 1]

    def normal(shape, scale):
        return jax.random.normal(nk(), shape, f32) * scale

    def uniform(shape, lo, hi):
        return jax.random.uniform(nk(), shape, f32, lo, hi)

    L, D = DEPTH, D_MODEL
    x = normal((BATCH, SEQ, D), 1.0)
    w_in = normal((L, D, IN_COLS), D ** -0.5)
    rwkv_mu = uniform((L, RWKV_COLS), 0.0, 1.0)
    rwkv_w0 = uniform((L, RWKV_DIM), -6.5, -1.5)
    rwkv_w_up = normal((L, DECAY_LORA, RWKV_DIM), 0.1 * DECAY_LORA ** -0.5)
    rwkv_a0 = normal((L, RWKV_DIM), 0.1)
    rwkv_a_up = normal((L, ICLR_LORA, RWKV_DIM), ICLR_LORA ** -0.5)
    rwkv_g_up = normal((L, GATE_LORA, RWKV_DIM), GATE_LORA ** -0.5)
    rwkv_k_k = 0.85 + normal((L, RWKV_DIM), 0.05)
    rwkv_k_a = 1.0 + normal((L, RWKV_DIM), 0.05)
    rwkv_r_k = normal((L, RWKV_DIM), 0.1)
    rwkv_gn_g = 1.0 + normal((L, RWKV_DIM), 0.05)
    rwkv_gn_b = normal((L, RWKV_DIM), 0.02)
    fox_f_bias = uniform((L, FOX_HEADS), 1.0, 4.0)
    ssm_conv_w = normal((L, CONV_WIDTH, SSM_CONV_DIM), CONV_WIDTH ** -0.5)
    ssm_conv_b = normal((L, SSM_CONV_DIM), 0.02)
    dt0 = jnp.exp(uniform((L, SSM_HEADS), float(np.log(1e-3)), float(np.log(1e-1))))
    ssm_dt_bias = dt0 + jnp.log(-jnp.expm1(-dt0))
    ssm_a_log = jnp.log(uniform((L, SSM_HEADS), 1.0, 16.0))
    ssm_d = 1.0 + normal((L, SSM_HEADS), 0.1)
    ssm_norm_g = 1.0 + normal((L, SSM_DIM), 0.05)
    gate_bias = normal((L, N_BRANCHES, D), 0.02)
    w_br_rwkv = normal((L, RWKV_DIM, D), RWKV_DIM ** -0.5)
    w_br_fox = normal((L, FOX_DIM, D), FOX_DIM ** -0.5)
    w_br_ssm = normal((L, SSM_DIM, D), SSM_DIM ** -0.5)
    w_out = normal((L, D, D), DEEPNORM_BETA * D ** -0.5)
    ln1_g = 1.0 + normal((L, D), 0.05)
    ln1_b = normal((L, D), 0.02)
    router_w = normal((D, N_EXPERTS), D ** -0.5)
    router_bias = normal((N_EXPERTS,), 0.01)
    exp_w_gate = normal((L, N_EXPERTS, D, D_EXPERT), D ** -0.5)
    exp_w_up = normal((L, N_EXPERTS, D, D_EXPERT), D ** -0.5)
    exp_w_down = normal((L, N_EXPERTS, D_EXPERT, D), DEEPNORM_BETA * D_EXPERT ** -0.5)
    ln2_g = 1.0 + normal((L, D), 0.05)
    ln2_b = normal((L, D), 0.02)
    return {"x": x, "w_in": w_in, "rwkv_mu": rwkv_mu, "rwkv_w0": rwkv_w0,
            "rwkv_w_up": rwkv_w_up, "rwkv_a0": rwkv_a0, "rwkv_a_up": rwkv_a_up,
            "rwkv_g_up": rwkv_g_up, "rwkv_k_k": rwkv_k_k, "rwkv_k_a": rwkv_k_a,
            "rwkv_r_k": rwkv_r_k, "rwkv_gn_g": rwkv_gn_g, "rwkv_gn_b": rwkv_gn_b,
            "fox_f_bias": fox_f_bias, "ssm_conv_w": ssm_conv_w, "ssm_conv_b": ssm_conv_b,
            "ssm_dt_bias": ssm_dt_bias, "ssm_a_log": ssm_a_log, "ssm_d": ssm_d,
            "ssm_norm_g": ssm_norm_g, "gate_bias": gate_bias, "w_br_rwkv": w_br_rwkv,
            "w_br_fox": w_br_fox, "w_br_ssm": w_br_ssm, "w_out": w_out,
            "ln1_g": ln1_g, "ln1_b": ln1_b, "router_w": router_w, "router_bias": router_bias,
            "exp_w_gate": exp_w_gate, "exp_w_up": exp_w_up, "exp_w_down": exp_w_down,
            "ln2_g": ln2_g, "ln2_b": ln2_b}


def reference(x, w_in, rwkv_mu, rwkv_w0, rwkv_w_up, rwkv_a0, rwkv_a_up, rwkv_g_up,
              rwkv_k_k, rwkv_k_a, rwkv_r_k, rwkv_gn_g, rwkv_gn_b, fox_f_bias,
              ssm_conv_w, ssm_conv_b, ssm_dt_bias, ssm_a_log, ssm_d, ssm_norm_g,
              gate_bias, w_br_rwkv, w_br_fox, w_br_ssm, w_out, ln1_g, ln1_b,
              router_w, router_bias, exp_w_gate, exp_w_up, exp_w_down, ln2_g, ln2_b):
    for l in range(DEPTH):
        mix = hybrid_mixer(x, w_in[l], rwkv_mu[l], rwkv_w0[l], rwkv_w_up[l], rwkv_a0[l],
                           rwkv_a_up[l], rwkv_g_up[l], rwkv_k_k[l], rwkv_k_a[l], rwkv_r_k[l],
                           rwkv_gn_g[l], rwkv_gn_b[l], fox_f_bias[l], ssm_conv_w[l],
                           ssm_conv_b[l], ssm_dt_bias[l], ssm_a_log[l], ssm_d[l],
                           ssm_norm_g[l], gate_bias[l], w_br_rwkv[l], w_br_fox[l],
                           w_br_ssm[l], w_out[l])
        x = layer_norm(DEEPNORM_ALPHA * x + mix, ln1_g[l], ln1_b[l])
        ffn = moe_ffn(x, router_w, router_bias, exp_w_gate[l], exp_w_up[l], exp_w_down[l])
        x = layer_norm(DEEPNORM_ALPHA * x + ffn, ln2_g[l], ln2_b[l])
    return x
```

```cpp
#include <hip/hip_runtime.h>
#include <cstdio>
#include <cstdint>

constexpr int D = 1024, BATCH = 16, SEQ = 2048, DEPTH = 4, NTOK = BATCH * SEQ;
constexpr int RWKV_DIM = 512, DECAY_LORA = 64, ICLR_LORA = 64, GATE_LORA = 128;
constexpr int FOX_DIM = 512, FOX_HEADS = 8;
constexpr int SSM_DIM = 1024, SSM_HEADS = 16, SSM_STATE = 128, SSM_CONV_DIM = 1536;
constexpr int RWKV_COLS = 1792, FOX_COLS = 1544, SSM_COLS = 2576, GATE_COLS = 3072;
constexpr int OFF_FOX = RWKV_COLS, OFF_SSM = OFF_FOX + FOX_COLS, OFF_GATE = OFF_SSM + SSM_COLS, IN_COLS = OFF_GATE + GATE_COLS;
constexpr int NEXP = 32, DEXP = 512;
constexpr float ALPHA = 1.681792830507429f;
constexpr float LN_EPS = 1e-5f, NORM_EPS = 1e-5f, RWKV_GN_EPS = 64e-5f;
static_assert(IN_COLS == 8984, "cols");

constexpr int GB = 4;
constexpr int GT = GB * SEQ;
constexpr int NGROUP = BATCH / GB;

typedef float f32x4 __attribute__((ext_vector_type(4)));
typedef float f32x16 __attribute__((ext_vector_type(16)));

__device__ __forceinline__ float sigmoidf_(float x) { return 1.f / (1.f + __expf(-x)); }
__device__ __forceinline__ float softplusf_(float x) { return x > 0.f ? x + log1pf(expf(-x)) : log1pf(expf(x)); }
__device__ __forceinline__ float siluf_(float x) { return x / (1.f + expf(-x)); }
__device__ __forceinline__ float wave_sum(float v) {
#pragma unroll
    for (int o = 1; o < 64; o <<= 1) v += __shfl_xor(v, o);
    return v;
}

struct GemmP {
    const float* A; long lda; const float* B; long ldb; int M, N, K;
    const int* list; const int* cnt; int ashift; long strideB; int list_stride;
    int mode; float* C; long ldc; const float* aux; long ldaux; const float* aux2; float alpha;
};
__global__ __launch_bounds__(256) void gemm_f32(GemmP p) {
    __shared__ float As[128][17];
    __shared__ __attribute__((aligned(16))) float Bs[16][132];
    const int e = blockIdx.z;
    int M = p.M; const int* list = nullptr;
    if (p.list) { M = p.cnt[e]; list = p.list + (long)e * p.list_stride; }
    const int m0 = blockIdx.y * 128; if (m0 >= M) return;
    const int n0 = blockIdx.x * 128;
    const float* B = p.B + (long)e * p.strideB;
    const int tid = threadIdx.x, lane = tid & 63, wave = tid >> 6;
    const int wm = (wave >> 1) * 64, wn = (wave & 1) * 64;
    long arow[2];
#pragma unroll
    for (int i = 0; i < 2; ++i) { const int m = m0 + (tid >> 2) + 64 * i; arow[i] = (m < M) ? (list ? (long)(list[m] >> p.ashift) : (long)m) : -1; }
    const int ac = (tid & 3) * 4;
    f32x16 acc[2][2];
#pragma unroll
    for (int i = 0; i < 2; ++i)
#pragma unroll
        for (int j = 0; j < 2; ++j)
#pragma unroll
            for (int r = 0; r < 16; ++r) acc[i][j][r] = 0.f;
    for (int k0 = 0; k0 < p.K; k0 += 16) {
#pragma unroll
        for (int i = 0; i < 2; ++i) {
            f32x4 v = (f32x4){0.f, 0.f, 0.f, 0.f};
            if (arow[i] >= 0) v = *(const f32x4*)(p.A + arow[i] * p.lda + k0 + ac);
            const int r = (tid >> 2) + 64 * i;
            As[r][ac] = v.x; As[r][ac + 1] = v.y; As[r][ac + 2] = v.z; As[r][ac + 3] = v.w;
        }
#pragma unroll
        for (int i = 0; i < 2; ++i) {
            const int kk = (tid >> 5) + 8 * i; const int n = n0 + (tid & 31) * 4;
            f32x4 v = (f32x4){0.f, 0.f, 0.f, 0.f};
            if (n < p.N) v = *(const f32x4*)(B + (long)(k0 + kk) * p.ldb + n);
            *(f32x4*)&Bs[kk][(tid & 31) * 4] = v;
        }
        __syncthreads();
#pragma unroll
        for (int s = 0; s < 8; ++s) {
            const int kk = 2 * s + (lane >> 5);
            const float a0 = As[wm + (lane & 31)][kk], a1 = As[wm + 32 + (lane & 31)][kk];
            const float b0 = Bs[kk][wn + (lane & 31)], b1 = Bs[kk][wn + 32 + (lane & 31)];
            acc[0][0] = __builtin_amdgcn_mfma_f32_32x32x2f32(a0, b0, acc[0][0], 0, 0, 0);
            acc[0][1] = __builtin_amdgcn_mfma_f32_32x32x2f32(a0, b1, acc[0][1], 0, 0, 0);
            acc[1][0] = __builtin_amdgcn_mfma_f32_32x32x2f32(a1, b0, acc[1][0], 0, 0, 0);
            acc[1][1] = __builtin_amdgcn_mfma_f32_32x32x2f32(a1, b1, acc[1][1], 0, 0, 0);
        }
        __syncthreads();
    }
#pragma unroll
    for (int i = 0; i < 2; ++i)
#pragma unroll
        for (int r = 0; r < 16; ++r) {
            const int m = m0 + wm + 32 * i + (r & 3) + 8 * (r >> 2) + 4 * (lane >> 5);
            if (m >= M) continue;
            const long cr = list ? (long)list[m] : (long)m;
            const long axr = list ? (long)(list[m] >> p.ashift) : (long)m;
#pragma unroll
            for (int j = 0; j < 2; ++j) {
                const int n = n0 + wn + 32 * j + (lane & 31);
                if (n >= p.N) continue;
                const float a = acc[i][j][r];
                float* c = p.C + cr * p.ldc + n;
                if (p.mode == 0) *c = a;
                else if (p.mode == 1) { const float g = sigmoidf_(p.aux[axr * p.ldaux + n] + p.aux2[n]); const float old = (p.alpha != 0.f) ? *c : 0.f; *c = old + g * a; }
                else if (p.mode == 2) *c = p.alpha * p.aux[axr * p.ldaux + n] + a;
                else { const float hg = *c; *c = siluf_(hg) * a; }
            }
        }
}

struct RwkvP {
    const float* proj;
    const float *mu, *w0, *w_up, *a0, *a_up, *g_up, *k_k, *k_a, *r_k, *gn_g, *gn_b;
    float *r, *k, *v, *w, *an, *bn, *g;
    float* o_r;
};
__global__ __launch_bounds__(256) void rwkv_prep(RwkvP p) {
    __shared__ float P[8][RWKV_COLS];
    const int tid = threadIdx.x, lane = tid & 63;
    const int t0 = blockIdx.x * 8;
    for (int idx = tid; idx < 8 * RWKV_COLS; idx += 256) {
        const int tt = idx / RWKV_COLS, c = idx % RWKV_COLS; const int t = t0 + tt;
        const float cur = p.proj[(long)t * IN_COLS + c];
        const float prev = ((t % SEQ) == 0) ? 0.f : p.proj[(long)(t - 1) * IN_COLS + c];
        float x = cur + p.mu[c] * (prev - cur);
        if (c >= 1536 && c < 1600) x = tanhf(x);
        else if (c >= 1664) x = sigmoidf_(x);
        P[tt][c] = x;
    }
    __syncthreads();
    float aw[2][8], aa[2][8], ag[2][8];
#pragma unroll
    for (int q = 0; q < 2; ++q)
#pragma unroll
        for (int t = 0; t < 8; ++t) { aw[q][t] = 0.f; aa[q][t] = 0.f; ag[q][t] = 0.f; }
    for (int j = 0; j < 64; ++j) {
#pragma unroll
        for (int q = 0; q < 2; ++q) {
            const int c = tid + 256 * q;
            const float wu = p.w_up[j * 512 + c], au = p.a_up[j * 512 + c];
#pragma unroll
            for (int t = 0; t < 8; ++t) { aw[q][t] += P[t][1536 + j] * wu; aa[q][t] += P[t][1600 + j] * au; }
        }
    }
    for (int j = 0; j < 128; ++j) {
#pragma unroll
        for (int q = 0; q < 2; ++q) {
            const int c = tid + 256 * q;
            const float gu = p.g_up[j * 512 + c];
#pragma unroll
            for (int t = 0; t < 8; ++t) ag[q][t] += P[t][1664 + j] * gu;
        }
    }
#pragma unroll
    for (int q = 0; q < 2; ++q) {
        const int c = tid + 256 * q;
        const float w0 = p.w0[c], a0 = p.a0[c], kkw = p.k_k[c], kaw = p.k_a[c];
#pragma unroll
        for (int t = 0; t < 8; ++t) {
            const long o = (long)(t0 + t) * 512 + c;
            const float wraw = -softplusf_(-(w0 + aw[q][t])) - 0.5f;
            const float decay = expf(-expf(wraw));
            const float a = sigmoidf_(a0 + aa[q][t]);
            const float kx = P[t][512 + c];
            const float kk = kx * kkw;
            const float ss = wave_sum(kk * kk);
            const float kkn = kk / fmaxf(sqrtf(ss), 1e-12f);
            p.r[o] = P[t][c]; p.v[o] = P[t][1024 + c];
            p.k[o] = kx * (1.f + (a - 1.f) * kaw);
            p.w[o] = decay; p.an[o] = -kkn; p.bn[o] = kkn * a; p.g[o] = ag[q][t];
        }
    }
    (void)lane;
}
__global__ __launch_bounds__(512) void rwkv_scan(RwkvP p) {
    constexpr int T = 32;
    __shared__ __attribute__((aligned(16))) float Lr[T][64], Lw[T][64], Lk[T][64], Lv[T][64], La[T][64], Lb[T][64], Ly[T][64];
    const int tid = threadIdx.x, lane = tid & 63, wave = tid >> 6;
    const int bl = blockIdx.x >> 3, h = blockIdx.x & 7;
    const int i8 = lane >> 3, seg = lane & 7, row = wave * 8 + i8;
    float S[8];
#pragma unroll
    for (int j = 0; j < 8; ++j) S[j] = 0.f;
    const float rk = p.r_k[h * 64 + lane], gg = p.gn_g[h * 64 + lane], gb = p.gn_b[h * 64 + lane];
    for (int c0 = 0; c0 < SEQ; c0 += T) {
        for (int idx = tid; idx < T * 64; idx += 512) {
            const int t = idx >> 6, j = idx & 63; const long o = (long)(bl * SEQ + c0 + t) * 512 + h * 64 + j;
            Lr[t][j] = p.r[o]; Lw[t][j] = p.w[o]; Lk[t][j] = p.k[o]; Lv[t][j] = p.v[o]; La[t][j] = p.an[o]; Lb[t][j] = p.bn[o];
        }
        __syncthreads();
        for (int t = 0; t < T; ++t) {
            float w8[8], a8[8], b8[8], k8[8], r8[8];
#pragma unroll
            for (int j = 0; j < 8; ++j) { w8[j] = Lw[t][seg * 8 + j]; a8[j] = La[t][seg * 8 + j]; b8[j] = Lb[t][seg * 8 + j]; k8[j] = Lk[t][seg * 8 + j]; r8[j] = Lr[t][seg * 8 + j]; }
            const float vi = Lv[t][row];
            float sa = 0.f;
#pragma unroll
            for (int j = 0; j < 8; ++j) sa += S[j] * a8[j];
            sa += __shfl_xor(sa, 1); sa += __shfl_xor(sa, 2); sa += __shfl_xor(sa, 4);
            float y = 0.f;
#pragma unroll
            for (int j = 0; j < 8; ++j) { S[j] = S[j] * w8[j] + sa * b8[j] + vi * k8[j]; y += S[j] * r8[j]; }
            y += __shfl_xor(y, 1); y += __shfl_xor(y, 2); y += __shfl_xor(y, 4);
            if (seg == 0) Ly[t][row] = y;
        }
        __syncthreads();
        for (int q = 0; q < 4; ++q) {
            const int t = wave * 4 + q; const long tok = (long)(bl * SEQ + c0 + t);
            const float yv = Ly[t][lane];
            const float mean = wave_sum(yv) * (1.f / 64.f);
            const float d = yv - mean;
            const float var = wave_sum(d * d) * (1.f / 64.f);
            float yn = d * rsqrtf(var + RWKV_GN_EPS) * gg + gb;
            const float bonus = wave_sum(Lr[t][lane] * Lk[t][lane] * rk);
            yn += bonus * Lv[t][lane];
            p.o_r[tok * 512 + h * 64 + lane] = yn * p.g[tok * 512 + h * 64 + lane];
        }
        __syncthreads();
    }
}

__global__ __launch_bounds__(64) void fox_cumsum(const float* proj, const float* f_bias, float* ck) {
    const int bl = blockIdx.x >> 3, h = blockIdx.x & 7, lane = threadIdx.x;
    const float fb = f_bias[h];
    float carry = 0.f;
    for (int s0 = 0; s0 < SEQ; s0 += 64) {
        const long tok = (long)bl * SEQ + s0 + lane;
        float v = -softplusf_(-(proj[tok * IN_COLS + OFF_FOX + 1536 + h] + fb));
#pragma unroll
        for (int o = 1; o < 64; o <<= 1) { const float u = __shfl_up(v, o); if (lane >= o) v += u; }
        v += carry;
        ck[(long)(bl * 8 + h) * SEQ + s0 + lane] = v;
        carry = __shfl(v, 63);
    }
}
__global__ __launch_bounds__(64) void fox_attn(const float* proj, const float* ck, float* o_f) {
    __shared__ __attribute__((aligned(16))) float Ks[64][64], Vs[64][64];
    __shared__ float Cs[64];
    const int qb = blockIdx.x, h = blockIdx.y, bl = blockIdx.z, lane = threadIdx.x;
    const int qi = qb * 64 + lane;
    const long tokq = (long)bl * SEQ + qi;
    float q[64], acc[64];
#pragma unroll
    for (int d = 0; d < 64; d += 4) { const f32x4 v = *(const f32x4*)(proj + tokq * IN_COLS + OFF_FOX + h * 64 + d); q[d] = v.x * 0.125f; q[d + 1] = v.y * 0.125f; q[d + 2] = v.z * 0.125f; q[d + 3] = v.w * 0.125f; }
#pragma unroll
    for (int d = 0; d < 64; ++d) acc[d] = 0.f;
    const float cq = ck[(long)(bl * 8 + h) * SEQ + qi];
    float m = -INFINITY, l = 0.f;
    for (int kt = 0; kt <= qb; ++kt) {
        __syncthreads();
        for (int i = 0; i < 16; ++i) {
            const int idx = i * 64 + lane; const int r = idx >> 4, c4 = (idx & 15) * 4;
            const long tok = (long)bl * SEQ + kt * 64 + r;
            *(f32x4*)&Ks[r][c4] = *(const f32x4*)(proj + tok * IN_COLS + OFF_FOX + 512 + h * 64 + c4);
            *(f32x4*)&Vs[r][c4] = *(const f32x4*)(proj + tok * IN_COLS + OFF_FOX + 1024 + h * 64 + c4);
        }
        Cs[lane] = ck[(long)(bl * 8 + h) * SEQ + kt * 64 + lane];
        __syncthreads();
        for (int j0 = 0; j0 < 64; j0 += 16) {
            float s[16]; float tmax = -INFINITY;
#pragma unroll
            for (int j = 0; j < 16; ++j) {
                float a = 0.f;
#pragma unroll
                for (int d = 0; d < 64; ++d) a += q[d] * Ks[j0 + j][d];
                a += cq - Cs[j0 + j];
                if (kt * 64 + j0 + j > qi) a = -INFINITY;
                s[j] = a; tmax = fmaxf(tmax, a);
            }
            const float mn = fmaxf(m, tmax);
            if (mn == -INFINITY) continue;
            const float sc = expf(m - mn);
            l *= sc;
#pragma unroll
            for (int d = 0; d < 64; ++d) acc[d] *= sc;
#pragma unroll
            for (int j = 0; j < 16; ++j) {
                const float pj = expf(s[j] - mn);
                l += pj;
#pragma unroll
                for (int d = 0; d < 64; ++d) acc[d] += pj * Vs[j0 + j][d];
            }
            m = mn;
        }
    }
    const float il = 1.f / l;
#pragma unroll
    for (int d = 0; d < 64; d += 4) *(f32x4*)(o_f + tokq * 512 + h * 64 + d) = (f32x4){acc[d] * il, acc[d + 1] * il, acc[d + 2] * il, acc[d + 3] * il};
}

__global__ __launch_bounds__(256) void ssm_prep(const float* proj, const float* conv_w, const float* conv_b, const float* dt_bias, float* xbc, float* dt) {
    const long idx = (long)blockIdx.x * 256 + threadIdx.x;
    const int t = (int)(idx / SSM_CONV_DIM), c = (int)(idx % SSM_CONV_DIM);
    const int ts = t % SEQ;
    float a = conv_b[c];
#pragma unroll
    for (int w = 0; w < 4; ++w) { const int tt = ts - 3 + w; if (tt >= 0) a += conv_w[w * SSM_CONV_DIM + c] * proj[(long)(t - 3 + w) * IN_COLS + OFF_SSM + 1024 + c]; }
    xbc[idx] = siluf_(a);
    if (c < SSM_HEADS) dt[(long)t * SSM_HEADS + c] = softplusf_(proj[(long)t * IN_COLS + OFF_SSM + 1024 + 1536 + c] + dt_bias[c]);
}
__global__ __launch_bounds__(256) void ssm_scan(const float* xbc, const float* dt, const float* a_log, const float* d_skip, float* yraw) {
    constexpr int T = 32;
    __shared__ float LB[T][128], LC[T][128], LX[T][64], LD[T];
    const int tid = threadIdx.x, p = tid >> 2, nq = tid & 3;
    const int bl = blockIdx.x >> 4, h = blockIdx.x & 15, g = h >> 3;
    const float A = -expf(a_log[h]), Dh = d_skip[h];
    float st[32];
#pragma unroll
    for (int n = 0; n < 32; ++n) st[n] = 0.f;
    for (int c0 = 0; c0 < SEQ; c0 += T) {
        __syncthreads();
        for (int idx = tid; idx < T * 128; idx += 256) { const int t = idx >> 7, n = idx & 127; const long tok = (long)bl * SEQ + c0 + t;
            LB[t][n] = xbc[tok * SSM_CONV_DIM + 1024 + g * 128 + n]; LC[t][n] = xbc[tok * SSM_CONV_DIM + 1280 + g * 128 + n]; }
        for (int idx = tid; idx < T * 64; idx += 256) { const int t = idx >> 6, j = idx & 63; const long tok = (long)bl * SEQ + c0 + t; LX[t][j] = xbc[tok * SSM_CONV_DIM + h * 64 + j]; }
        if (tid < T) LD[tid] = dt[((long)bl * SEQ + c0 + tid) * SSM_HEADS + h];
        __syncthreads();
        for (int t = 0; t < T; ++t) {
            const float dtv = LD[t], dA = expf(dtv * A), x = LX[t][p], xdt = x * dtv;
            float y = 0.f;
#pragma unroll
            for (int n = 0; n < 32; ++n) { st[n] = st[n] * dA + xdt * LB[t][nq * 32 + n]; y += LC[t][nq * 32 + n] * st[n]; }
            y += __shfl_xor(y, 1); y += __shfl_xor(y, 2);
            if (nq == 0) yraw[((long)bl * SEQ + c0 + t) * SSM_DIM + h * 64 + p] = y + Dh * x;
        }
    }
}
__global__ __launch_bounds__(256) void ssm_finish(const float* proj, const float* yraw, const float* norm_g, float* o_m) {
    __shared__ float red[4];
    const int t = blockIdx.x, tid = threadIdx.x, wave = tid >> 6;
    const int c = tid * 4;
    const f32x4 y = *(const f32x4*)(yraw + (long)t * SSM_DIM + c);
    const f32x4 z = *(const f32x4*)(proj + (long)t * IN_COLS + OFF_SSM + c);
    f32x4 v; v.x = y.x * siluf_(z.x); v.y = y.y * siluf_(z.y); v.z = y.z * siluf_(z.z); v.w = y.w * siluf_(z.w);
    const float ss = wave_sum(v.x * v.x + v.y * v.y + v.z * v.z + v.w * v.w);
    if ((tid & 63) == 0) red[wave] = ss;
    __syncthreads();
    const float tot = (wave < 2) ? (red[0] + red[1]) : (red[2] + red[3]);
    const float rs = rsqrtf(tot * (1.f / 512.f) + NORM_EPS);
    const f32x4 g = *(const f32x4*)(norm_g + c);
    *(f32x4*)(o_m + (long)t * SSM_DIM + c) = (f32x4){v.x * rs * g.x, v.y * rs * g.y, v.z * rs * g.z, v.w * rs * g.w};
}

__global__ __launch_bounds__(256) void ln_router(float* xio, const float* ln_g, const float* ln_b, const float* rw, const float* rbias,
                                                 float* gate, int* cnt, int* list) {
    __shared__ __attribute__((aligned(16))) float X[4][D];
    const int tid = threadIdx.x, lane = tid & 63, wave = tid >> 6;
    const long tok = (long)blockIdx.x * 4 + wave;
    float* row = xio + tok * D;
    f32x4 v[4]; float s = 0.f;
#pragma unroll
    for (int j = 0; j < 4; ++j) { v[j] = *(const f32x4*)(row + 4 * lane + 256 * j); s += (v[j].x + v[j].y) + (v[j].z + v[j].w); }
    const float mean = wave_sum(s) * (1.f / D); float s2 = 0.f;
#pragma unroll
    for (int j = 0; j < 4; ++j) { v[j] = v[j] - mean; s2 += (v[j].x * v[j].x + v[j].y * v[j].y) + (v[j].z * v[j].z + v[j].w * v[j].w); }
    const float rstd = rsqrtf(wave_sum(s2) * (1.f / D) + LN_EPS);
#pragma unroll
    for (int j = 0; j < 4; ++j) {
        const f32x4 g = *(const f32x4*)(ln_g + 4 * lane + 256 * j), b = *(const f32x4*)(ln_b + 4 * lane + 256 * j);
        const f32x4 o = v[j] * rstd * g + b;
        *(f32x4*)(row + 4 * lane + 256 * j) = o;
        *(f32x4*)&X[wave][4 * lane + 256 * j] = o;
    }
    __syncthreads();
    const int e = lane & 31, half = lane >> 5;
    float a = 0.f;
    for (int c = half * 512; c < half * 512 + 512; ++c) a += X[wave][c] * rw[c * NEXP + e];
    a += __shfl_xor(a, 32);
    const float aff = sigmoidf_(a);
    const float sel = aff + rbias[e];
    float t1 = -INFINITY, t2 = -INFINITY; int i1 = -1, i2 = -1;
    const int gbase = lane & ~7;
#pragma unroll
    for (int k = 0; k < 8; ++k) {
        const float u = __shfl(sel, gbase + k); const int ui = (gbase + k) & 31;
        if (u > t1) { t2 = t1; i2 = i1; t1 = u; i1 = ui; } else if (u > t2) { t2 = u; i2 = ui; }
    }
    const float gs = t1 + t2;
    float best = -INFINITY; int bg = 0;
#pragma unroll
    for (int g = 0; g < 4; ++g) { const float u = __shfl(gs, g * 8); if (u > best) { best = u; bg = g; } }
    const int e0 = __shfl(i1, bg * 8), e1 = __shfl(i2, bg * 8);
    const float w0 = __shfl(aff, e0), w1 = __shfl(aff, e1);
    if (lane == 0) {
        const float inv = 1.f / (w0 + w1);
        gate[tok * 2] = w0 * inv; gate[tok * 2 + 1] = w1 * inv;
        const int s0 = atomicAdd(&cnt[e0], 1); list[(long)e0 * NTOK + s0] = (int)(tok * 2);
        const int s1 = atomicAdd(&cnt[e1], 1); list[(long)e1 * NTOK + s1] = (int)(tok * 2 + 1);
    }
}
__global__ __launch_bounds__(256) void ln2_kernel(const float* x1, const float* y, const float* gate, const float* ln_g, const float* ln_b, float* out) {
    const int tid = threadIdx.x, lane = tid & 63, wave = tid >> 6;
    const long tok = (long)blockIdx.x * 4 + wave;
    const float g0 = gate[tok * 2], g1 = gate[tok * 2 + 1];
    f32x4 v[4]; float s = 0.f;
#pragma unroll
    for (int j = 0; j < 4; ++j) {
        const int c = 4 * lane + 256 * j;
        const f32x4 a = *(const f32x4*)(x1 + tok * D + c), y0 = *(const f32x4*)(y + (tok * 2) * D + c), y1 = *(const f32x4*)(y + (tok * 2 + 1) * D + c);
        v[j] = a * ALPHA + (y0 * g0 + y1 * g1);
        s += (v[j].x + v[j].y) + (v[j].z + v[j].w);
    }
    const float mean = wave_sum(s) * (1.f / D); float s2 = 0.f;
#pragma unroll
    for (int j = 0; j < 4; ++j) { v[j] = v[j] - mean; s2 += (v[j].x * v[j].x + v[j].y * v[j].y) + (v[j].z * v[j].z + v[j].w * v[j].w); }
    const float rstd = rsqrtf(wave_sum(s2) * (1.f / D) + LN_EPS);
#pragma unroll
    for (int j = 0; j < 4; ++j) {
        const int c = 4 * lane + 256 * j;
        const f32x4 g = *(const f32x4*)(ln_g + c), b = *(const f32x4*)(ln_b + c);
        *(f32x4*)(out + tok * D + c) = v[j] * rstd * g + b;
    }
}

constexpr size_t MiB = 1u << 20;
constexpr size_t WS_PROJ = 0;
constexpr size_t WS_RW = 282 * MiB;
constexpr size_t WS_CK = 394 * MiB;
constexpr size_t WS_XBC = 395 * MiB;
constexpr size_t WS_DT = 443 * MiB;
constexpr size_t WS_YS = 444 * MiB;
constexpr size_t WS_OR = 476 * MiB, WS_OF = 492 * MiB, WS_OM = 508 * MiB;
constexpr size_t WS_MERGED = 540 * MiB;
constexpr size_t WS_X1 = 572 * MiB;
constexpr size_t WS_GATE = 700 * MiB;
constexpr size_t WS_CNT = 701 * MiB;
constexpr size_t WS_LIST = 702 * MiB;
constexpr size_t WS_END = 706 * MiB;
constexpr size_t WS_H = 0;
constexpr size_t WS_Y = 128 * MiB;
static_assert(WS_Y + 256 * MiB <= WS_CK, "alias");

extern "C" void kernel_launch(void* const* d_in, const int* in_sizes, int n_in, void* d_out, int out_size, void* d_ws, size_t ws_size, hipStream_t stream) {
    if (n_in != 34 || ws_size < WS_END) { fprintf(stderr, "kernel_launch: unexpected n_in %d or ws_size %zu\n", n_in, ws_size); return; }
    const float* const* in = (const float* const*)d_in;
    const float* x_in = in[0];
    char* ws = (char*)d_ws;
    float* out = (float*)d_out;
    float* proj = (float*)(ws + WS_PROJ);
    float* rwb = (float*)(ws + WS_RW);
    float* ck = (float*)(ws + WS_CK);
    float* xbc = (float*)(ws + WS_XBC);
    float* dtb = (float*)(ws + WS_DT);
    float* ys = (float*)(ws + WS_YS);
    float* o_r = (float*)(ws + WS_OR); float* o_f = (float*)(ws + WS_OF); float* o_m = (float*)(ws + WS_OM);
    float* merged = (float*)(ws + WS_MERGED);
    float* x1 = (float*)(ws + WS_X1);
    float* gate = (float*)(ws + WS_GATE);
    int* cnt = (int*)(ws + WS_CNT);
    int* list = (int*)(ws + WS_LIST);
    float* hbuf = (float*)(ws + WS_H);
    float* ybuf = (float*)(ws + WS_Y);

    for (int l = 0; l < DEPTH; ++l) {
        const float* xcur = (l == 0) ? x_in : out;
        const float* w_in = in[1] + (size_t)l * D * IN_COLS;
        for (int g = 0; g < NGROUP; ++g) {
            const float* xg = xcur + (size_t)g * GT * D;
            { GemmP p{}; p.A = xg; p.lda = D; p.B = w_in; p.ldb = IN_COLS; p.M = GT; p.N = IN_COLS; p.K = D; p.mode = 0; p.C = proj; p.ldc = IN_COLS;
              hipLaunchKernelGGL(gemm_f32, dim3((IN_COLS + 127) / 128, GT / 128, 1), dim3(256), 0, stream, p); }
            { RwkvP p{}; p.proj = proj; p.mu = in[2] + l * RWKV_COLS; p.w0 = in[3] + l * 512; p.w_up = in[4] + (size_t)l * 64 * 512; p.a0 = in[5] + l * 512; p.a_up = in[6] + (size_t)l * 64 * 512;
              p.g_up = in[7] + (size_t)l * 128 * 512; p.k_k = in[8] + l * 512; p.k_a = in[9] + l * 512; p.r_k = in[10] + l * 512; p.gn_g = in[11] + l * 512; p.gn_b = in[12] + l * 512;
              const size_t S1 = (size_t)GT * 512;
              p.r = rwb; p.k = rwb + S1; p.v = rwb + 2 * S1; p.w = rwb + 3 * S1; p.an = rwb + 4 * S1; p.bn = rwb + 5 * S1; p.g = rwb + 6 * S1; p.o_r = o_r;
              hipLaunchKernelGGL(rwkv_prep, dim3(GT / 8), dim3(256), 0, stream, p);
              hipLaunchKernelGGL(rwkv_scan, dim3(GB * 8), dim3(512), 0, stream, p); }
            hipLaunchKernelGGL(fox_cumsum, dim3(GB * 8), dim3(64), 0, stream, (const float*)proj, in[13] + l * FOX_HEADS, ck);
            hipLaunchKernelGGL(fox_attn, dim3(SEQ / 64, FOX_HEADS, GB), dim3(64), 0, stream, (const float*)proj, (const float*)ck, o_f);
            hipLaunchKernelGGL(ssm_prep, dim3((unsigned)((size_t)GT * SSM_CONV_DIM / 256)), dim3(256), 0, stream, (const float*)proj, in[14] + (size_t)l * 4 * SSM_CONV_DIM, in[15] + l * SSM_CONV_DIM, in[16] + l * SSM_HEADS, xbc, dtb);
            hipLaunchKernelGGL(ssm_scan, dim3(GB * SSM_HEADS), dim3(256), 0, stream, (const float*)xbc, (const float*)dtb, in[17] + l * SSM_HEADS, in[18] + l * SSM_HEADS, ys);
            hipLaunchKernelGGL(ssm_finish, dim3(GT), dim3(256), 0, stream, (const float*)proj, (const float*)ys, in[19] + l * SSM_DIM, o_m);
            const float* gbias = in[20] + (size_t)l * 3 * D;
            { GemmP p{}; p.A = o_r; p.lda = 512; p.B = in[21] + (size_t)l * 512 * D; p.ldb = D; p.M = GT; p.N = D; p.K = 512; p.mode = 1; p.C = merged; p.ldc = D; p.aux = proj + OFF_GATE; p.ldaux = IN_COLS; p.aux2 = gbias; p.alpha = 0.f;
              hipLaunchKernelGGL(gemm_f32, dim3(D / 128, GT / 128, 1), dim3(256), 0, stream, p); }
            { GemmP p{}; p.A = o_f; p.lda = 512; p.B = in[22] + (size_t)l * 512 * D; p.ldb = D; p.M = GT; p.N = D; p.K = 512; p.mode = 1; p.C = merged; p.ldc = D; p.aux = proj + OFF_GATE + D; p.ldaux = IN_COLS; p.aux2 = gbias + D; p.alpha = 1.f;
              hipLaunchKernelGGL(gemm_f32, dim3(D / 128, GT / 128, 1), dim3(256), 0, stream, p); }
            { GemmP p{}; p.A = o_m; p.lda = 1024; p.B = in[23] + (size_t)l * 1024 * D; p.ldb = D; p.M = GT; p.N = D; p.K = 1024; p.mode = 1; p.C = merged; p.ldc = D; p.aux = proj + OFF_GATE + 2 * D; p.ldaux = IN_COLS; p.aux2 = gbias + 2 * D; p.alpha = 1.f;
              hipLaunchKernelGGL(gemm_f32, dim3(D / 128, GT / 128, 1), dim3(256), 0, stream, p); }
            { GemmP p{}; p.A = merged; p.lda = D; p.B = in[24] + (size_t)l * D * D; p.ldb = D; p.M = GT; p.N = D; p.K = D; p.mode = 2; p.C = x1 + (size_t)g * GT * D; p.ldc = D; p.aux = xg; p.ldaux = D; p.alpha = ALPHA;
              hipLaunchKernelGGL(gemm_f32, dim3(D / 128, GT / 128, 1), dim3(256), 0, stream, p); }
        }
        hipMemsetAsync(cnt, 0, 256, stream);
        hipLaunchKernelGGL(ln_router, dim3(NTOK / 4), dim3(256), 0, stream, x1, in[25] + l * D, in[26] + l * D, in[27], in[28], gate, cnt, list);
        { GemmP p{}; p.A = x1; p.lda = D; p.B = in[29] + (size_t)l * NEXP * D * DEXP; p.ldb = DEXP; p.M = 0; p.N = DEXP; p.K = D; p.list = list; p.cnt = cnt; p.ashift = 1; p.strideB = (long)D * DEXP; p.list_stride = NTOK;
          p.mode = 0; p.C = hbuf; p.ldc = DEXP;
          hipLaunchKernelGGL(gemm_f32, dim3(DEXP / 128, NTOK / 128, NEXP), dim3(256), 0, stream, p);
          p.B = in[30] + (size_t)l * NEXP * D * DEXP; p.mode = 3;
          hipLaunchKernelGGL(gemm_f32, dim3(DEXP / 128, NTOK / 128, NEXP), dim3(256), 0, stream, p); }
        { GemmP p{}; p.A = hbuf; p.lda = DEXP; p.B = in[31] + (size_t)l * NEXP * DEXP * D; p.ldb = D; p.M = 0; p.N = D; p.K = DEXP; p.list = list; p.cnt = cnt; p.ashift = 0; p.strideB = (long)DEXP * D; p.list_stride = NTOK;
          p.mode = 0; p.C = ybuf; p.ldc = D;
          hipLaunchKernelGGL(gemm_f32, dim3(D / 128, NTOK / 128, NEXP), dim3(256), 0, stream, p); }
        hipLaunchKernelGGL(ln2_kernel, dim3(NTOK / 4), dim3(256), 0, stream, (const float*)x1, (const float*)ybuf, (const float*)gate, in[32] + l * D, in[33] + l * D, out);
    }
}
```

```cpp
#include <hip/hip_runtime.h>
#include <cstdio>
#include <cstdint>

constexpr int D = 1024, BATCH = 16, SEQ = 2048, DEPTH = 4, NTOK = BATCH * SEQ;
constexpr int FOX_HEADS = 8;
constexpr int SSM_DIM = 1024, SSM_HEADS = 16, SSM_CONV_DIM = 1536;
constexpr int RWKV_COLS = 1792;
constexpr int IN_COLS = 8984;
constexpr int NEXP = 32, DEXP = 512;
constexpr float ALPHA = 1.681792830507429f;
constexpr float LN_EPS = 1e-5f, NORM_EPS = 1e-5f, RWKV_GN_EPS = 64e-5f;
constexpr int PMIX_LD = 5888, PGATE_LD = 3072, NPROJ = 9216;
constexpr int C_RW = 0, C_FQ = 1792, C_FK = 2304, C_FV = 2816, C_SZ = 3328, C_SX = 4352;
enum { I_X = 0, I_WIN, I_MU, I_W0, I_WUP, I_A0, I_AUP, I_GUP, I_KK, I_KA, I_RK, I_GNG, I_GNB, I_FB, I_CW, I_CB, I_DTB, I_ALOG, I_DSK, I_NG, I_GB, I_BRR, I_BRF, I_BRM, I_WO,
       I_L1G, I_L1B, I_RW, I_RB, I_EG, I_EU, I_ED, I_L2G, I_L2B, N_IN };

typedef float f32x4 __attribute__((ext_vector_type(4)));
typedef float f32x16 __attribute__((ext_vector_type(16)));
typedef unsigned short bf16;

__device__ __forceinline__ float sigmoidf_(float x) { return __builtin_amdgcn_rcpf(1.f + __expf(-x)); }
__device__ __forceinline__ float softplusf_(float x) { const float e = __expf(-fabsf(x)); return fmaxf(x, 0.f) + __logf(1.f + e); }
__device__ __forceinline__ float siluf_(float x) { return x * __builtin_amdgcn_rcpf(1.f + __expf(-x)); }
__device__ __forceinline__ float tanhf_(float x) { const float e = __expf(-2.f * fabsf(x)); const float t = (1.f - e) * __builtin_amdgcn_rcpf(1.f + e); return x < 0.f ? -t : t; }
__device__ __forceinline__ float wave_sum(float v) {
#pragma unroll
    for (int o = 1; o < 64; o <<= 1) v += __shfl_xor(v, o);
    return v;
}
__device__ __forceinline__ float bf2f(bf16 b) { return __uint_as_float((unsigned)b << 16); }

namespace pg8 {
#define PG8_LAS __attribute__((address_space(3)))
typedef unsigned short bf16_t;
typedef short bf16x8 __attribute__((ext_vector_type(8)));
typedef float f32x4 __attribute__((ext_vector_type(4)));
typedef unsigned u32x4 __attribute__((ext_vector_type(4)));
constexpr int BM = 256, BK = 64, HALF = 128, HTB = HALF * BK * 2  , STAGE_BYTES = 8 * HTB, NXCD = 8, WGM = 8;

__host__ __device__ __forceinline__ int lds_byte(int r, int c) { const int st = (r >> 4) * 2 + (c >> 5), rr = r & 15, cc = c & 31, ob = rr * 64 + cc * 2; return st * 1024 + (ob ^ (((ob >> 9) & 1) << 5)); }
__host__ __device__ __forceinline__ void stage_rc(int b, int& R, int& C) { const int st = b / 1024, sb = b % 1024, swz = sb ^ (((sb >> 9) & 1) << 5); R = (st >> 1) * 16 + swz / 64; C = (st & 1) * 32 + (swz % 64) / 2; }
__host__ __device__ __forceinline__ int perm32(int rho) { const int n = rho >> 4, i = rho & 15; return 8 * (i >> 2) + 4 * n + (i & 3); }

#define PG8_GAS __attribute__((address_space(1)))
struct Unit { int pm, pn, pb, seg, last; };

typedef float f32x2_t __attribute__((ext_vector_type(2))); typedef __bf16 bf16x2_t __attribute__((ext_vector_type(2)));
__device__ __forceinline__ unsigned cvt_pk_bf16(float lo, float hi) { f32x2_t v = {lo, hi}; bf16x2_t b = __builtin_convertvector(v, bf16x2_t); return __builtin_bit_cast(unsigned, b); }

struct TileMap {
    int nM, nN, nwg, G, c;
    __device__ void init(int M, int N, int G_, int c_) { nM = M / BM; nN = N / BM; nwg = nM * nN; G = G_; c = c_; }
    __device__ bool tile(int i, int& pm, int& pn) const {
        const long L = (long)i * G + c; if (L >= nwg) return false;
        int wgid = (int)L; { const int q = nwg / NXCD, r = nwg % NXCD, xcd = wgid % NXCD, off = wgid / NXCD; wgid = (xcd < r ? xcd * (q + 1) : r * (q + 1) + (xcd - r) * q) + off; }
        const int nig = WGM * nN, gid = wgid / nig, fm = gid * WGM, gsz = (nM - fm) < WGM ? (nM - fm) : WGM;
        pm = fm + ((wgid % nig) % gsz); pn = (wgid % nig) / gsz; return true;
    }
};
struct DenseOrder {
    static constexpr bool GATHER = false;
    TileMap tm; const char* A; const char* Bt; size_t tstep;
    __device__ void init(const void* A_, const void* Bt_, int M, int N, int K, int G, int c) { tm.init(M, N, G, c); A = (const char*)A_; Bt = (const char*)Bt_; tstep = (size_t)BM * K * 2; }
    __device__ bool next(int i, Unit& u) const { if (!tm.tile(i, u.pm, u.pn)) return false; u.pb = 0; u.seg = 0; u.last = 1; return true; }
    __device__ __forceinline__ void addr(const Unit& u, const char*& a, const char*& b) const { a = A + (size_t)u.pm * tstep; b = Bt + (size_t)u.pn * tstep; }
    __device__ __forceinline__ void a_ready(const Unit&) const {}
    __device__ __forceinline__ void done(const Unit&) const {}
};
struct MergeOrder {
    static constexpr bool GATHER = false;
    TileMap tm; const char *A, *Bt; size_t tstep, segA, segB;
    __device__ bool next(int i, Unit& u) const { if (!tm.tile(i >> 2, u.pm, u.pn)) return false; const int sg = i & 3; u.pb = 0; u.seg = sg; u.last = (sg == 3); return true; }
    __device__ __forceinline__ void addr(const Unit& u, const char*& a, const char*& b) const { a = A + (size_t)u.seg * segA + (size_t)u.pm * tstep; b = Bt + (size_t)u.seg * segB + (size_t)u.pn * tstep; }
    __device__ __forceinline__ void a_ready(const Unit&) const {}
    __device__ __forceinline__ void done(const Unit&) const {}
};

__device__ __forceinline__ void unpack8(const u32x4 w, float (&f)[8]) {
    f[0] = __uint_as_float(w.x << 16); f[1] = __uint_as_float(w.x & 0xffff0000u); f[2] = __uint_as_float(w.y << 16); f[3] = __uint_as_float(w.y & 0xffff0000u);
    f[4] = __uint_as_float(w.z << 16); f[5] = __uint_as_float(w.z & 0xffff0000u); f[6] = __uint_as_float(w.w << 16); f[7] = __uint_as_float(w.w & 0xffff0000u);
}
__device__ __forceinline__ u32x4 pack8(const f32x4 v0, const f32x4 v1) { u32x4 w; w.x = cvt_pk_bf16(v0[0], v0[1]); w.y = cvt_pk_bf16(v0[2], v0[3]); w.z = cvt_pk_bf16(v1[0], v1[1]); w.w = cvt_pk_bf16(v1[2], v1[3]); return w; }

template <int LDC> struct EpiBf16 {
    static constexpr bool PERM = true; static constexpr int ldc = LDC;
    bf16_t* O;
    __device__ __forceinline__ void mid(f32x4 (&)[2][2][4][2], const Unit&, int, int, int, int) const {}
    __device__ __forceinline__ void operator()(const f32x4 (&acc)[2][2][4][2], const Unit& u, int wr, int wc, int fr, int fq) const {
        const int row0 = u.pm * BM + wr * 64 + fr, col0 = u.pn * BM + wc * 32 + 8 * fq;
#pragma unroll
        for (int ai = 0; ai < 2; ++ai)
#pragma unroll
            for (int m = 0; m < 4; ++m) { bf16_t* rowp = O + (size_t)(row0 + ai * HALF + m * 16) * ldc + col0;
#pragma unroll
                for (int bj = 0; bj < 2; ++bj) *(PG8_GAS u32x4*)(rowp + bj * HALF) = pack8(acc[ai][bj][m][0], acc[ai][bj][m][1]); }
    }
};
struct EpiProj {
    static constexpr bool PERM = true;
    bf16_t* pmix; bf16_t* pgate; float* misc; const float* gbias;
    __device__ __forceinline__ void mid(f32x4 (&)[2][2][4][2], const Unit&, int, int, int, int) const {}
    __device__ __forceinline__ void operator()(const f32x4 (&acc)[2][2][4][2], const Unit& u, int wr, int wc, int fr, int fq) const {
        const int row0 = u.pm * BM + wr * 64 + fr, cl = wc * 32 + 8 * fq;
        if (u.pn < 23) {
            const float sc = (u.pn == 7 || u.pn == 8) ? 0.18033688011112042f : 1.f;
#pragma unroll
            for (int ai = 0; ai < 2; ++ai)
#pragma unroll
                for (int m = 0; m < 4; ++m) { bf16_t* rowp = pmix + (size_t)(row0 + ai * HALF + m * 16) * PMIX_LD + u.pn * BM + cl;
#pragma unroll
                    for (int bj = 0; bj < 2; ++bj) *(PG8_GAS u32x4*)(rowp + bj * HALF) = pack8(acc[ai][bj][m][0] * sc, acc[ai][bj][m][1] * sc); }
        } else if (u.pn == 23) {
            if (wc == 0 && fq < 3) {
#pragma unroll
                for (int ai = 0; ai < 2; ++ai)
#pragma unroll
                    for (int m = 0; m < 4; ++m) { float* rowp = misc + (size_t)(row0 + ai * HALF + m * 16) * 32 + 8 * fq;
                        *(PG8_GAS f32x4*)rowp = acc[ai][0][m][0]; *(PG8_GAS f32x4*)(rowp + 4) = acc[ai][0][m][1]; }
            }
        } else {
            const int gc = (u.pn - 24) * BM + cl;
            f32x4 bv[2][2];
#pragma unroll
            for (int bj = 0; bj < 2; ++bj)
#pragma unroll
                for (int n = 0; n < 2; ++n) bv[bj][n] = *(const PG8_GAS f32x4*)(gbias + gc + bj * HALF + 4 * n);
#pragma unroll
            for (int ai = 0; ai < 2; ++ai)
#pragma unroll
                for (int m = 0; m < 4; ++m) { bf16_t* rowp = pgate + (size_t)(row0 + ai * HALF + m * 16) * PGATE_LD + gc;
#pragma unroll
                    for (int bj = 0; bj < 2; ++bj) { f32x4 v0 = acc[ai][bj][m][0] + bv[bj][0], v1 = acc[ai][bj][m][1] + bv[bj][1];
#pragma unroll
                        for (int i = 0; i < 4; ++i) { v0[i] = __builtin_amdgcn_rcpf(1.f + __expf(-v0[i])); v1[i] = __builtin_amdgcn_rcpf(1.f + __expf(-v1[i])); }
                        *(PG8_GAS u32x4*)(rowp + bj * HALF) = pack8(v0, v1); } }
        }
    }
};
struct EpiMerge {
    static constexpr bool PERM = true;
    const bf16_t* pgate; bf16_t* O; const float* ssq;
    __device__ __forceinline__ float rs(size_t row, int g) const { const PG8_GAS f32x4* q = (const PG8_GAS f32x4*)(ssq + row * 16 + 8 * g); const f32x4 a = q[0], b = q[1];
        return __builtin_amdgcn_rsqf((((a[0] + a[1]) + (a[2] + a[3])) + ((b[0] + b[1]) + (b[2] + b[3]))) * (1.f / 512.f) + 1e-5f); }
    __device__ __forceinline__ void ld_ssq(size_t row, int g, f32x4& a, f32x4& b) const { const PG8_GAS f32x4* q = (const PG8_GAS f32x4*)(ssq + row * 16 + 8 * g); a = q[0]; b = q[1]; }
    static __device__ __forceinline__ float rs_of(const f32x4 a, const f32x4 b) { return __builtin_amdgcn_rsqf((((a[0] + a[1]) + (a[2] + a[3])) + ((b[0] + b[1]) + (b[2] + b[3]))) * (1.f / 512.f) + 1e-5f); }
    __device__ __forceinline__ void mid(f32x4 (&acc)[2][2][4][2], const Unit& u, int wr, int wc, int fr, int fq) const {
        const int row0 = u.pm * BM + wr * 64 + fr, col0 = u.pn * BM + wc * 32 + 8 * fq;
#pragma unroll
        for (int ai = 0; ai < 2; ++ai)
#pragma unroll
            for (int m0 = 0; m0 < 4; m0 += 2) {
                if (u.seg == 2) {
#pragma unroll
                    for (int mm = 0; mm < 2; ++mm) { const int m = m0 + mm; const size_t r = (size_t)(row0 + ai * HALF + m * 16); const float f = rs(r, 0) * __builtin_amdgcn_rcpf(rs(r, 1));
#pragma unroll
                        for (int bj = 0; bj < 2; ++bj) { acc[ai][bj][m][0] = acc[ai][bj][m][0] * f; acc[ai][bj][m][1] = acc[ai][bj][m][1] * f; } }
                } else {
                    u32x4 GA[2][2], GB[2][2]; float f[2];
#pragma unroll
                    for (int mm = 0; mm < 2; ++mm) { const size_t r = (size_t)(row0 + ai * HALF + (m0 + mm) * 16); const bf16_t* gp = pgate + r * PGATE_LD + u.seg * 1024 + col0;
#pragma unroll
                        for (int bj = 0; bj < 2; ++bj) { GA[mm][bj] = *(const PG8_GAS u32x4*)(gp + bj * HALF); GB[mm][bj] = *(const PG8_GAS u32x4*)(gp + 1024 + bj * HALF); }
                        f[mm] = (u.seg == 1) ? __builtin_amdgcn_rcpf(rs(r, 0)) : 1.f; }
#pragma unroll
                    for (int mm = 0; mm < 2; ++mm) { const int m = m0 + mm;
#pragma unroll
                        for (int bj = 0; bj < 2; ++bj) { float ga[8], gb[8]; unpack8(GA[mm][bj], ga); unpack8(GB[mm][bj], gb);
#pragma unroll
                            for (int i = 0; i < 4; ++i) { acc[ai][bj][m][0][i] *= f[mm] * ga[i] * __builtin_amdgcn_rcpf(fmaxf(gb[i], 1e-20f)); acc[ai][bj][m][1][i] *= f[mm] * ga[4 + i] * __builtin_amdgcn_rcpf(fmaxf(gb[4 + i], 1e-20f)); } } }
                }
#pragma unroll
                for (int mm = 0; mm < 2; ++mm) asm volatile("" : "+v"(acc[ai][0][m0 + mm][0]), "+v"(acc[ai][0][m0 + mm][1]), "+v"(acc[ai][1][m0 + mm][0]), "+v"(acc[ai][1][m0 + mm][1]) :: "memory");
            }
    }
    __device__ __forceinline__ void operator()(const f32x4 (&acc)[2][2][4][2], const Unit& u, int wr, int wc, int fr, int fq) const {
        const int row0 = u.pm * BM + wr * 64 + fr, col0 = u.pn * BM + wc * 32 + 8 * fq;
#pragma unroll
        for (int ai = 0; ai < 2; ++ai)
#pragma unroll
            for (int m0 = 0; m0 < 4; m0 += 2) {
                u32x4 G2[2][2]; f32x4 sa[2], sb[2];
#pragma unroll
                for (int mm = 0; mm < 2; ++mm) { const size_t r = (size_t)(row0 + ai * HALF + (m0 + mm) * 16); ld_ssq(r, 1, sa[mm], sb[mm]);
#pragma unroll
                    for (int bj = 0; bj < 2; ++bj) G2[mm][bj] = *(const PG8_GAS u32x4*)(pgate + r * PGATE_LD + 2048 + col0 + bj * HALF); }
#pragma unroll
                for (int mm = 0; mm < 2; ++mm) { const int m = m0 + mm; const size_t r = (size_t)(row0 + ai * HALF + m * 16); const float f = rs_of(sa[mm], sb[mm]);
#pragma unroll
                    for (int bj = 0; bj < 2; ++bj) { float g[8]; unpack8(G2[mm][bj], g);
                        f32x4 v0 = acc[ai][bj][m][0], v1 = acc[ai][bj][m][1];
#pragma unroll
                        for (int i = 0; i < 4; ++i) { v0[i] *= f * g[i]; v1[i] *= f * g[4 + i]; }
                        *(PG8_GAS u32x4*)(O + r * 1024 + col0 + bj * HALF) = pack8(v0, v1); } }
                asm volatile("" ::: "memory");
            }
    }
};
struct EpiRes {
    static constexpr bool PERM = false;
    const bf16_t* base; bf16_t* out; float alpha;
    __device__ __forceinline__ void mid(f32x4 (&)[2][2][4][2], const Unit&, int, int, int, int) const {}
    __device__ __forceinline__ void operator()(const f32x4 (&acc)[2][2][4][2], const Unit& u, int wr, int wc, int fr, int fq) const {
        const int row0 = u.pm * BM + wr * 64 + fr, col0 = u.pn * BM + wc * 32 + 4 * fq;
#pragma unroll
        for (int ai = 0; ai < 2; ++ai)
#pragma unroll
            for (int m = 0; m < 4; ++m) { const size_t off = (size_t)(row0 + ai * HALF + m * 16) * 1024 + col0;
#pragma unroll
                for (int bj = 0; bj < 2; ++bj)
#pragma unroll
                    for (int n = 0; n < 2; ++n) { const unsigned long long bw = *(const PG8_GAS unsigned long long*)(base + off + bj * HALF + n * 16);
                        const f32x4 b = (f32x4){__uint_as_float((unsigned)bw << 16), __uint_as_float((unsigned)bw & 0xffff0000u), __uint_as_float((unsigned)(bw >> 32) << 16), __uint_as_float((unsigned)(bw >> 32) & 0xffff0000u)};
                        const f32x4 o = b * alpha + acc[ai][bj][m][n];
                        *(PG8_GAS unsigned long long*)(out + off + bj * HALF + n * 16) = (unsigned long long)cvt_pk_bf16(o[0], o[1]) | ((unsigned long long)cvt_pk_bf16(o[2], o[3]) << 32); } }
    }
};

template <bool GATHER_> struct GroupOrderT {
    static constexpr bool GATHER = GATHER_;
    const PG8_LAS int* ltok;
    __device__ __forceinline__ unsigned arow(int ui, int r) const { return (unsigned)ltok[256 * ui + r]; }
    const PG8_LAS int* tab; const char* A; const char* Bt; size_t tstepA, tstepB, estride; int nN, G, c;
    __device__ bool next(int i, Unit& u) const {
        const int nb = __builtin_amdgcn_readfirstlane(tab[0]);
        int rb, pn;
        if ((G & 31) == 0) { const int x = c & 7, j = c >> 3; rb = i * (G >> 2) + x * (G >> 5) + (j >> 2); pn = j & 3; }
        else { const int L = i * G + c; rb = L >> 2; pn = L & 3; }
        if (rb >= nb) return false;
        u.pm = rb; u.pn = pn; u.pb = __builtin_amdgcn_readfirstlane(tab[1 + rb]); u.seg = 0; u.last = 1; return true;
    }
    __device__ __forceinline__ void addr(const Unit& u, const char*& a, const char*& b) const { a = GATHER_ ? A : A + (size_t)u.pm * tstepA; b = Bt + (size_t)u.pb * estride + (size_t)u.pn * tstepB; }
    __device__ __forceinline__ void a_ready(const Unit&) const {}
    __device__ __forceinline__ void done(const Unit&) const {}
};
using GroupOrder = GroupOrderT<false>; using GroupGatherOrder = GroupOrderT<true>;
struct EpiSwiGLU {
    static constexpr bool PERM = true;
    bf16_t* H;
    __device__ __forceinline__ void mid(f32x4 (&)[2][2][4][2], const Unit&, int, int, int, int) const {}
    __device__ __forceinline__ void operator()(const f32x4 (&acc)[2][2][4][2], const Unit& u, int wr, int wc, int fr, int fq) const {
        const int row0 = u.pm * BM + wr * 64 + fr, col0 = u.pn * HALF + wc * 32 + 8 * fq;
#pragma unroll
        for (int ai = 0; ai < 2; ++ai)
#pragma unroll
            for (int m = 0; m < 4; ++m) { f32x4 h0, h1;
#pragma unroll
                for (int i = 0; i < 4; ++i) { const float g0 = acc[ai][0][m][0][i], g1 = acc[ai][0][m][1][i];
                    h0[i] = g0 * __builtin_amdgcn_rcpf(1.f + __expf(-g0)) * acc[ai][1][m][0][i]; h1[i] = g1 * __builtin_amdgcn_rcpf(1.f + __expf(-g1)) * acc[ai][1][m][1][i]; }
                *(PG8_GAS u32x4*)(H + (size_t)(row0 + ai * HALF + m * 16) * 512 + col0) = pack8(h0, h1); }
    }
};

template <class Epi, class Sched, bool ALIGN_EPI = false, bool SP2 = false>
__device__ __forceinline__ void gemm_phase(PG8_LAS unsigned char* lds, const int K, const Sched& S, const Epi& E, const int wave0) {
    int sw_ = wave0; asm volatile("" : "+s"(sw_)); int ln_; asm volatile("v_mbcnt_lo_u32_b32 %0, -1, 0\n\tv_mbcnt_hi_u32_b32 %0, -1, %0" : "=v"(ln_));
    const int tid_ = sw_ * 64 + ln_;
    const int tid = tid_, wid = __builtin_amdgcn_readfirstlane(tid >> 6), lane = tid & 63, wr = wid >> 2, wc = wid & 3, fr = lane & 15, fq = lane >> 4;
    const int nt = K / BK;
    unsigned voffA[2], voffB[2];
#pragma unroll
    for (int i = 0; i < 2; ++i) { int R, C; stage_rc(tid * 16 + i * 8192, R, C); const int Rb = Epi::PERM ? ((R & ~31) + perm32(R & 31)) : R;
        voffA[i] = (unsigned)(R * K + C) * 2u; voffB[i] = (unsigned)(Rb * K + C) * 2u; }
    unsigned gc[2][2] = {{0u, 0u}, {0u, 0u}};
    auto gof = [&](int ui_, unsigned (&g)[2][2]) {
        if constexpr (Sched::GATHER) {
#pragma unroll
        for (int i = 0; i < 2; ++i) { int R, C; stage_rc(tid * 16 + i * 8192, R, C);
#pragma unroll
            for (int h = 0; h < 2; ++h) g[h][i] = S.arow(ui_, h * HALF + R) * (unsigned)(K * 2) + (unsigned)(C * 2); } } };
    const size_t kstep = (size_t)(BK * 2);
    const size_t hstep = (size_t)HALF * K * 2;
    const unsigned ldsw = (unsigned)wid * 1024u;
    const int aoff = lds_byte(wr * 64 + fr, fq * 8), boff = lds_byte(wc * 32 + fr, fq * 8);
#define PG8_SA(b, h) (((b) * 2 + (h)) * HTB)
#define PG8_SB(b, h) ((4 + (b) * 2 + (h)) * HTB)
#define PG8_STAGE(bufoff, gbase, voff) do { _Pragma("unroll") for (int _i = 0; _i < 2; ++_i) \
        __builtin_amdgcn_global_load_lds((const unsigned*)((const char*)(gbase) + (voff)[_i]), (PG8_LAS unsigned*)(lds + (bufoff) + ldsw + _i * 8192), 16, 0, 0); } while (0)
#define PG8_LDA(dst, b, h) do { _Pragma("unroll") for (int m = 0; m < 4; ++m) _Pragma("unroll") for (int k = 0; k < 2; ++k) dst[m][k] = *(const PG8_LAS bf16x8*)(lds + PG8_SA(b, h) + aoff + m * 2048 + k * 1024); } while (0)
#define PG8_LDB(dst, b, h) do { _Pragma("unroll") for (int n = 0; n < 2; ++n) _Pragma("unroll") for (int k = 0; k < 2; ++k) dst[n][k] = *(const PG8_LAS bf16x8*)(lds + PG8_SB(b, h) + boff + n * 2048 + k * 1024); } while (0)
#define PG8_MMA(ai, bj, At, Bt) do { __builtin_amdgcn_s_setprio(1); _Pragma("unroll") for (int m = 0; m < 4; ++m) _Pragma("unroll") for (int n = 0; n < 2; ++n) _Pragma("unroll") for (int k = 0; k < 2; ++k) \
        acc[ai][bj][m][n] = __builtin_amdgcn_mfma_f32_16x16x32_bf16(Bt[n][k], At[m][k], acc[ai][bj][m][n], 0, 0, 0); __builtin_amdgcn_s_setprio(0); } while (0)
#define PG8_WAIT_V(n) asm volatile("s_waitcnt vmcnt(" #n ")" ::: "memory")
#define PG8_WAIT_L(n) asm volatile("s_waitcnt lgkmcnt(" #n ")" ::: "memory")
#define PG8_BAR __builtin_amdgcn_s_barrier()
#define PG8_SCHED __builtin_amdgcn_sched_barrier(0)
    Unit cur, nxt; int ui = 0;
    if (!S.next(0, cur)) return;
    f32x4 acc[2][2][4][2];
#pragma unroll
    for (int a = 0; a < 2; ++a)
#pragma unroll
        for (int b = 0; b < 2; ++b)
#pragma unroll
            for (int m = 0; m < 4; ++m)
#pragma unroll
                for (int n = 0; n < 2; ++n) acc[a][b][m][n] = (f32x4){0.f, 0.f, 0.f, 0.f};
    bf16x8 At[4][2], B0[2][2], B1[2][2];
    const char* cA; const char* cB; S.addr(cur, cA, cB);
    S.a_ready(cur);
    if constexpr (Sched::GATHER) {
        static_assert(SP2, "GATHER schedulers use the SP2 loop");
        gof(0, gc);
        PG8_STAGE(PG8_SB(0, 0), cB, voffB); PG8_STAGE(PG8_SB(0, 1), cB + hstep, voffB); PG8_STAGE(PG8_SA(0, 0), cA, gc[0]); PG8_STAGE(PG8_SA(0, 1), cA, gc[1]);
        if (wr == 1) PG8_BAR;
        PG8_WAIT_V(2); PG8_BAR;
        PG8_STAGE(PG8_SB(1, 0), cB + kstep, voffB); PG8_STAGE(PG8_SA(1, 0), cA + kstep, gc[0]); PG8_STAGE(PG8_SB(1, 1), cB + hstep + kstep, voffB);
        PG8_WAIT_V(6); PG8_BAR;
    } else if constexpr (SP2) {
        PG8_STAGE(PG8_SB(0, 0), cB, voffB); PG8_STAGE(PG8_SB(0, 1), cB + hstep, voffB); PG8_STAGE(PG8_SA(0, 0), cA, voffA); PG8_STAGE(PG8_SA(0, 1), cA + hstep, voffA);
        if (wr == 1) PG8_BAR;
        PG8_WAIT_V(2); PG8_BAR;
        PG8_STAGE(PG8_SB(1, 0), cB + kstep, voffB); PG8_STAGE(PG8_SA(1, 0), cA + kstep, voffA); PG8_STAGE(PG8_SB(1, 1), cB + hstep + kstep, voffB);
        PG8_WAIT_V(6); PG8_BAR;
    } else {
        PG8_STAGE(PG8_SB(0, 0), cB, voffB); PG8_STAGE(PG8_SA(0, 0), cA, voffA); PG8_STAGE(PG8_SB(0, 1), cB + hstep, voffB); PG8_STAGE(PG8_SA(0, 1), cA + hstep, voffA);
        if (wr == 1) PG8_BAR;
        PG8_WAIT_V(4); PG8_BAR;
        PG8_STAGE(PG8_SB(1, 0), cB + kstep, voffB); PG8_STAGE(PG8_SA(1, 0), cA + kstep, voffA); PG8_STAGE(PG8_SB(1, 1), cB + hstep + kstep, voffB);
        PG8_WAIT_V(6); PG8_BAR;
    }
    for (;;) {
        const bool has_next = S.next(ui + 1, nxt);
        const char* nA = cA; const char* nB = cB; if (has_next) S.addr(nxt, nA, nB);
        for (int t = 0; t < nt; t += 2) {
            const bool last = (t == nt - 2);
            const char* a1 = cA + (size_t)(t + 1) * kstep;
            const char* a2 = last ? nA : cA + (size_t)(t + 2) * kstep; const char* b2 = last ? nB : cB + (size_t)(t + 2) * kstep;
            const char* a3 = a2 + kstep; const char* b3 = b2 + kstep;
            if (last && has_next) S.a_ready(nxt);
            if constexpr (Sched::GATHER) {
            unsigned o2[2][2];
            o2[0][0] = gc[0][0]; o2[0][1] = gc[0][1]; o2[1][0] = gc[1][0]; o2[1][1] = gc[1][1];
            if (last && has_next) gof(ui + 1, o2);
            PG8_LDB(B0, 0, 0); PG8_LDB(B1, 0, 1); PG8_SCHED; PG8_LDA(At, 0, 0); PG8_STAGE(PG8_SA(1, 1), a1, gc[1]);
            PG8_WAIT_V(8); PG8_WAIT_L(0); PG8_BAR; PG8_MMA(0, 0, At, B0); PG8_MMA(0, 1, At, B1); PG8_BAR; PG8_SCHED;
            PG8_LDA(At, 0, 1); PG8_STAGE(PG8_SB(0, 0), b2, voffB); PG8_STAGE(PG8_SB(0, 1), b2 + hstep, voffB); PG8_STAGE(PG8_SA(0, 0), a2, o2[0]);
            PG8_WAIT_V(8); PG8_WAIT_L(0); PG8_BAR; PG8_MMA(1, 0, At, B0); PG8_MMA(1, 1, At, B1); PG8_BAR; PG8_SCHED;
            PG8_LDB(B0, 1, 0); PG8_LDB(B1, 1, 1); PG8_SCHED; PG8_LDA(At, 1, 0); PG8_STAGE(PG8_SA(0, 1), a2, o2[1]);
            PG8_WAIT_V(8); PG8_WAIT_L(0); PG8_BAR; PG8_MMA(0, 0, At, B0); PG8_MMA(0, 1, At, B1); PG8_BAR; PG8_SCHED;
            PG8_LDA(At, 1, 1); PG8_STAGE(PG8_SB(1, 0), b3, voffB); PG8_STAGE(PG8_SB(1, 1), b3 + hstep, voffB); PG8_STAGE(PG8_SA(1, 0), a3, o2[0]);
            PG8_WAIT_V(8); PG8_WAIT_L(0); PG8_BAR; PG8_MMA(1, 0, At, B0); PG8_MMA(1, 1, At, B1); PG8_BAR; PG8_SCHED;
            } else if constexpr (SP2) {
            PG8_LDB(B0, 0, 0); PG8_LDB(B1, 0, 1); PG8_SCHED; PG8_LDA(At, 0, 0); PG8_STAGE(PG8_SA(1, 1), a1 + hstep, voffA);
            PG8_WAIT_V(8); PG8_WAIT_L(0); PG8_BAR; PG8_MMA(0, 0, At, B0); PG8_MMA(0, 1, At, B1); PG8_BAR; PG8_SCHED;
            PG8_LDA(At, 0, 1); PG8_STAGE(PG8_SB(0, 0), b2, voffB); PG8_STAGE(PG8_SB(0, 1), b2 + hstep, voffB); PG8_STAGE(PG8_SA(0, 0), a2, voffA);
            PG8_WAIT_V(8); PG8_WAIT_L(0); PG8_BAR; PG8_MMA(1, 0, At, B0); PG8_MMA(1, 1, At, B1); PG8_BAR; PG8_SCHED;
            PG8_LDB(B0, 1, 0); PG8_LDB(B1, 1, 1); PG8_SCHED; PG8_LDA(At, 1, 0); PG8_STAGE(PG8_SA(0, 1), a2 + hstep, voffA);
            PG8_WAIT_V(8); PG8_WAIT_L(0); PG8_BAR; PG8_MMA(0, 0, At, B0); PG8_MMA(0, 1, At, B1); PG8_BAR; PG8_SCHED;
            PG8_LDA(At, 1, 1); PG8_STAGE(PG8_SB(1, 0), b3, voffB); PG8_STAGE(PG8_SB(1, 1), b3 + hstep, voffB); PG8_STAGE(PG8_SA(1, 0), a3, voffA);
            PG8_WAIT_V(8); PG8_WAIT_L(0); PG8_BAR; PG8_MMA(1, 0, At, B0); PG8_MMA(1, 1, At, B1); PG8_BAR; PG8_SCHED;
            } else {
            PG8_LDB(B0, 0, 0); PG8_SCHED; PG8_LDA(At, 0, 0); PG8_STAGE(PG8_SA(1, 1), a1 + hstep, voffA);
            PG8_WAIT_L(8); PG8_BAR; PG8_WAIT_L(0); PG8_MMA(0, 0, At, B0); PG8_BAR; PG8_SCHED;
            PG8_LDB(B1, 0, 1); PG8_STAGE(PG8_SB(0, 0), b2, voffB);
            PG8_BAR; PG8_WAIT_L(0); PG8_MMA(0, 1, At, B1); PG8_BAR;
            PG8_LDA(At, 0, 1); PG8_STAGE(PG8_SA(0, 0), a2, voffA);
            PG8_BAR; PG8_WAIT_L(0); PG8_MMA(1, 0, At, B0); PG8_BAR; PG8_SCHED;
            PG8_STAGE(PG8_SB(0, 1), b2 + hstep, voffB);
            PG8_WAIT_V(6); PG8_BAR; PG8_MMA(1, 1, At, B1); PG8_BAR;
            PG8_LDB(B0, 1, 0); PG8_SCHED; PG8_LDA(At, 1, 0); PG8_STAGE(PG8_SA(0, 1), a2 + hstep, voffA);
            PG8_WAIT_L(8); PG8_BAR; PG8_WAIT_L(0); PG8_MMA(0, 0, At, B0); PG8_BAR; PG8_SCHED;
            PG8_LDB(B1, 1, 1); PG8_STAGE(PG8_SB(1, 0), b3, voffB);
            PG8_BAR; PG8_WAIT_L(0); PG8_MMA(0, 1, At, B1); PG8_BAR;
            PG8_LDA(At, 1, 1); PG8_STAGE(PG8_SA(1, 0), a3, voffA);
            PG8_BAR; PG8_WAIT_L(0); PG8_MMA(1, 0, At, B0); PG8_BAR; PG8_SCHED;
            PG8_STAGE(PG8_SB(1, 1), b3 + hstep, voffB);
            PG8_WAIT_V(6); PG8_BAR; PG8_MMA(1, 1, At, B1); PG8_BAR;
            }
        }
        if constexpr (ALIGN_EPI) { if (wr == 0) PG8_BAR; }
        { int le_; asm volatile("v_mbcnt_lo_u32_b32 %0, -1, 0\n\tv_mbcnt_hi_u32_b32 %0, -1, %0" : "=v"(le_));
          const int fr_e = le_ & 15, fq_e = le_ >> 4;
          if (cur.last) E(acc, cur, wr, wc, fr_e, fq_e); else E.mid(acc, cur, wr, wc, fr_e, fq_e); }
        if (!has_next) break;
        if (cur.last) {
#pragma unroll
        for (int a = 0; a < 2; ++a)
#pragma unroll
            for (int b = 0; b < 2; ++b)
#pragma unroll
                for (int m = 0; m < 4; ++m)
#pragma unroll
                    for (int n = 0; n < 2; ++n) acc[a][b][m][n] = (f32x4){0.f, 0.f, 0.f, 0.f};
        }
        cur = nxt; cA = nA; cB = nB; ++ui;
        if constexpr (Sched::GATHER) gof(ui, gc);
        if constexpr (ALIGN_EPI) { if (wr == 1) PG8_BAR; }
    }
    PG8_WAIT_V(0);
    if constexpr (!ALIGN_EPI) { if (wr == 0) PG8_BAR; }
    PG8_BAR;
#undef PG8_SA
#undef PG8_SB
#undef PG8_STAGE
#undef PG8_LDA
#undef PG8_LDB
#undef PG8_MMA
#undef PG8_WAIT_V
#undef PG8_WAIT_L
#undef PG8_BAR
#undef PG8_SCHED
}
}


#define GAS __attribute__((address_space(1)))
#define LAS __attribute__((address_space(3)))
typedef unsigned short bf16;
typedef unsigned v4u __attribute__((ext_vector_type(4)));
typedef float f32x4 __attribute__((ext_vector_type(4)));
typedef short bf16x8 __attribute__((ext_vector_type(8)));
typedef GAS unsigned gu32;
typedef GAS unsigned long long gu64;
#define RLX_AGENT __ATOMIC_RELAXED, __HIP_MEMORY_SCOPE_AGENT
#define LDS_WAIT() asm volatile("s_waitcnt lgkmcnt(0)" ::: "memory")
#define VM_WAIT() asm volatile("s_waitcnt vmcnt(0)" ::: "memory")
__device__ __forceinline__ unsigned long long rt() { return __builtin_amdgcn_s_memrealtime(); }
__device__ __forceinline__ unsigned f2bf(float f) { unsigned u = __builtin_bit_cast(unsigned, f); return (u + 0x7fffu + ((u >> 16) & 1u)) >> 16; }
__device__ __forceinline__ unsigned pk2(float lo, float hi) { return f2bf(lo) | (f2bf(hi) << 16); }

#define XB_TMO      128
#define XB_XCNT(j)  (256  + 64 * (j))
#define XB_XSUB(j)  (1280 + 64 * (j))
#define XB_XGEN(j)  (2304 + 64 * (j))
#define XB_TOP      3328
#define XB_TOPGEN   3392
#define XCD_BAR_WORDS 3456
#define XB_SPIN_CAP (1u << 18)

__device__ __forceinline__ unsigned xb_ld(unsigned* p)              { return __hip_atomic_load(p, __ATOMIC_RELAXED, __HIP_MEMORY_SCOPE_AGENT); }
__device__ __forceinline__ unsigned xb_add(unsigned* p, unsigned v) { return __hip_atomic_fetch_add(p, v, __ATOMIC_RELAXED, __HIP_MEMORY_SCOPE_AGENT); }
__device__ __forceinline__ unsigned xb_xcc_id() { return (unsigned)__builtin_amdgcn_s_getreg((3 << 11) | 20) & 0xFu; }
#define XB_SPIN(cond, bar) do { unsigned _sp = 0; while (cond) { __builtin_amdgcn_s_sleep(1); \
    if ((++_sp & 255u) == 0u) { if (xb_ld(&(bar)[XB_TMO])) break; if (_sp > XB_SPIN_CAP) { atomicAdd(&(bar)[XB_TMO], 1u); break; } } } } while (0)

struct XcdBarrier {
    unsigned* bar; unsigned x;
    volatile LAS unsigned* st;
};

__device__ __forceinline__ XcdBarrier xcd_barrier_post(unsigned* bar, volatile LAS unsigned* st) {
    XcdBarrier b; b.bar = bar; b.x = xb_xcc_id(); b.st = st;
    if (threadIdx.x == 0) (void)xb_add(&bar[XB_XCNT(b.x)], 1u);
    return b;
}
__device__ __forceinline__ void xcd_barrier_complete(unsigned* bar, unsigned x, unsigned& nloc, unsigned& nx) {
    const unsigned G = gridDim.x * gridDim.y * gridDim.z;
    unsigned sum, cnt, mine, sp = 0u;
    for (;;) {
        sum = 0u; cnt = 0u; mine = 0u;
#pragma unroll
        for (unsigned j = 0; j < 16; ++j) { const unsigned c = xb_ld(&bar[XB_XCNT(j)]); sum += c; cnt += (c > 0u) ? 1u : 0u; mine = (j == x) ? c : mine; }
        if (sum == G) break;
        __builtin_amdgcn_s_sleep(1);
        if ((++sp & 255u) == 0u) { if (xb_ld(&bar[XB_TMO])) break; if (sp > XB_SPIN_CAP) { atomicAdd(&bar[XB_TMO], 1u); break; } }
    }
    nloc = mine > 0u ? mine : 1u; nx = cnt > 0u ? cnt : 1u;
}

__device__ __forceinline__ void xcd_barrier(const XcdBarrier& b) {
    asm volatile("s_waitcnt vmcnt(0)" ::: "memory");
    __syncthreads();
    if (threadIdx.x == 0) {
        unsigned* bar = b.bar;
        __builtin_amdgcn_s_waitcnt(0);
        unsigned nloc = b.st[0], nx = b.st[1];
        if (nloc == 0u) { xcd_barrier_complete(bar, b.x, nloc, nx); b.st[0] = nloc; b.st[1] = nx; }
        const unsigned old = xb_add(&bar[XB_XSUB(b.x)], 1u);
        const unsigned gen = old / nloc;
        if (old + 1u == (gen + 1u) * nloc) {
            __builtin_amdgcn_fence(__ATOMIC_RELEASE, "agent");
            asm volatile("s_waitcnt vmcnt(0)" ::: "memory");
            const unsigned og = xb_add(&bar[XB_TOP], 1u);
            const unsigned tg = og / nx;
            if (og + 1u == (tg + 1u) * nx) xb_add(&bar[XB_TOPGEN], 1u);
            else XB_SPIN(xb_ld(&bar[XB_TOPGEN]) == tg, bar);
            __builtin_amdgcn_fence(__ATOMIC_ACQUIRE, "agent");
            xb_add(&bar[XB_XGEN(b.x)], 1u);
            asm volatile("s_waitcnt vmcnt(0)" ::: "memory");
        } else {
            XB_SPIN(xb_ld(&bar[XB_XGEN(b.x)]) == gen, bar);
            __builtin_amdgcn_fence(__ATOMIC_ACQUIRE, "agent");
            asm volatile("s_waitcnt vmcnt(0)" ::: "memory");
        }
    }
    __syncthreads();
}


#include <hip/hip_bf16.h>
#include <cmath>
#include <hip/hip_bf16.h>
#include <cmath>
namespace attn_body {
using bf16=__hip_bfloat16;
using bf16x8=__attribute__((ext_vector_type(8)))short;
using s16x4=__attribute__((ext_vector_type(4)))short;
using f32x16=__attribute__((ext_vector_type(16)))float;
using u32x4=__attribute__((ext_vector_type(4)))unsigned;
using f32x4_t=__attribute__((ext_vector_type(4)))float;
constexpr int BATCH=16,NHEAD=8,SEQ=2048,D=64,DM=5888,OP=512;
constexpr int NW=8,QBLK=32,QB=QBLK*NW,KVBLK=64,NQB=SEQ/QB;
constexpr int ATTN_PITCH=DM, ATTN_UNIT_ROWS=QB;
__device__ __forceinline__ int crow(int r,int hi){return (r&3)+8*(r>>2)+4*hi;}
#define SBAR() __builtin_amdgcn_sched_barrier(0)
__device__ __forceinline__ void cmask(f32x16&p0,f32x16&p1,int jb,int qrel,int hi){
  const float NEG=-INFINITY; int kb=64*jb+4*hi;
  #pragma unroll
  for(int r=0;r<16;++r){int kv=kb+(r&3)+8*(r>>2); if(kv>qrel)p0[r]=NEG; if(kv+32>qrel)p1[r]=NEG;}
}

constexpr int NSLOT=3, SLOTB=8192;
constexpr int LDS_K=0, LDS_V=NSLOT*SLOTB, LDS_WS=2*NSLOT*SLOTB, LDS_OST=LDS_WS+NW*64*4, LDS_CB=LDS_OST+NW*4096, LDS_BYTES=LDS_CB+SEQ*4;
constexpr float C2=0.125f*1.4426950408889634f;
__device__ __forceinline__ void glds16(const void*gsrc,unsigned lds_dst){unsigned keep;
  asm volatile("s_mov_b32 %0, m0\n\ts_mov_b32 m0, %2\n\ts_nop 0\n\tglobal_load_lds_dwordx4 %1, off\n\ts_mov_b32 m0, %0":"=&s"(keep):"v"(gsrc),"s"(lds_dst):"memory");}
__device__ __forceinline__ float max3f(float a,float b,float c){float r;asm("v_max3_f32 %0, %1, %2, %3":"=v"(r):"v"(a),"v"(b),"v"(c));return r;}
__device__ __forceinline__ float max2f(float a,float b){float r;asm("v_max_f32_e32 %0, %1, %2":"=v"(r):"v"(a),"v"(b));return r;}
__device__ __forceinline__ float fadd_s(float a,float b){float r;asm("v_add_f32_e32 %0, %1, %2":"=v"(r):"v"(a),"v"(b));return r;}
__device__ __forceinline__ float fsub_s(float a,float b){float r;asm("v_sub_f32_e32 %0, %1, %2":"=v"(r):"v"(a),"v"(b));return r;}
typedef float f32x2_t __attribute__((ext_vector_type(2))); typedef __bf16 bf16x2_t __attribute__((ext_vector_type(2)));
__device__ __forceinline__ unsigned cvtpk_s(float lo,float hi){f32x2_t v={lo,hi};bf16x2_t b=__builtin_convertvector(v,bf16x2_t);return __builtin_bit_cast(unsigned,b);}
#define WAIT_BAR(N) asm volatile("s_waitcnt vmcnt(" #N ") lgkmcnt(0)\n\ts_barrier":::"memory")

__device__ __forceinline__ void qkt(f32x16&p0,f32x16&p1,const char*Kslot,const bf16x8*qr,int r32,int hi){
  const char*kb=Kslot+hi*1024+r32*16;
  #pragma unroll
  for(int d0=0;d0<4;++d0){
    const bf16x8 b0=*reinterpret_cast<const bf16x8*>(kb+d0*2048);
    const bf16x8 b1=*reinterpret_cast<const bf16x8*>(kb+d0*2048+512);
    if(d0==0){p0=__builtin_amdgcn_mfma_f32_32x32x16_bf16(b0,qr[0],p0,0,0,0);p1=__builtin_amdgcn_mfma_f32_32x32x16_bf16(b1,qr[0],p1,0,0,0);}
    else{p0=__builtin_amdgcn_mfma_f32_32x32x16_bf16(b0,qr[d0],p0,0,0,0);p1=__builtin_amdgcn_mfma_f32_32x32x16_bf16(b1,qr[d0],p1,0,0,0);}}
}
typedef __attribute__((address_space(3))) const char* lds_cptr;
typedef short v4i16_t __attribute__((ext_vector_type(4)));
__device__ __forceinline__ void kload8(bf16x8*kf,lds_cptr kp){
  kf[0]=*(const __attribute__((address_space(3))) bf16x8*)(kp);      kf[1]=*(const __attribute__((address_space(3))) bf16x8*)(kp+512);
  kf[2]=*(const __attribute__((address_space(3))) bf16x8*)(kp+2048); kf[3]=*(const __attribute__((address_space(3))) bf16x8*)(kp+2560);
  kf[4]=*(const __attribute__((address_space(3))) bf16x8*)(kp+4096); kf[5]=*(const __attribute__((address_space(3))) bf16x8*)(kp+4608);
  kf[6]=*(const __attribute__((address_space(3))) bf16x8*)(kp+6144); kf[7]=*(const __attribute__((address_space(3))) bf16x8*)(kp+6656);
}
__device__ __forceinline__ void kload2(bf16x8*kf,lds_cptr kp,int j){ kf[2*j]=*(const __attribute__((address_space(3))) bf16x8*)(kp+j*2048); kf[2*j+1]=*(const __attribute__((address_space(3))) bf16x8*)(kp+j*2048+512); }
__device__ __forceinline__ s16x4 vtr(lds_cptr p){ return __builtin_bit_cast(s16x4,__builtin_amdgcn_ds_read_tr16_b64_v4i16((__attribute__((address_space(3))) v4i16_t*)p)); }
__device__ __forceinline__ float rowmax(const f32x16&p0,const f32x16&p1){
  float a=max3f(p0[0],p0[1],p1[0]),b=max3f(p0[2],p0[3],p1[1]);a=max3f(a,p1[2],p1[3]);
  #pragma unroll
  for(int r=4;r<16;r+=4){a=max3f(a,p0[r],p0[r+1]);b=max3f(b,p0[r+2],p0[r+3]);a=max3f(a,p1[r],p1[r+1]);b=max3f(b,p1[r+2],p1[r+3]);}
  const float m=max2f(a,b);
  auto rr=__builtin_amdgcn_permlane32_swap(__float_as_uint(m),__float_as_uint(m),false,false);
  return max2f(__uint_as_float(rr[0]),__uint_as_float(rr[1]));
}
__device__ __forceinline__ void pv(f32x16*o,int vb,bf16x8 pa0,bf16x8 pa1,bf16x8 pa2,bf16x8 pa3){
  #pragma unroll
  for(int d0=0;d0<2;++d0){s16x4 lo[4],hi[4];
    #pragma unroll
    for(int ks=0;ks<4;++ks){
      asm volatile("ds_read_b64_tr_b16 %0,%1 offset:%c2":"=&v"(lo[ks]):"v"(vb),"i"(d0*4096+ks*1024):"memory");
      asm volatile("ds_read_b64_tr_b16 %0,%1 offset:%c2":"=&v"(hi[ks]):"v"(vb),"i"(d0*4096+ks*1024+512):"memory");}
    asm volatile("s_waitcnt lgkmcnt(0)":::"memory");SBAR();
    #define PK(k) (bf16x8){lo[k][0],lo[k][1],lo[k][2],lo[k][3],hi[k][0],hi[k][1],hi[k][2],hi[k][3]}
    o[d0]=__builtin_amdgcn_mfma_f32_32x32x16_bf16(pa0,PK(0),o[d0],0,0,0);
    o[d0]=__builtin_amdgcn_mfma_f32_32x32x16_bf16(pa1,PK(1),o[d0],0,0,0);
    o[d0]=__builtin_amdgcn_mfma_f32_32x32x16_bf16(pa2,PK(2),o[d0],0,0,0);
    o[d0]=__builtin_amdgcn_mfma_f32_32x32x16_bf16(pa3,PK(3),o[d0],0,0,0);
    #undef PK
  }
}

#ifndef ATTN_STORE16
#define ATTN_STORE16(p,v) (*(u32x4*)(p)=(v))
#endif
template<int THRL> __device__ __forceinline__ void attn_unit(int b,int h,int qb,const bf16*Q,const bf16*__restrict__ K,const bf16*__restrict__ V,bf16*O,const float*__restrict__ ck,char*shm,const int wave0){
  int sw_=wave0; asm volatile("":"+s"(sw_)); int ln_; asm volatile("v_mbcnt_lo_u32_b32 %0, -1, 0\n\tv_mbcnt_hi_u32_b32 %0, -1, %0":"=v"(ln_)); const int tid=sw_*64+ln_,lane=tid&63,r32=lane&31,hi=lane>>5; const int wid=__builtin_amdgcn_readfirstlane(tid>>6);
  const long rowbase=(long)b*SEQ; const int q0=qb*QB;
  const bf16*Qw=Q+(rowbase+q0+wid*QBLK)*DM+h*D;
  const bf16*Kh=K+rowbase*DM+h*D,*Vh=V+rowbase*DM+h*D;
  const unsigned lds0=(unsigned)(uintptr_t)shm;
  float*wsf=(float*)(shm+LDS_WS)+wid*64;
  const bf16*ksrc=Kh+(long)lane*DM+wid*8;
  const bf16*vsrc=Vh+(long)(16*(wid&3)+(lane>>2))*DM+(wid>>2)*32+(lane&3)*8;
  const unsigned kdst=lds0+LDS_K+wid*1024, vdst=lds0+LDS_V+wid*1024;
  #define DMA_K(t,slot) glds16(ksrc+(long)(t)*KVBLK*DM,(unsigned)__builtin_amdgcn_readfirstlane(kdst+(slot)))
  #define DMA_V(t,slot) glds16(vsrc+(long)(t)*KVBLK*DM,(unsigned)__builtin_amdgcn_readfirstlane(vdst+(slot)))
  const int vb0=(int)(lds0+LDS_V)+((lane>>4)&1)*32+(lane&3)*8+(4*hi+((lane&15)>>2))*64;
  const char*Kbase=shm+LDS_K; bf16x8 kf[8];
  const lds_cptr shm3=(lds_cptr)shm; const lds_cptr kp0=shm3+LDS_K+hi*1024+r32*16; const lds_cptr vp0=shm3+LDS_V+((lane>>4)&1)*32+(lane&3)*8+(4*hi+((lane&15)>>2))*64;
  const int NT=(q0+QB)/KVBLK;
  { __attribute__((address_space(3))) float*cbl=(__attribute__((address_space(3))) float*)((__attribute__((address_space(3))) char*)shm+LDS_CB); const float cref=ck[q0+QB-1]; for(int i=tid;i<q0+QB;i+=NW*64)cbl[i]=cref-ck[i]; }
  typedef __attribute__((address_space(3))) const f32x4_t* lds_f4p; const lds_f4p cbp=(lds_f4p)((lds_cptr)shm+LDS_CB)+hi;
  #define BIASLD(X0,X1,t) do{ const lds_f4p c_=cbp+16*(t); _Pragma("unroll") for(int g_=0;g_<4;++g_){ const f32x4_t a_=c_[2*g_],b_=c_[8+2*g_]; X0[4*g_]=a_[0];X0[4*g_+1]=a_[1];X0[4*g_+2]=a_[2];X0[4*g_+3]=a_[3]; X1[4*g_]=b_[0];X1[4*g_+1]=b_[1];X1[4*g_+2]=b_[2];X1[4*g_+3]=b_[3]; } }while(0)
  DMA_K(0,0);DMA_V(0,0);DMA_K(1,SLOTB);
  bf16x8 qr[4];
  #pragma unroll
  for(int d0=0;d0<4;++d0)qr[d0]=*reinterpret_cast<const bf16x8*>(&Qw[(long)r32*DM+d0*16+hi*8]);
  float mhat=0.f,l_reg=0.f;f32x16 o[2];o[0]=f32x16{};o[1]=f32x16{};
  const int qrel=wid*QBLK+r32;
  #define CMASK(P0,P1,t) do{int jb_=(t)-(NT-4); if(jb_>=0)cmask(P0,P1,jb_,qrel,hi);}while(0)
  bool resc=false;
  #define START(P0,P1) do{ const float rm=rowmax(P0,P1); resc=false; \
    { const float dl=rm; mhat=fadd_s(mhat,dl); \
      _Pragma("unroll") for(int r=0;r<16;++r){P0[r]=fsub_s(P0[r],dl);P1[r]=fsub_s(P1[r],dl);} } \
    _Pragma("unroll") for(int r=0;r<16;++r)P0[r]=__builtin_amdgcn_exp2f(P0[r]); }while(0)
  #define RESC() do{ if(resc){ asm volatile("s_waitcnt lgkmcnt(0)":::"memory"); \
      _Pragma("unroll") for(int d_=0;d_<2;++d_) _Pragma("unroll") for(int r=0;r<16;++r)o[d_][r]*=wsf[crow(r,hi)]; } }while(0)
  f32x16 pA0,pA1,pB0,pB1;
  int sl_prev=0,sl_cur=0,sl_next=SLOTB;
  #define ROT() do{sl_prev=sl_cur;sl_cur=sl_next;sl_next=(sl_next==(NSLOT-1)*SLOTB)?0:sl_next+SLOTB;}while(0)
  DMA_K(2,2*SLOTB);
  WAIT_BAR(3);
  BIASLD(pA0,pA1,0);
  qkt(pA0,pA1,Kbase,qr,r32,hi);asm volatile("s_nop 15\n\ts_nop 7":"+v"(pA0),"+v"(pA1));CMASK(pA0,pA1,0);
  START(pA0,pA1);
  _Pragma("unroll") for(int r=0;r<16;++r)pA1[r]=__builtin_amdgcn_exp2f(pA1[r]);
  WAIT_BAR(0);
  DMA_K(3,0);DMA_V(1,SLOTB);
  ROT();
  kload8(kf,kp0+sl_cur);
  BIASLD(pB0,pB1,1);
  WAIT_BAR(2);
  s16x4 vlo[8],vhi[8]; u32x4 pw0,pw1,pw2,pw3;
  #define PKW(P,B) cvtpk_s(P[B],P[B+1])
  #define PAF(k) __builtin_bit_cast(bf16x8,pw##k)
  #define VFR(i) (bf16x8){vlo[i][0],vlo[i][1],vlo[i][2],vlo[i][3],vhi[i][0],vhi[i][1],vhi[i][2],vhi[i][3]}
  #define PIN(x) asm volatile("":"+v"(x))
  #define MX3(a,b,c) __builtin_fmaxf(__builtin_fmaxf((a),(b)),(c))
  #define GAPA(MF,A0,A1,A2,A3,W0,W1,PW) do{ MF; sacc+=A0; sacc+=A1; sacc+=A2; sacc+=A3; PIN(sacc); W0; W1; PIN(PW); SBAR(); }while(0)
  #define EX(v) __builtin_amdgcn_exp2f(v)
  #define GAPB(MF,X,B) do{ MF; X[B]=EX(X[B]); X[B+1]=EX(X[B+1]); X[B+2]=EX(X[B+2]); X[B+3]=EX(X[B+3]); PIN(X); SBAR(); }while(0)
  #define VRD(i) do{ vlo[i]=vtr(vp_+(((i)>>2)*4096+((i)&3)*1024)); vhi[i]=vtr(vp_+(((i)>>2)*4096+((i)&3)*1024+512)); }while(0)
  #define KRD(G,j) do{ if(G){ kload2(kf,kp0+sl_next,j); SBAR(); } }while(0)
  #define STEP(C0,C1,P0,P1,t,GK,GV,GL) do{ SBAR(); \
    _Pragma("unroll") for(int r=0;r<16;++r){C0[r]-=mhat;C1[r]-=mhat;} \
    const lds_cptr vp_=vp0+sl_prev; \
    VRD(0); SBAR(); float sacc=(P0[0]+P0[1]); \
    GAPA(C0=__builtin_amdgcn_mfma_f32_32x32x16_bf16(kf[0],qr[0],C0,0,0,0), P0[2],P0[3],P0[4],P0[5],     pw0[0]=PKW(P0,0), pw0[1]=PKW(P0,2), pw0); \
    VRD(4); SBAR(); GAPA(C1=__builtin_amdgcn_mfma_f32_32x32x16_bf16(kf[1],qr[0],C1,0,0,0), P0[6],P0[7],P0[8],P0[9],     pw0[2]=PKW(P0,4), pw0[3]=PKW(P0,6), pw0); \
    VRD(1); SBAR(); GAPA(C0=__builtin_amdgcn_mfma_f32_32x32x16_bf16(kf[2],qr[1],C0,0,0,0),   P0[10],P0[11],P0[12],P0[13], pw1[0]=PKW(P0,8), pw1[1]=PKW(P0,10), pw1); \
    VRD(5); SBAR(); GAPA(C1=__builtin_amdgcn_mfma_f32_32x32x16_bf16(kf[3],qr[1],C1,0,0,0),   P0[14],P0[15],P1[0],P1[1],   pw1[2]=PKW(P0,12),pw1[3]=PKW(P0,14), pw1); \
    VRD(2); SBAR(); GAPA(C0=__builtin_amdgcn_mfma_f32_32x32x16_bf16(kf[4],qr[2],C0,0,0,0),   P1[2],P1[3],P1[4],P1[5],     pw2[0]=PKW(P1,0), pw2[1]=PKW(P1,2), pw2); \
    VRD(6); SBAR(); GAPA(C1=__builtin_amdgcn_mfma_f32_32x32x16_bf16(kf[5],qr[2],C1,0,0,0),   P1[6],P1[7],P1[8],P1[9],     pw2[2]=PKW(P1,4), pw2[3]=PKW(P1,6), pw2); \
    VRD(3); SBAR(); GAPA(C0=__builtin_amdgcn_mfma_f32_32x32x16_bf16(kf[6],qr[3],C0,0,0,0),   P1[10],P1[11],P1[12],P1[13], pw3[0]=PKW(P1,8), pw3[1]=PKW(P1,10), pw3); \
    VRD(7); SBAR(); GAPA(C1=__builtin_amdgcn_mfma_f32_32x32x16_bf16(kf[7],qr[3],C1,0,0,0),   P1[14],P1[15],0.f,0.f,       pw3[2]=PKW(P1,12),pw3[3]=PKW(P1,14), pw3); \
    l_reg+=sacc; \
    if(GK){DMA_K((t)+3,sl_cur);} if(GV){DMA_V((t)+1,sl_next);} \
    CMASK(C0,C1,t); \
    { float a=MX3(C0[0],C0[1],C1[0]),b=MX3(C0[2],C0[3],C1[1]); a=MX3(a,C1[2],C1[3]); \
      _Pragma("unroll") for(int r=4;r<16;r+=4){a=MX3(a,C0[r],C0[r+1]);b=MX3(b,C0[r+2],C0[r+3]);a=MX3(a,C1[r],C1[r+1]);b=MX3(b,C1[r+2],C1[r+3]);} \
      float rm=__builtin_fmaxf(a,b); { auto rr=__builtin_amdgcn_permlane32_swap(__float_as_uint(rm),__float_as_uint(rm),false,false); rm=__builtin_fmaxf(__uint_as_float(rr[0]),__uint_as_float(rr[1])); } \
      resc=false; \
      if(__builtin_expect(__any(rm>(float)THRL),0)){ const float dl=__builtin_fmaxf(rm,0.f); mhat+=dl; \
        _Pragma("unroll") for(int r=0;r<16;++r){C0[r]-=dl;C1[r]-=dl;} \
        const float f=__builtin_amdgcn_exp2f(-dl); l_reg*=f; if(hi==0)wsf[r32]=f; resc=true; } } \
    SBAR(); \
    GAPB(o[0]=__builtin_amdgcn_mfma_f32_32x32x16_bf16(PAF(0),VFR(0),o[0],0,0,0), C0,0); \
    GAPB(o[1]=__builtin_amdgcn_mfma_f32_32x32x16_bf16(PAF(0),VFR(4),o[1],0,0,0), C0,4); \
    KRD(GL,0); GAPB(o[0]=__builtin_amdgcn_mfma_f32_32x32x16_bf16(PAF(1),VFR(1),o[0],0,0,0), C0,8); \
    KRD(GL,1); GAPB(o[1]=__builtin_amdgcn_mfma_f32_32x32x16_bf16(PAF(1),VFR(5),o[1],0,0,0), C0,12); \
    KRD(GL,2); GAPB(o[0]=__builtin_amdgcn_mfma_f32_32x32x16_bf16(PAF(2),VFR(2),o[0],0,0,0), C1,0); \
    KRD(GL,3); GAPB(o[1]=__builtin_amdgcn_mfma_f32_32x32x16_bf16(PAF(2),VFR(6),o[1],0,0,0), C1,4); \
    GAPB(o[0]=__builtin_amdgcn_mfma_f32_32x32x16_bf16(PAF(3),VFR(3),o[0],0,0,0), C1,8); \
    GAPB(o[1]=__builtin_amdgcn_mfma_f32_32x32x16_bf16(PAF(3),VFR(7),o[1],0,0,0), C1,12); \
    if((t)+1<NT){ BIASLD(P0,P1,(t)+1); } \
    }while(0)
  int t=1;
  #undef CMASK
  #define CMASK(P0,P1,t) do{}while(0)
  for(;t+5<NT;t+=2){
    STEP(pB0,pB1,pA0,pA1,t,true,true,true);     WAIT_BAR(2); RESC(); ROT();
    STEP(pA0,pA1,pB0,pB1,t+1,true,true,true);   WAIT_BAR(2); RESC(); ROT();
  }
  #undef CMASK
  #define CMASK(P0,P1,t) do{int jb_=(t)-(NT-4); if(jb_>=0)cmask(P0,P1,jb_,qrel,hi);}while(0)
  #define ENDW(tt) do{ if((tt)+3<NT){WAIT_BAR(2);} else if((tt)+2<NT){WAIT_BAR(1);} else {WAIT_BAR(0);} }while(0)
  for(;t+1<NT;t+=2){
    STEP(pB0,pB1,pA0,pA1,t,(t+3<NT),(t+1<NT),(t+1<NT));       ENDW(t);   RESC(); ROT();
    STEP(pA0,pA1,pB0,pB1,t+1,(t+4<NT),(t+2<NT),(t+2<NT));     ENDW(t+1); RESC(); ROT();
  }
  STEP(pB0,pB1,pA0,pA1,NT-1,false,false,false); RESC();
  { float sacc=pB0[0]+pB0[1]; _Pragma("unroll") for(int r=2;r<16;++r)sacc+=pB0[r]; _Pragma("unroll") for(int r=0;r<16;++r)sacc+=pB1[r]; l_reg+=sacc;
    pw0=(u32x4){PKW(pB0,0),PKW(pB0,2),PKW(pB0,4),PKW(pB0,6)};pw1=(u32x4){PKW(pB0,8),PKW(pB0,10),PKW(pB0,12),PKW(pB0,14)};pw2=(u32x4){PKW(pB1,0),PKW(pB1,2),PKW(pB1,4),PKW(pB1,6)};pw3=(u32x4){PKW(pB1,8),PKW(pB1,10),PKW(pB1,12),PKW(pB1,14)};
    SBAR(); pv(o,vb0+sl_cur,PAF(0),PAF(1),PAF(2),PAF(3)); }
  #undef PKW
  #undef PAF
  #undef VFR
  #undef PIN
  #undef MX3
  #undef GAPA
  #undef GAPB
  #undef EX
  #undef VRD
  #undef KRD
  #undef STEP
  #undef ENDW
  {auto rr=__builtin_amdgcn_permlane32_swap(__float_as_uint(l_reg),__float_as_uint(l_reg),false,false);l_reg=__uint_as_float(rr[0])+__uint_as_float(rr[1]);}
  if(hi==0)wsf[32+r32]=l_reg;asm volatile("s_waitcnt lgkmcnt(0)":::"memory");
  float rli[16];
  #pragma unroll
  for(int r=0;r<16;++r)rli[r]=__builtin_amdgcn_rcpf(wsf[32+crow(r,hi)]);
  bf16*Ow=O+(rowbase+q0+wid*QBLK)*OP+h*D;
  { bf16*stg=(bf16*)(shm+LDS_OST)+wid*2048;
    #pragma unroll
    for(int r=0;r<16;++r){const int orow=crow(r,hi);
      #pragma unroll
      for(int d0=0;d0<2;++d0)stg[orow*64+d0*32+r32]=__float2bfloat16(o[d0][r]*rli[r]);}
    asm volatile("s_waitcnt lgkmcnt(0)":::"memory");
    #pragma unroll
    for(int i=0;i<4;++i){const int row=i*8+(lane>>3),ch=lane&7; const u32x4 v=*(const u32x4*)(stg+row*64+ch*8); ATTN_STORE16(Ow+(long)row*OP+ch*8,v);} }
  asm volatile("s_waitcnt lgkmcnt(0)\n\ts_barrier":::"memory");
  #undef DMA_K
  #undef DMA_V
  #undef BIASLD
  #undef CMASK
  #undef START
  #undef RESC
  #undef ROT
}
constexpr int ATTN_LDS_BYTES=LDS_BYTES;
#undef SBAR
#undef WAIT_BAR
}


constexpr size_t MiB = 1u << 20;
constexpr size_t WS_CTL = 0, CTL_ZERO_BYTES = 1 * MiB;
constexpr size_t WS_WSMALL = 1 * MiB;
constexpr size_t WL_WIN = 0, WL_LORA = 18 * MiB, WL_BR = WL_LORA + 768 * 1024, WL_WOUT = WL_BR + 4 * MiB, WL_STRIDE = WL_WOUT + 2 * MiB;
constexpr size_t WS_WEXP = 100 * MiB;
constexpr size_t WS_PMIX = 196 * MiB;
constexpr size_t WS_MISC = 564 * MiB;
constexpr size_t WS_PGATE = 568 * MiB;
constexpr size_t WS_RA = 760 * MiB;
constexpr size_t WS_RB = 888 * MiB;
constexpr size_t WS_ROUTE = 1016 * MiB;
constexpr size_t WS_END = 1024 * MiB;
static_assert(WS_WSMALL + 4 * WL_STRIDE <= WS_WEXP, "small weights");
constexpr size_t WS_MERGED = WS_PMIX;
constexpr size_t WS_X1 = WS_RA;
constexpr size_t WS_LIN = WS_RA, WS_LOUT = WS_RA + 16 * MiB, WS_CK = WS_RA + 112 * MiB, WS_SSQ = WS_RA + 113 * MiB;
constexpr size_t WS_DTCS = WS_RA + 115 * MiB;
constexpr size_t WS_HALO = WS_ROUTE + 1 * MiB;
constexpr int CW_QUEUE = 12288;
constexpr size_t WS_OR = WS_RB, WS_OF = WS_RB + 32 * MiB, WS_OM0 = WS_RB + 64 * MiB, WS_OM1 = WS_RB + 96 * MiB, WS_XB = WS_RB;
constexpr size_t WS_GATEW = WS_ROUTE, WS_CNT = WS_ROUTE + 512 * 1024;
constexpr size_t WS_POS = WS_ROUTE + 256 * 1024;
constexpr size_t WS_ROWTOK = WS_ROUTE + 6 * MiB;
constexpr size_t WS_TAB = WS_ROUTE + 768 * 1024;
constexpr int MPAD = 73728;
constexpr size_t WS_XG = 196 * MiB, WS_H = 340 * MiB, WS_YS = 412 * MiB;
constexpr size_t WEXP_GU = 0, WEXP_D = 64 * MiB;
constexpr int CW_BAR = 1024;
constexpr int CW_CNT = 16384, CNT_STRIDE = 32;

constexpr int RING_OFF = 0, RING_BYTES = 131072;
constexpr int LDS_BYTES = 147456;
constexpr int LDSCTL_OFF = LDS_BYTES - 4096, MISC_OFF = LDSCTL_OFF;
constexpr int LTOK_OFF = RING_OFF + RING_BYTES, LTOK_UNITS = 11;
static_assert(LTOK_OFF + LTOK_UNITS * 1024 <= LDSCTL_OFF, "ltok");
constexpr int LTAB_OFF = LDSCTL_OFF + 256;
constexpr int ROUTER_LD = 1028;
static_assert(NEXP * ROUTER_LD * 4 <= LDSCTL_OFF, "router table");
constexpr int NWAVES = 8;

__device__ __forceinline__ void tr_item(const float* W, size_t ldw, int k0, int srccol, bf16* WT, size_t Kd, int drow0, int dk0, LAS float* scr, int lane, const float* kscale = nullptr) {
#pragma unroll 8
    for (int i = 0; i < 32; ++i) { const int kk = 2 * i + (lane >> 5); float wv = srccol >= 0 ? W[(size_t)(k0 + kk) * ldw + srccol] : 0.f; if (kscale) wv *= kscale[k0 + kk]; scr[kk * 33 + (lane & 31)] = wv; }
    LDS_WAIT(); asm volatile("" ::: "memory");
    const int c = lane & 7;
#pragma unroll
    for (int j = 0; j < 4; ++j) { const int n = (lane >> 3) + 8 * j; const LAS float* s = scr + (8 * c) * 33 + n;
        v4u o; o.x = pk2(s[0 * 33], s[1 * 33]); o.y = pk2(s[2 * 33], s[3 * 33]); o.z = pk2(s[4 * 33], s[5 * 33]); o.w = pk2(s[6 * 33], s[7 * 33]);
        *(GAS v4u*)(WT + (size_t)(drow0 + n) * Kd + dk0 + 8 * c) = o; }
    LDS_WAIT(); asm volatile("" ::: "memory");
}
__device__ __forceinline__ void tr4_load(f32x4 (&v)[8], const float* W, size_t ldw, int k0, int n0, int lane, const float* kscale) {
    const int rr = lane >> 3, c4 = (lane & 7) * 4;
#pragma unroll
    for (int i = 0; i < 8; ++i) v[i] = *(const GAS f32x4*)(W + (size_t)(k0 + 8 * i + rr) * ldw + n0 + c4);
    if (kscale) {
#pragma unroll
        for (int i = 0; i < 8; ++i) v[i] = v[i] * kscale[k0 + 8 * i + rr]; }
}
__device__ __forceinline__ void tr4_store(const f32x4 (&v)[8], bf16* WT, size_t Kd, int drow0, int dk0, LAS float* scr, int lane) {
    const int rr = lane >> 3, c4 = (lane & 7) * 4;
#pragma unroll
    for (int i = 0; i < 8; ++i) { LAS float* d = scr + (8 * i + rr) * 33 + c4; d[0] = v[i].x; d[1] = v[i].y; d[2] = v[i].z; d[3] = v[i].w; }
    LDS_WAIT(); asm volatile("" ::: "memory");
    const int c = lane & 7;
#pragma unroll
    for (int j = 0; j < 4; ++j) { const int n = (lane >> 3) + 8 * j; const LAS float* sp = scr + (8 * c) * 33 + n;
        v4u o; o.x = pk2(sp[0 * 33], sp[1 * 33]); o.y = pk2(sp[2 * 33], sp[3 * 33]); o.z = pk2(sp[4 * 33], sp[5 * 33]); o.w = pk2(sp[6 * 33], sp[7 * 33]);
        *(GAS v4u*)(WT + (size_t)(drow0 + n) * Kd + dk0 + 8 * c) = o; }
    LDS_WAIT(); asm volatile("" ::: "memory");
}
__device__ __forceinline__ void tr_item4(const float* W, size_t ldw, int k0, int n0, bf16* WT, size_t Kd, int drow0, int dk0, LAS float* scr, int lane, const float* kscale = nullptr) {
    f32x4 v[8]; tr4_load(v, W, ldw, k0, n0, lane, kscale); tr4_store(v, WT, Kd, drow0, dk0, scr, lane);
}
__device__ __forceinline__ int win_srccol(int r) { return r < 3328 ? r : r < 5888 ? r + 8 : r < 5896 ? r - 2560 : r < 5912 ? r : r < 6144 ? -1 : r - 232; }

__device__ __forceinline__ unsigned char* opaque_ptr(unsigned char* p) { GAS unsigned char* g = (GAS unsigned char*)p; asm volatile("" : "+s"(g)); return (unsigned char*)g; }
__device__ __forceinline__ int lane_id() { int x; asm volatile("v_mbcnt_lo_u32_b32 %0, -1, 0\n\tv_mbcnt_hi_u32_b32 %0, -1, %0" : "=v"(x)); return x; }
__device__ __forceinline__ float shfl_f(float v, int src) { return __int_as_float(__builtin_amdgcn_ds_bpermute(src << 2, __float_as_int(v))); }
__device__ __forceinline__ int shfl_i(int v, int src) { return __builtin_amdgcn_ds_bpermute(src << 2, v); }
__device__ __forceinline__ float shx(float v, int m, int lane) { return shfl_f(v, lane ^ m); }
template <int CTRL> __device__ __forceinline__ float dpp_f(float v) { return __builtin_bit_cast(float, __builtin_amdgcn_update_dpp(0, __builtin_bit_cast(int, v), CTRL, 0xF, 0xF, false)); }
__device__ __forceinline__ float sum8(float v) { v += dpp_f<0xB1>(v); v += dpp_f<0x4E>(v); v += dpp_f<0x141>(v); return v; }
__device__ __forceinline__ float sum16(float v) { v = sum8(v); v += dpp_f<0x140>(v); return v; }
template <int CTRL, int RMASK> __device__ __forceinline__ float dpp_fm(float v) { return __builtin_bit_cast(float, __builtin_amdgcn_update_dpp(0, __builtin_bit_cast(int, v), CTRL, RMASK, 0xF, true)); }
__device__ __forceinline__ float wave_scan(float v) {
    v += dpp_fm<0x111, 0xF>(v); v += dpp_fm<0x112, 0xF>(v); v += dpp_fm<0x114, 0xF>(v); v += dpp_fm<0x118, 0xF>(v);
    v += __builtin_bit_cast(float, __builtin_amdgcn_update_dpp(0, __builtin_bit_cast(int, v), 0x142, 0xA, 0xF, false));
    v += __builtin_bit_cast(float, __builtin_amdgcn_update_dpp(0, __builtin_bit_cast(int, v), 0x143, 0xC, 0xF, false));
    return v;
}
__device__ __forceinline__ float wsum(float v, int lane) {
    v = sum16(v); (void)lane;
    const float r0 = __builtin_bit_cast(float, __builtin_amdgcn_readlane(__builtin_bit_cast(int, v), 0)), r1 = __builtin_bit_cast(float, __builtin_amdgcn_readlane(__builtin_bit_cast(int, v), 16));
    const float r2 = __builtin_bit_cast(float, __builtin_amdgcn_readlane(__builtin_bit_cast(int, v), 32)), r3 = __builtin_bit_cast(float, __builtin_amdgcn_readlane(__builtin_bit_cast(int, v), 48));
    return (r0 + r1) + (r2 + r3);
}
#define LBAR() asm volatile("s_waitcnt lgkmcnt(0)\n\ts_barrier" ::: "memory")
#define PHASE_IDS const int wave = opaque_int(wave0), lane = lane_id(), tid = wave * 64 + lane; const int G = opaque_int((int)gridDim.x), bx = opaque_int((int)blockIdx.x); \
    const int vcu = (G % 8 == 0) ? (bx % 8) * (G / 8) + bx / 8 : bx; const int gw = vcu * NWAVES + wave, NGW = G * NWAVES; LAS float* scr = (LAS float*)(lds + RING_OFF + wave * 16384); (void)tid; (void)gw; (void)NGW; (void)scr; (void)lane
struct Args;
__device__ __forceinline__ int opaque_int(int i) { asm volatile("" : "+s"(i)); return i; }
struct Args { const float* in[N_IN]; float* out; unsigned char* ws; int prologue, l_lo, l_hi, ph_lo, ph_hi, pad; };
enum { PH_EXPW = 0, PH_INPROJ = 1, PH_PREP = 2, PH_LORA = 3, PH_MIX = 4, PH_FIN = 5, PH_MERGE = 6, PH_WOUT = 7, PH_LN1 = 8, PH_DISPATCH = 9, PH_GU = 10, PH_DOWN = 11, PH_LN2 = 12, PH_COUNT = 13 };

__global__ void __launch_bounds__(NWAVES * 64, 2) mk_fwd(Args a) {
    extern __shared__ __attribute__((aligned(16))) unsigned char lds_raw[];
    LAS unsigned char* lds = (LAS unsigned char*)lds_raw;
    const int wave0 = __builtin_amdgcn_readfirstlane((int)threadIdx.x >> 6);
    const int wave = wave0, lane = lane_id(), tid = wave * 64 + lane;
    const int G = gridDim.x; const int bx = blockIdx.x; const int vcu = (G % 8 == 0) ? (bx % 8) * (G / 8) + bx / 8 : bx;
    unsigned char* ws = a.ws;
    for (int u = tid; u < (LDS_BYTES - LDSCTL_OFF) / 4; u += NWAVES * 64) ((LAS unsigned*)(lds + LDSCTL_OFF))[u] = 0u;
    __syncthreads();
    const bool one_launch = a.prologue && (a.l_hi - a.l_lo) * (a.ph_hi - a.ph_lo) > 1;
    unsigned bar_x = 0u;
    if (one_launch) bar_x = xcd_barrier_post((unsigned*)(a.ws + WS_CTL) + CW_BAR, (volatile LAS unsigned*)(lds + MISC_OFF) + 8).x;
#define SEAM() do { if (a.prologue && (a.l_hi - a.l_lo) * (a.ph_hi - a.ph_lo) > 1) { XcdBarrier b2_; b2_.bar = (unsigned*)(opaque_ptr(a.ws) + WS_CTL) + CW_BAR; b2_.x = (unsigned)opaque_int((int)bar_x); b2_.st = (volatile LAS unsigned*)(lds + MISC_OFF) + 8; xcd_barrier(b2_); } } while (0)
    const int gw = vcu * NWAVES + wave, NGW = G * NWAVES;
    LAS float* scr = (LAS float*)(lds + RING_OFF + wave * 16384);

    if (a.prologue) {
        constexpr int I_WINI = 16 * 280, I_BRI = 8 * 32, I_WOI = 16 * 32, I_LAYER = I_WINI + 4 * I_BRI + I_WOI;
        auto dsc = [&](int it, const float*& W, size_t& ldw, int& k0, int& n0, bf16*& WT, size_t& Kd, int& drow0, int& dk0, const float*& ks) {
            const int l = it / I_LAYER; int r = it % I_LAYER; unsigned char* wl = ws + WS_WSMALL + (size_t)l * WL_STRIDE; ks = nullptr;
            if (r < I_WINI) { const int kb = r / 280, q = r % 280, nb = q < 184 ? q : q + 8;
                W = a.in[opaque_int(I_WIN)] + (size_t)l * D * IN_COLS; ldw = IN_COLS; k0 = 64 * kb; n0 = win_srccol(32 * nb); WT = (bf16*)(wl + WL_WIN); Kd = 1024; drow0 = 32 * nb; dk0 = 64 * kb; return; }
            r -= I_WINI;
            if (r < 4 * I_BRI) { const int sg = r / I_BRI, q = r % I_BRI, kb = q / 32, nb = q % 32;
                W = sg == 0 ? a.in[opaque_int(I_BRR)] + (size_t)l * 512 * D : sg == 1 ? a.in[opaque_int(I_BRF)] + (size_t)l * 512 * D : a.in[opaque_int(I_BRM)] + (size_t)l * 1024 * D + (size_t)(sg - 2) * 512 * D;
                ldw = D; k0 = 64 * kb; n0 = 32 * nb; WT = (bf16*)(wl + WL_BR + (size_t)sg * MiB); Kd = 512; drow0 = 32 * nb; dk0 = 64 * kb;
                if (sg >= 2) ks = a.in[I_NG] + (size_t)l * SSM_DIM + (size_t)(sg - 2) * 512; return; }
            r -= 4 * I_BRI;
            { const int kb = r / 32, nb = r % 32;
              W = a.in[opaque_int(I_WO)] + (size_t)l * D * D; ldw = D; k0 = 64 * kb; n0 = 32 * nb; WT = (bf16*)(wl + WL_WOUT); Kd = 1024; drow0 = 32 * nb; dk0 = 64 * kb; }
        };
        for (int it = gw; it < DEPTH * I_LAYER; it += 2 * NGW) {
            const float *W0, *W1, *ks0, *ks1; size_t ldw0, ldw1, Kd0, Kd1; int k00, k01, n00, n01, dr0, dr1, dk00, dk01; bf16 *WT0, *WT1;
            const bool two = it + NGW < DEPTH * I_LAYER;
            dsc(it, W0, ldw0, k00, n00, WT0, Kd0, dr0, dk00, ks0); dsc(two ? it + NGW : it, W1, ldw1, k01, n01, WT1, Kd1, dr1, dk01, ks1);
            f32x4 v0[8], v1[8];
            tr4_load(v0, W0, ldw0, k00, n00, lane, ks0); tr4_load(v1, W1, ldw1, k01, n01, lane, ks1);
            tr4_store(v0, WT0, Kd0, dr0, dk00, scr, lane);
            if (two) tr4_store(v1, WT1, Kd1, dr1, dk01, scr, lane);
        }
        for (int it = gw; it < DEPTH * 16 * 8; it += NGW) { const int l = it >> 7, kb = (it >> 3) & 15, nb = 184 + (it & 7);
            tr_item(a.in[opaque_int(I_WIN)] + (size_t)l * D * IN_COLS, IN_COLS, 64 * kb, win_srccol(32 * nb + (lane & 31)), (bf16*)(ws + WS_WSMALL + (size_t)l * WL_STRIDE + WL_WIN), 1024, 32 * nb, 64 * kb, scr, lane); }
        for (int it = gw; it < DEPTH * 64; it += NGW) {
            const int l = it >> 6, r = it & 63; bf16* LT = (bf16*)(ws + WS_WSMALL + (size_t)l * WL_STRIDE + WL_LORA);
            if (r < 16) tr_item4(a.in[I_WUP] + (size_t)l * 64 * 512, 512, 0, 32 * r, LT, 256, 32 * r, 0, scr, lane);
            else if (r < 32) tr_item4(a.in[I_AUP] + (size_t)l * 64 * 512, 512, 0, 32 * (r - 16), LT, 256, 512 + 32 * (r - 16), 64, scr, lane);
            else { const int q = r - 32, kb = q >> 4, nb = q & 15; tr_item4(a.in[I_GUP] + (size_t)l * 128 * 512, 512, 64 * kb, 32 * nb, LT, 256, 1024 + 32 * nb, 128 + 64 * kb, scr, lane); }
        }
        for (int idx = gw * 64 + lane; idx < DEPTH * 1536 * 32; idx += NGW * 64) {
            const int l = idx / (1536 * 32), r = idx % (1536 * 32), n = r >> 5, k8 = (r & 31) * 8;
            const bool nz = (n < 512) ? (k8 < 64) : (n < 1024) ? (k8 >= 64 && k8 < 128) : (k8 >= 128);
            if (!nz) *(GAS v4u*)((bf16*)(ws + WS_WSMALL + (size_t)l * WL_STRIDE + WL_LORA) + (size_t)n * 256 + k8) = (v4u){0u, 0u, 0u, 0u};
        }
        for (int m = gw; m < NTOK; m += 4 * NGW) {
            f32x4 v[4][4];
#pragma unroll
            for (int u = 0; u < 4; ++u) { const int mm = (m + u * NGW < NTOK) ? m + u * NGW : m; const GAS f32x4* xr = (const GAS f32x4*)(a.in[opaque_int(I_X)] + (size_t)mm * D) + lane;
#pragma unroll
                for (int j = 0; j < 4; ++j) v[u][j] = xr[64 * j]; }
#pragma unroll
            for (int u = 0; u < 4; ++u) { if (m + u * NGW >= NTOK) break; GAS unsigned long long* o8 = (GAS unsigned long long*)((bf16*)a.out + (size_t)(m + u * NGW) * D) + lane;
#pragma unroll
                for (int j = 0; j < 4; ++j) o8[64 * j] = (unsigned long long)pk2(v[u][j].x, v[u][j].y) | ((unsigned long long)pk2(v[u][j].z, v[u][j].w) << 32); }
        }
        SEAM();
    }
#define IN(k) (opaque_int(a.ph_lo) <= (k) && (k) < opaque_int(a.ph_hi))
    for (int l = a.l_lo; l < a.l_hi; ++l) {
        if (IN(PH_PREP)) { PHASE_IDS;
            unsigned char* ws = opaque_ptr(a.ws);
            constexpr int I_G = NEXP * 16 * 16, I_D = NEXP * 8 * 32;
            for (int it = gw; it < 2 * I_G + I_D; it += NGW) {
                if (it < 2 * I_G) { const int up = it >= I_G, r = it - up * I_G, e = r >> 8, q = r & 255, kb = q >> 4, nb = q & 15, n0 = 32 * nb;
                    const float* W = (up ? a.in[opaque_int(I_EU)] : a.in[opaque_int(I_EG)]) + ((size_t)l * NEXP + e) * D * DEXP;
                    tr_item4(W, DEXP, 64 * kb, n0, (bf16*)(ws + WS_WEXP + WEXP_GU) + (size_t)e * 1024 * 1024, 1024, 256 * (n0 >> 7) + (n0 & 127) + 128 * up, 64 * kb, scr, lane);
                } else { const int r = it - 2 * I_G, e = r >> 8, q = r & 255, kb = q >> 5, nb = q & 31;
                    const float* W = a.in[opaque_int(I_ED)] + ((size_t)l * NEXP + e) * DEXP * D;
                    tr_item4(W, D, 64 * kb, 32 * nb, (bf16*)(ws + WS_WEXP + WEXP_D) + (size_t)e * 1024 * 512, 512, 32 * nb, 64 * kb, scr, lane); }
            }
            __syncthreads();
        }
        if (IN(PH_INPROJ)) { PHASE_IDS;
            unsigned char* ws = opaque_ptr(a.ws); unsigned char* wl = ws + WS_WSMALL + (size_t)l * WL_STRIDE;
            pg8::DenseOrder S; S.init(a.out, wl + WL_WIN, NTOK, NPROJ, D, G, bx);
            pg8::EpiProj E{(bf16*)(ws + WS_PMIX), (bf16*)(ws + WS_PGATE), (float*)(ws + WS_MISC), a.in[opaque_int(I_GB)] + (size_t)l * 3 * D};
            pg8::gemm_phase<pg8::EpiProj, pg8::DenseOrder, true, true>(lds + RING_OFF, D, S, E, wave0);
        }
        if (IN(PH_INPROJ)) SEAM();
        if (IN(PH_PREP)) { PHASE_IDS;
            unsigned char* ws = opaque_ptr(a.ws);
            const bf16* pmix = (const bf16*)(ws + WS_PMIX);
            { const float* mu = a.in[I_MU] + (size_t)l * RWKV_COLS + 1536 + 4 * lane; const f32x4 m4 = *(const f32x4*)mu;
              bf16* lin = (bf16*)(ws + WS_LIN);
              for (int tokp = gw; tokp < NTOK; tokp += 4 * NGW) {
                  unsigned long long cw[4], pw[4];
#pragma unroll
                  for (int u = 0; u < 4; ++u) { const int tok = (tokp + u * NGW < NTOK) ? tokp + u * NGW : tokp;
                      cw[u] = *(const unsigned long long*)(pmix + (size_t)tok * PMIX_LD + C_RW + 1536 + 4 * lane);
                      pw[u] = 0ull; if (tok % SEQ) pw[u] = *(const unsigned long long*)(pmix + (size_t)(tok - 1) * PMIX_LD + C_RW + 1536 + 4 * lane); }
#pragma unroll
                  for (int u = 0; u < 4; ++u) { const int tok = tokp + u * NGW; if (tok >= NTOK) break;
                      float c[4], q[4];
                      c[0] = __uint_as_float((unsigned)cw[u] << 16); c[1] = __uint_as_float((unsigned)cw[u] & 0xffff0000u); c[2] = __uint_as_float((unsigned)(cw[u] >> 32) << 16); c[3] = __uint_as_float((unsigned)(cw[u] >> 32) & 0xffff0000u);
                      q[0] = __uint_as_float((unsigned)pw[u] << 16); q[1] = __uint_as_float((unsigned)pw[u] & 0xffff0000u); q[2] = __uint_as_float((unsigned)(pw[u] >> 32) << 16); q[3] = __uint_as_float((unsigned)(pw[u] >> 32) & 0xffff0000u);
#pragma unroll
                      for (int i = 0; i < 4; ++i) { float x = c[i] + m4[i] * (q[i] - c[i]); if (lane < 16) x = tanhf_(x); else if (lane >= 32) x = sigmoidf_(x); c[i] = x; }
                      *(unsigned long long*)(lin + (size_t)tok * 256 + 4 * lane) = (unsigned long long)pk2(c[0], c[1]) | ((unsigned long long)pk2(c[2], c[3]) << 32); }
              } }
            if (gw < BATCH * FOX_HEADS) {
                const int b = gw >> 3, h = gw & 7; const float fb = a.in[I_FB][l * FOX_HEADS + h];
                const float* misc = (const float*)(ws + WS_MISC); float* ck = (float*)(ws + WS_CK) + (size_t)gw * SEQ;
                float carry = 0.f;
#pragma unroll 4
                for (int s0 = 0; s0 < SEQ; s0 += 64) {
                    float v = -softplusf_(-(misc[((size_t)b * SEQ + s0 + lane) * 32 + h] + fb)) * 1.4426950408889634f;
                    v = wave_scan(v) + carry; ck[s0 + lane] = v; carry = __builtin_bit_cast(float, __builtin_amdgcn_readlane(__builtin_bit_cast(int, v), 63));
                }
            }
            for (int task = gw; task < BATCH * 16 * 16; task += NGW) {
                const int c = task & 15, h = (task >> 4) & 15, bb = task >> 8;
                const float A = -__expf(a.in[opaque_int(I_ALOG)][l * SSM_HEADS + h]), dtb = a.in[opaque_int(I_DTB)][l * SSM_HEADS + h];
                const float* misc = (const float*)(ws + WS_MISC); const size_t tok0 = (size_t)bb * SEQ + c * 128;
                const float d0 = softplusf_(misc[(tok0 + 2 * lane) * 32 + 8 + h] + dtb), d1 = softplusf_(misc[(tok0 + 2 * lane + 1) * 32 + 8 + h] + dtb);
                const float a0 = d0 * A, a1 = d1 * A; const float sc = wave_scan(a0 + a1);
                *(f32x4*)((float*)(ws + WS_DTCS) + (((size_t)(bb * 16 + h) * SEQ + c * 128 + 2 * lane) * 2)) = (f32x4){d0, sc - a1, d1, sc};
            }
            { int* rowtok = (int*)(ws + WS_ROWTOK); for (int idx = gw * 64 + lane; idx < MPAD; idx += NGW * 64) rowtok[idx] = 0; }
            for (int it = gw; it < BATCH * 32 * 3; it += NGW) {
                const int bb = it / 96, r = it % 96, c = r / 3, k = r % 3;
                if (c == 0) continue;
                const bf16* src = (const bf16*)(ws + WS_PMIX) + ((size_t)bb * SEQ + c * 64 - 3 + k) * PMIX_LD + C_SX;
                bf16* dst = (bf16*)(ws + WS_HALO) + (size_t)it * SSM_CONV_DIM;
#pragma unroll
                for (int j = 0; j < 3; ++j) *((v4u*)dst + lane + 64 * j) = *((const v4u*)src + lane + 64 * j);
            }
        }
        if (IN(PH_PREP)) SEAM();
        if (IN(PH_LORA)) { PHASE_IDS;
            unsigned char* ws = opaque_ptr(a.ws); unsigned char* wl = ws + WS_WSMALL + (size_t)l * WL_STRIDE;
            pg8::DenseOrder S; S.init(ws + WS_LIN, wl + WL_LORA, NTOK, 1536, 256, G, bx);
            pg8::EpiBf16<1536> E{(bf16*)(ws + WS_LOUT)};
            pg8::gemm_phase<pg8::EpiBf16<1536>, pg8::DenseOrder, true, true>(lds + RING_OFF, 256, S, E, wave0);
            {   const int lane = lane_id(), tid = wave * 64 + lane;
                const float* cwp = a.in[opaque_int(I_CW)] + (size_t)l * 4 * SSM_CONV_DIM; const float* cbp = a.in[opaque_int(I_CB)] + (size_t)l * SSM_CONV_DIM;
                for (int task = vcu * 384 + tid; tid < 384 && task < BATCH * 16 * 384; task += G * 384) {
                    const int oc = task % 192, r = task / 192, c = r & 31, bb = r >> 5;
                    float cw[4][8], cb[8];
#pragma unroll
                    for (int i = 0; i < 8; ++i) { cb[i] = cbp[8 * oc + i];
#pragma unroll
                        for (int w = 0; w < 4; ++w) cw[w][i] = cwp[w * SSM_CONV_DIM + 8 * oc + i]; }
                    bf16* rowp = (bf16*)(ws + WS_PMIX) + ((size_t)bb * SEQ + c * 64) * PMIX_LD + C_SX + 8 * oc;
                    float w1[8], w2[8], w3[8];
                    if (c == 0) {
#pragma unroll
                        for (int i = 0; i < 8; ++i) { w1[i] = 0.f; w2[i] = 0.f; w3[i] = 0.f; } }
                    else { const bf16* hp = (const bf16*)(ws + WS_HALO) + (size_t)((bb * 32 + c) * 3) * SSM_CONV_DIM + 8 * oc;
                        pg8::unpack8(*(const pg8::u32x4*)hp, w1); pg8::unpack8(*(const pg8::u32x4*)(hp + SSM_CONV_DIM), w2); pg8::unpack8(*(const pg8::u32x4*)(hp + 2 * SSM_CONV_DIM), w3); }
                    pg8::u32x4 raw[8], nxt[8];
#pragma unroll
                    for (int j = 0; j < 8; ++j) raw[j] = *(const pg8::u32x4*)(rowp + (size_t)j * PMIX_LD);
#pragma unroll 1
                    for (int t0 = 0; t0 < 64; t0 += 8) {
                        { const int tn = (t0 + 8 < 64) ? t0 + 8 : t0;
#pragma unroll
                          for (int j = 0; j < 8; ++j) nxt[j] = *(const pg8::u32x4*)(rowp + (size_t)(tn + j) * PMIX_LD); }
#pragma unroll
                        for (int j = 0; j < 8; ++j) {
                            float w0[8], o8[8];
#pragma unroll
                            for (int i = 0; i < 8; ++i) { w0[i] = w1[i]; w1[i] = w2[i]; w2[i] = w3[i]; }
                            pg8::unpack8(raw[j], w3);
#pragma unroll
                            for (int i = 0; i < 8; ++i) o8[i] = siluf_(cb[i] + cw[0][i] * w0[i] + cw[1][i] * w1[i] + cw[2][i] * w2[i] + cw[3][i] * w3[i]);
                            pg8::u32x4 pk; pk.x = pk2(o8[0], o8[1]); pk.y = pk2(o8[2], o8[3]); pk.z = pk2(o8[4], o8[5]); pk.w = pk2(o8[6], o8[7]);
                            *(pg8::u32x4*)(rowp + (size_t)(t0 + j) * PMIX_LD) = pk;
                        }
#pragma unroll
                        for (int j = 0; j < 8; ++j) raw[j] = nxt[j];
                    }
                }
            }
        }
        if (IN(PH_LORA)) SEAM();
        if (IN(PH_MIX)) { PHASE_IDS;
            unsigned char* ws = opaque_ptr(a.ws);
            unsigned* qhead = (unsigned*)(ws + WS_CTL) + CW_QUEUE + 64 * l;
            LAS int* qslot = (LAS int*)(lds + LDSCTL_OFF + 64);
            bool first_pop = true;
            for (;;) {
                __syncthreads();
                if (tid == 0) qslot[0] = first_pop ? bx : (int)atomicAdd(qhead, 1u) + G;
                first_pop = false;
                __syncthreads();
                const int unit = __builtin_amdgcn_readfirstlane(qslot[0]);
                if (unit >= 128 + 1024 + 256) break;
                if (unit < 128) {
                    constexpr int T = 32, BUF = 8 * T * 64;
                    const int wave = opaque_int(wave0), lane = lane_id();
                    const int b = unit >> 3, h = unit & 7;
                    LAS float* L0 = (LAS float*)lds;
                    const bf16* pmix = (const bf16*)(ws + WS_PMIX); const bf16* lout = (const bf16*)(ws + WS_LOUT); bf16* o_r = (bf16*)(ws + WS_OR);
                    __syncthreads();
                    if (wave >= 4) {
                        const int a4 = wave - 4, c4 = (lane & 15) * 4, ch = h * 64 + c4, tq = lane >> 4;
                        const f32x4 mu_r = *(const f32x4*)(a.in[opaque_int(I_MU)] + (size_t)l * RWKV_COLS + ch), mu_k = *(const f32x4*)(a.in[opaque_int(I_MU)] + (size_t)l * RWKV_COLS + 512 + ch), mu_v = *(const f32x4*)(a.in[opaque_int(I_MU)] + (size_t)l * RWKV_COLS + 1024 + ch);
                        const f32x4 w0 = *(const f32x4*)(a.in[opaque_int(I_W0)] + l * 512 + ch), a0 = *(const f32x4*)(a.in[opaque_int(I_A0)] + l * 512 + ch), kkw = *(const f32x4*)(a.in[opaque_int(I_KK)] + l * 512 + ch), kaw = *(const f32x4*)(a.in[opaque_int(I_KA)] + l * 512 + ch);
                        const f32x4 rk4 = *(const f32x4*)(a.in[opaque_int(I_RK)] + l * 512 + ch), gg4 = *(const f32x4*)(a.in[opaque_int(I_GNG)] + l * 512 + ch), gb4 = *(const f32x4*)(a.in[opaque_int(I_GNB)] + l * 512 + ch);
                        auto up4 = [](unsigned long long w, float* f) { f[0] = __uint_as_float((unsigned)w << 16); f[1] = __uint_as_float((unsigned)w & 0xffff0000u); f[2] = __uint_as_float((unsigned)(w >> 32) << 16); f[3] = __uint_as_float((unsigned)(w >> 32) & 0xffff0000u); };
                        unsigned long long R[2][9];
                        auto dload = [&](int c0) {
#pragma unroll
                            for (int u = 0; u < 2; ++u) { const int tt = 16 * u + 4 * a4 + tq; const size_t tok = (size_t)b * SEQ + c0 + tt; const bf16* pc = pmix + tok * PMIX_LD + C_RW + ch; const bf16* lo = lout + tok * 1536 + ch;
                                R[u][0] = *(const unsigned long long*)pc; R[u][1] = *(const unsigned long long*)(pc + 512); R[u][2] = *(const unsigned long long*)(pc + 1024);
                                if (c0 + tt > 0) { R[u][3] = *(const unsigned long long*)(pc - PMIX_LD); R[u][4] = *(const unsigned long long*)(pc - PMIX_LD + 512); R[u][5] = *(const unsigned long long*)(pc - PMIX_LD + 1024); } else { R[u][3] = 0ull; R[u][4] = 0ull; R[u][5] = 0ull; }
                                R[u][6] = *(const unsigned long long*)lo; R[u][7] = *(const unsigned long long*)(lo + 512); R[u][8] = *(const unsigned long long*)(lo + 1024); }
                        };
                        auto dcomp = [&](LAS float* Lb_) {
                            LAS float* Lr = Lb_; LAS float* Lw = Lr + T * 64; LAS float* Lk = Lw + T * 64; LAS float* Lv = Lk + T * 64; LAS float* La = Lv + T * 64; LAS float* Lbb = La + T * 64; LAS float* Lg = Lbb + T * 64;
#pragma unroll
                            for (int u = 0; u < 2; ++u) { const int tt = 16 * u + 4 * a4 + tq;
                                float cr[4], ck_[4], cv[4], pr[4], pk[4], pv[4], lw[4], la[4], lg[4];
                                up4(R[u][0], cr); up4(R[u][1], ck_); up4(R[u][2], cv); up4(R[u][3], pr); up4(R[u][4], pk); up4(R[u][5], pv); up4(R[u][6], lw); up4(R[u][7], la); up4(R[u][8], lg);
                                float kk[4], av[4], ss = 0.f;
#pragma unroll
                                for (int i = 0; i < 4; ++i) {
                                    cr[i] += mu_r[i] * (pr[i] - cr[i]); ck_[i] += mu_k[i] * (pk[i] - ck_[i]); cv[i] += mu_v[i] * (pv[i] - cv[i]);
                                    lw[i] = __expf(-0.6065306597126334f * sigmoidf_(w0[i] + lw[i]));
                                    av[i] = sigmoidf_(a0[i] + la[i]);
                                    kk[i] = ck_[i] * kkw[i]; ss += kk[i] * kk[i];
                                }
                                ss = sum16(ss);
                                const float inv = 1.f / fmaxf(sqrtf(ss), 1e-12f);
                                f32x4 o_r4, o_w4, o_k4, o_v4, o_a4, o_b4, o_g4;
#pragma unroll
                                for (int i = 0; i < 4; ++i) { const float kkn = kk[i] * inv; o_r4[i] = cr[i]; o_w4[i] = lw[i]; o_k4[i] = ck_[i] * (1.f + (av[i] - 1.f) * kaw[i]); o_v4[i] = cv[i]; o_a4[i] = -kkn; o_b4[i] = kkn * av[i]; o_g4[i] = lg[i]; }
                                *(LAS f32x4*)(Lr + tt * 64 + c4) = o_r4; *(LAS f32x4*)(Lw + tt * 64 + c4) = o_w4; *(LAS f32x4*)(Lk + tt * 64 + c4) = o_k4; *(LAS f32x4*)(Lv + tt * 64 + c4) = o_v4;
                                *(LAS f32x4*)(La + tt * 64 + c4) = o_a4; *(LAS f32x4*)(Lbb + tt * 64 + c4) = o_b4; *(LAS f32x4*)(Lg + tt * 64 + c4) = o_g4; }
                        };
                        auto post = [&](int c0, LAS float* Lb_) {
                            LAS float* Lr = Lb_; LAS float* Lk = Lr + 2 * T * 64; LAS float* Lv = Lk + T * 64; LAS float* Lg = Lr + 6 * T * 64; LAS float* Ly = Lg + T * 64;
#pragma unroll
                            for (int u = 0; u < 2; ++u) { const int tt = 16 * u + 4 * a4 + tq; const size_t tok = (size_t)b * SEQ + c0 + tt;
                                const f32x4 y4 = *(const LAS f32x4*)(Ly + tt * 64 + c4), r4 = *(const LAS f32x4*)(Lr + tt * 64 + c4), k4 = *(const LAS f32x4*)(Lk + tt * 64 + c4), v4 = *(const LAS f32x4*)(Lv + tt * 64 + c4), g4 = *(const LAS f32x4*)(Lg + tt * 64 + c4);
                                const float mean = sum16((y4[0] + y4[1]) + (y4[2] + y4[3])) * (1.f / 64.f);
                                float d[4], q = 0.f, pb = 0.f;
#pragma unroll
                                for (int i = 0; i < 4; ++i) { d[i] = y4[i] - mean; q += d[i] * d[i]; pb += r4[i] * k4[i] * rk4[i]; }
                                const float rs = rsqrtf(sum16(q) * (1.f / 64.f) + RWKV_GN_EPS);
                                const float bonus = sum16(pb);
                                float o[4];
#pragma unroll
                                for (int i = 0; i < 4; ++i) o[i] = (d[i] * rs * gg4[i] + gb4[i] + bonus * v4[i]) * g4[i];
                                *(unsigned long long*)(o_r + tok * 512 + ch) = (unsigned long long)pk2(o[0], o[1]) | ((unsigned long long)pk2(o[2], o[3]) << 32);
                            }
                        };
                        dload(0); dcomp(L0);
                        LBAR();
                        for (int c = 0; c < SEQ / T; ++c) {
                            if (c + 1 < SEQ / T) dload((c + 1) * T);
                            if (c > 0) post((c - 1) * T, L0 + ((c - 1) & 1) * BUF);
                            if (c + 1 < SEQ / T) dcomp(L0 + ((c + 1) & 1) * BUF);
                            LBAR();
                        }
                        post(SEQ - T, L0 + ((SEQ / T - 1) & 1) * BUF);
                    } else {
                        const int rg = lane >> 3, seg = lane & 7, row0 = 16 * wave + 2 * rg;
                        typedef float f32x2 __attribute__((ext_vector_type(2)));
                        f32x2 S0[4], S1[4];
#pragma unroll
                        for (int j = 0; j < 4; ++j) { S0[j] = (f32x2){0.f, 0.f}; S1[j] = (f32x2){0.f, 0.f}; }
                        LBAR();
                        __builtin_amdgcn_s_setprio(3);
                        for (int c = 0; c < SEQ / T; ++c) {
                            LAS float* Lr = L0 + (c & 1) * BUF; LAS float* Lw = Lr + T * 64; LAS float* Lk = Lw + T * 64; LAS float* Lv = Lk + T * 64; LAS float* La = Lv + T * 64; LAS float* Lbb = La + T * 64; LAS float* Ly = Lr + 7 * T * 64;
#define RW_LOAD(P, t) do { \
                                { const f32x4 x0 = *(const LAS f32x4*)(Lw + (t) * 64 + seg * 8), x1 = *(const LAS f32x4*)(Lw + (t) * 64 + seg * 8 + 4); P##w[0] = (f32x2){x0[0], x0[1]}; P##w[1] = (f32x2){x0[2], x0[3]}; P##w[2] = (f32x2){x1[0], x1[1]}; P##w[3] = (f32x2){x1[2], x1[3]}; } \
                                { const f32x4 x0 = *(const LAS f32x4*)(La + (t) * 64 + seg * 8), x1 = *(const LAS f32x4*)(La + (t) * 64 + seg * 8 + 4); P##a[0] = (f32x2){x0[0], x0[1]}; P##a[1] = (f32x2){x0[2], x0[3]}; P##a[2] = (f32x2){x1[0], x1[1]}; P##a[3] = (f32x2){x1[2], x1[3]}; } \
                                { const f32x4 x0 = *(const LAS f32x4*)(Lbb + (t) * 64 + seg * 8), x1 = *(const LAS f32x4*)(Lbb + (t) * 64 + seg * 8 + 4); P##b[0] = (f32x2){x0[0], x0[1]}; P##b[1] = (f32x2){x0[2], x0[3]}; P##b[2] = (f32x2){x1[0], x1[1]}; P##b[3] = (f32x2){x1[2], x1[3]}; } \
                                { const f32x4 x0 = *(const LAS f32x4*)(Lk + (t) * 64 + seg * 8), x1 = *(const LAS f32x4*)(Lk + (t) * 64 + seg * 8 + 4); P##k[0] = (f32x2){x0[0], x0[1]}; P##k[1] = (f32x2){x0[2], x0[3]}; P##k[2] = (f32x2){x1[0], x1[1]}; P##k[3] = (f32x2){x1[2], x1[3]}; } \
                                { const f32x4 x0 = *(const LAS f32x4*)(Lr + (t) * 64 + seg * 8), x1 = *(const LAS f32x4*)(Lr + (t) * 64 + seg * 8 + 4); P##r[0] = (f32x2){x0[0], x0[1]}; P##r[1] = (f32x2){x0[2], x0[3]}; P##r[2] = (f32x2){x1[0], x1[1]}; P##r[3] = (f32x2){x1[2], x1[3]}; } \
                                P##v0 = Lv[(t) * 64 + row0]; P##v1 = Lv[(t) * 64 + row0 + 1]; } while (0)
#define RW_STEP(P, t) do { \
                                f32x2 d0 = S0[0] * P##a[0], d1 = S1[0] * P##a[0]; \
                                _Pragma("unroll") for (int j = 1; j < 4; ++j) { d0 = S0[j] * P##a[j] + d0; d1 = S1[j] * P##a[j] + d1; } \
                                const float sa0 = sum8(d0.x + d0.y), sa1 = sum8(d1.x + d1.y); \
                                const f32x2 sa0v = (f32x2){sa0, sa0}, sa1v = (f32x2){sa1, sa1}, v0v = (f32x2){P##v0, P##v0}, v1v = (f32x2){P##v1, P##v1}; \
                                f32x2 y0 = (f32x2){0.f, 0.f}, y1 = (f32x2){0.f, 0.f}; \
                                _Pragma("unroll") for (int j = 0; j < 4; ++j) { \
                                    S0[j] = S0[j] * P##w[j] + (sa0v * P##b[j] + v0v * P##k[j]); \
                                    S1[j] = S1[j] * P##w[j] + (sa1v * P##b[j] + v1v * P##k[j]); \
                                    y0 = S0[j] * P##r[j] + y0; y1 = S1[j] * P##r[j] + y1; } \
                                float yy0 = sum8(y0.x + y0.y), yy1 = sum8(y1.x + y1.y); asm("" : "+v"(yy0), "+v"(yy1));     \
                                if (seg == 0) { Ly[(t) * 64 + row0] = yy0; Ly[(t) * 64 + row0 + 1] = yy1; } } while (0)
                            f32x2 Aw[4], Aa[4], Ab[4], Ak[4], Ar[4], Bw[4], Ba[4], Bb[4], Bk[4], Br[4]; float Av0, Av1, Bv0, Bv1;
                            RW_LOAD(A, 0);
                            for (int t = 0; t < T; t += 2) {
                                RW_LOAD(B, t + 1);
                                RW_STEP(A, t);
                                if (t + 2 < T) RW_LOAD(A, t + 2);
                                RW_STEP(B, t + 1);
                            }
#undef RW_LOAD
#undef RW_STEP
                            LBAR();
                        }
                        __builtin_amdgcn_s_setprio(0);
                    }
                } else if (unit >= 128 + 256) {
                    const int u2 = unit - 384, qb = 7 - (u2 >> 7), bh = u2 & 127;
                    attn_body::attn_unit<8>(bh >> 3, bh & 7, qb, (const attn_body::bf16*)(ws + WS_PMIX) + C_FQ, (const attn_body::bf16*)(ws + WS_PMIX) + C_FK, (const attn_body::bf16*)(ws + WS_PMIX) + C_FV,
                                            (attn_body::bf16*)(ws + WS_OF), (const float*)(ws + WS_CK) + (size_t)bh * SEQ, (char*)lds_raw, wave0);
                } else {
                    constexpr int LD = 136, XLD = 72;
                    typedef short bf16x8 __attribute__((ext_vector_type(8))); typedef short s16x4 __attribute__((ext_vector_type(4))); typedef float f32x2_t __attribute__((ext_vector_type(2)));
                    const int wave = opaque_int(wave0), lane = lane_id(), tid = wave * 64 + lane;
                    const int u3 = unit - 128, b = u3 >> 4, h = u3 & 15, g = h >> 3;
                    LAS bf16* Cm = (LAS bf16*)lds; LAS bf16* Bm = Cm + 128 * LD; LAS bf16* Xm = Bm + 128 * LD; LAS bf16* Xw = Xm + 128 * XLD; LAS bf16* St = Xw + 128 * XLD;
                    LAS float* Fd = (LAS float*)(St + 64 * LD); LAS float* Fc = Fd + 128;
                    const bf16* pmix = (const bf16*)(ws + WS_PMIX);
                    bf16* om = (bf16*)(ws + (g ? WS_OM1 : WS_OM0)); float* ssq = (float*)(ws + WS_SSQ);
                    const float* dtcs = (const float*)(ws + WS_DTCS) + (size_t)(b * 16 + h) * SEQ * 2;
                    const float Dh = a.in[opaque_int(I_DSK)][l * SSM_HEADS + h];
                    f32x4 accS[4];
#pragma unroll
                    for (int nt = 0; nt < 4; ++nt) accS[nt] = (f32x4){0.f, 0.f, 0.f, 0.f};
                    __syncthreads();
                    for (int i = tid; i < 64 * LD / 2; i += NWAVES * 64) ((LAS unsigned*)St)[i] = 0u;
                    pg8::u32x4 tb[8], tx[2]; f32x2_t tdc = (f32x2_t){0.f, 0.f};
                    auto request = [&](int c0) { const size_t tok0 = (size_t)b * SEQ + c0; const int o_bc = tid & 31;
#pragma unroll
                        for (int j = 0; j < 8; ++j) { const int ll = (tid >> 5) + 16 * j; tb[j] = *(const pg8::u32x4*)(pmix + (tok0 + ll) * PMIX_LD + C_SX + ((o_bc < 16) ? (1024 + g * 128 + 8 * o_bc) : (1280 + g * 128 + 8 * (o_bc - 16)))); }
#pragma unroll
                        for (int j = 0; j < 2; ++j) { const int ll = (tid >> 3) + 64 * j; tx[j] = *(const pg8::u32x4*)(pmix + (tok0 + ll) * PMIX_LD + C_SX + h * 64 + 8 * (tid & 7)); }
                        if (tid < 128) tdc = *(const f32x2_t*)(dtcs + (size_t)(c0 + tid) * 2); };
                    request(0);
                    for (int c0 = 0; c0 < SEQ; c0 += 128) {
                        LBAR();
                        const int lane = lane_id(), tid = wave * 64 + lane, fr = lane & 15, fq = lane >> 4;
                        const size_t tok0 = (size_t)b * SEQ + c0;
                        { const int o_bc = tid & 31;
#pragma unroll
                          for (int j = 0; j < 8; ++j) { const int ll = (tid >> 5) + 16 * j; *(LAS pg8::u32x4*)((o_bc < 16 ? Bm : Cm) + ll * LD + 8 * (o_bc & 15)) = tb[j]; }
#pragma unroll
                          for (int j = 0; j < 2; ++j) { const int ll = (tid >> 3) + 64 * j; *(LAS pg8::u32x4*)(Xm + ll * XLD + 8 * (tid & 7)) = tx[j]; }
                          if (tid < 128) { Fd[tid] = tdc.x; Fc[tid] = tdc.y; } }
                        if (c0 + 128 < SEQ) request(c0 + 128);
                        unsigned long long zr[4];
#pragma unroll
                        for (int nt = 0; nt < 4; ++nt) zr[nt] = *(const unsigned long long*)(pmix + (tok0 + 16 * (wave < 4 ? wave : 11 - wave) + fr) * PMIX_LD + C_SZ + h * 64 + 16 * nt + 4 * fq);
                        LBAR();
                        const float cs_last = Fc[127];
#pragma unroll
                        for (int jj = 0; jj < 2; ++jj) {
                            const int idx = tid + NWAVES * 64 * jj, ll = idx >> 3, ox = idx & 7; const float wgt = __expf(cs_last - Fc[ll]) * Fd[ll];
                            float x8[8]; pg8::unpack8(*(const LAS pg8::u32x4*)(Xm + ll * XLD + 8 * ox), x8);
                            pg8::u32x4 pk; pk.x = pk2(x8[0] * wgt, x8[1] * wgt); pk.y = pk2(x8[2] * wgt, x8[3] * wgt); pk.z = pk2(x8[4] * wgt, x8[5] * wgt); pk.w = pk2(x8[6] * wgt, x8[7] * wgt);
                            *(LAS pg8::u32x4*)(Xw + ll * XLD + 8 * ox) = pk;
                        }
                        const int sbp = (int)((0x31322010u >> (4 * wave)) & 3u), lq = (int)((0x8Bu >> wave) & 1u), d0 = 2 * sbp - 4 * lq;
                        const int m1 = 32 * sbp, n1 = 64 * lq, m4 = 16 * (wave < 4 ? wave : 11 - wave);
                        f32x4 acc1[2][4];
#pragma unroll
                        for (int mt = 0; mt < 2; ++mt)
#pragma unroll
                            for (int nt = 0; nt < 4; ++nt) acc1[mt][nt] = (f32x4){0.f, 0.f, 0.f, 0.f};
                        if (d0 <= 3) {
#pragma unroll
                        for (int k0 = 0; k0 < 128; k0 += 32) {
                            bf16x8 af[2], bfv[4];
#pragma unroll
                            for (int mt = 0; mt < 2; ++mt) af[mt] = *(const LAS bf16x8*)(Bm + (m1 + 16 * mt + fr) * LD + k0 + 8 * fq);
#pragma unroll
                            for (int nt = 0; nt < 4; ++nt) bfv[nt] = *(const LAS bf16x8*)(Cm + (n1 + 16 * nt + fr) * LD + k0 + 8 * fq);
#pragma unroll
                            for (int mt = 0; mt < 2; ++mt)
#pragma unroll
                                for (int nt = 0; nt < 4; ++nt) if (nt >= d0 + mt) acc1[mt][nt] = __builtin_amdgcn_mfma_f32_16x16x32_bf16(af[mt], bfv[nt], acc1[mt][nt], 0, 0, 0);
                        }
                        }
                        f32x4 acc2[4];
#pragma unroll
                        for (int nt = 0; nt < 4; ++nt) acc2[nt] = (f32x4){0.f, 0.f, 0.f, 0.f};
#pragma unroll
                        for (int k0 = 0; k0 < 128; k0 += 32) {
                            const bf16x8 af = *(const LAS bf16x8*)(Cm + (m4 + fr) * LD + k0 + 8 * fq);
#pragma unroll
                            for (int nt = 0; nt < 4; ++nt) { const bf16x8 bfv = *(const LAS bf16x8*)(St + (16 * nt + fr) * LD + k0 + 8 * fq); acc2[nt] = __builtin_amdgcn_mfma_f32_16x16x32_bf16(bfv, af, acc2[nt], 0, 0, 0); }
                        }
                        LBAR();
                        if (d0 <= 4) {   float csl[4]; f32x4 css[2], dts[2];
#pragma unroll
                            for (int nt = 0; nt < 4; ++nt) csl[nt] = Fc[n1 + 16 * nt + fr];
#pragma unroll
                            for (int mt = 0; mt < 2; ++mt) { css[mt] = *(const LAS f32x4*)(Fc + m1 + 16 * mt + 4 * fq); dts[mt] = *(const LAS f32x4*)(Fd + m1 + 16 * mt + 4 * fq); }
#pragma unroll
                            for (int mt = 0; mt < 2; ++mt)
#pragma unroll
                                for (int nt = 0; nt < 4; ++nt) { const int ll = n1 + 16 * nt + fr, s0 = m1 + 16 * mt + 4 * fq;
                                    if (nt > d0 + mt) {
                                        float v[4];
#pragma unroll
                                        for (int r = 0; r < 4; ++r) v[r] = acc1[mt][nt][r] * __expf(csl[nt] - css[mt][r]) * dts[mt][r];
                                        *(LAS unsigned long long*)(Cm + ll * LD + s0) = (unsigned long long)pk2(v[0], v[1]) | ((unsigned long long)pk2(v[2], v[3]) << 32);
                                    } else if (nt == d0 + mt) {
                                        float v[4];
#pragma unroll
                                        for (int r = 0; r < 4; ++r) v[r] = (s0 + r <= ll) ? acc1[mt][nt][r] * __expf(csl[nt] - css[mt][r]) * dts[mt][r] + ((s0 + r == ll) ? Dh : 0.f) : 0.f;
                                        *(LAS unsigned long long*)(Cm + ll * LD + s0) = (unsigned long long)pk2(v[0], v[1]) | ((unsigned long long)pk2(v[2], v[3]) << 32);
                                    } else if (nt + 1 == d0 + mt) {
                                        *(LAS unsigned long long*)(Cm + ll * LD + s0) = 0ull;
                                    } }
                        }
                        LBAR();
                        const int q4 = (lane & 15) >> 2, p4 = lane & 3;
                        f32x4 acc3[4];
#pragma unroll
                        for (int nt = 0; nt < 4; ++nt) acc3[nt] = (f32x4){0.f, 0.f, 0.f, 0.f};
                        for (int k0 = 0; k0 < m4 + 16; k0 += 32) {
                            const bf16x8 af = *(const LAS bf16x8*)(Cm + (m4 + fr) * LD + k0 + 8 * fq);
#pragma unroll
                            for (int nt = 0; nt < 4; ++nt) {
                                const s16x4 lo = __builtin_bit_cast(s16x4, __builtin_amdgcn_ds_read_tr16_b64_v4i16((LAS s16x4*)(Xm + (k0 + 8 * fq + q4) * XLD + 16 * nt + 4 * p4)));
                                const s16x4 hi = __builtin_bit_cast(s16x4, __builtin_amdgcn_ds_read_tr16_b64_v4i16((LAS s16x4*)(Xm + (k0 + 8 * fq + 4 + q4) * XLD + 16 * nt + 4 * p4)));
                                const bf16x8 bfv = (bf16x8){lo[0], lo[1], lo[2], lo[3], hi[0], hi[1], hi[2], hi[3]};
                                acc3[nt] = __builtin_amdgcn_mfma_f32_16x16x32_bf16(bfv, af, acc3[nt], 0, 0, 0);
                            }
                        }
                        { const float dec = __expf(cs_last);
#pragma unroll
                          for (int nt = 0; nt < 4; ++nt) accS[nt] = accS[nt] * dec; }
#pragma unroll
                        for (int k0 = 0; k0 < 128; k0 += 32) {
                            const s16x4 alo = __builtin_bit_cast(s16x4, __builtin_amdgcn_ds_read_tr16_b64_v4i16((LAS s16x4*)(Bm + (k0 + 8 * fq + q4) * LD + m4 + 4 * p4)));
                            const s16x4 ahi = __builtin_bit_cast(s16x4, __builtin_amdgcn_ds_read_tr16_b64_v4i16((LAS s16x4*)(Bm + (k0 + 8 * fq + 4 + q4) * LD + m4 + 4 * p4)));
                            const bf16x8 af = (bf16x8){alo[0], alo[1], alo[2], alo[3], ahi[0], ahi[1], ahi[2], ahi[3]};
#pragma unroll
                            for (int nt = 0; nt < 4; ++nt) {
                                const s16x4 lo = __builtin_bit_cast(s16x4, __builtin_amdgcn_ds_read_tr16_b64_v4i16((LAS s16x4*)(Xw + (k0 + 8 * fq + q4) * XLD + 16 * nt + 4 * p4)));
                                const s16x4 hi = __builtin_bit_cast(s16x4, __builtin_amdgcn_ds_read_tr16_b64_v4i16((LAS s16x4*)(Xw + (k0 + 8 * fq + 4 + q4) * XLD + 16 * nt + 4 * p4)));
                                const bf16x8 bfv = (bf16x8){lo[0], lo[1], lo[2], lo[3], hi[0], hi[1], hi[2], hi[3]};
                                accS[nt] = __builtin_amdgcn_mfma_f32_16x16x32_bf16(af, bfv, accS[nt], 0, 0, 0);
                            }
                        }
                        {   const int ll = m4 + fr; const size_t tok = tok0 + ll; const float ecs = __expf(Fc[ll]);
                            float s2 = 0.f;
#pragma unroll
                            for (int nt = 0; nt < 4; ++nt) {
                                const float z4[4] = {__uint_as_float((unsigned)zr[nt] << 16), __uint_as_float((unsigned)zr[nt] & 0xffff0000u), __uint_as_float((unsigned)(zr[nt] >> 32) << 16), __uint_as_float((unsigned)(zr[nt] >> 32) & 0xffff0000u)};
                                float v[4];
#pragma unroll
                                for (int r = 0; r < 4; ++r) { const float y = acc3[nt][r] + ecs * acc2[nt][r]; v[r] = y * siluf_(z4[r]); s2 += v[r] * v[r]; }
                                *(unsigned long long*)(om + tok * 512 + (h & 7) * 64 + 16 * nt + 4 * fq) = (unsigned long long)pk2(v[0], v[1]) | ((unsigned long long)pk2(v[2], v[3]) << 32);
                            }
                            s2 += shx(s2, 16, lane); s2 += shx(s2, 32, lane);
                            if (fq == 0) ssq[tok * 16 + h] = s2;
                        }
#pragma unroll
                        for (int nt = 0; nt < 4; ++nt) *(LAS unsigned long long*)(St + (16 * nt + fr) * LD + m4 + 4 * fq) = (unsigned long long)pk2(accS[nt][0], accS[nt][1]) | ((unsigned long long)pk2(accS[nt][2], accS[nt][3]) << 32);
                    }
                }
            }
        }
        if (IN(PH_MIX)) SEAM();
        if (IN(PH_MERGE)) { PHASE_IDS;
            unsigned char* ws = opaque_ptr(a.ws); unsigned char* wl = ws + WS_WSMALL + (size_t)l * WL_STRIDE;
            pg8::MergeOrder S; S.tm.init(NTOK, D, G, bx); S.tstep = (size_t)256 * 512 * 2; S.segA = 32 * MiB; S.segB = MiB;
            S.A = (const char*)(ws + WS_OR); S.Bt = (const char*)(wl + WL_BR);
            pg8::EpiMerge E{(const bf16*)(ws + WS_PGATE), (bf16*)(ws + WS_MERGED), (const float*)(ws + WS_SSQ)};
            pg8::gemm_phase<pg8::EpiMerge, pg8::MergeOrder, true, true>(lds + RING_OFF, 512, S, E, wave0);
        }
        if (IN(PH_MERGE)) SEAM();
        if (IN(PH_WOUT)) { PHASE_IDS;
            unsigned char* ws = opaque_ptr(a.ws); unsigned char* wl = ws + WS_WSMALL + (size_t)l * WL_STRIDE;
            pg8::DenseOrder S; S.init(ws + WS_MERGED, wl + WL_WOUT, NTOK, D, D, G, bx);
            pg8::EpiRes E{(const bf16*)a.out, (bf16*)(ws + WS_X1), ALPHA};
            pg8::gemm_phase<pg8::EpiRes, pg8::DenseOrder, true, true>(lds + RING_OFF, D, S, E, wave0);
        }
        if (IN(PH_WOUT)) SEAM();
        if (IN(PH_LN1)) { PHASE_IDS;
            unsigned char* ws = opaque_ptr(a.ws);
            LAS float* WT = (LAS float*)lds;
            { const float* rw = a.in[opaque_int(I_RW)];
              f32x4 rv[16];
#pragma unroll
              for (int i = 0; i < 16; ++i) rv[i] = *(const f32x4*)(rw + 4 * (tid + 512 * i));
#pragma unroll
              for (int i = 0; i < 16; ++i) { const int q = tid + 512 * i, d = q >> 3, e0 = (q & 7) * 4; LAS float* wp = WT + e0 * ROUTER_LD + d;
                  wp[0] = rv[i].x; wp[ROUTER_LD] = rv[i].y; wp[2 * ROUTER_LD] = rv[i].z; wp[3 * ROUTER_LD] = rv[i].w; } }
            __syncthreads();
            const bf16* X1 = (const bf16*)(ws + WS_X1); bf16* XBp = (bf16*)(ws + WS_XB);
            float* gatew = (float*)(ws + WS_GATEW); int* pos = (int*)(ws + WS_POS);
            unsigned* cnt = (unsigned*)(ws + WS_CTL) + CW_CNT + 1024 * l;
            const float* lg = a.in[opaque_int(I_L1G)] + (size_t)l * D; const float* lb = a.in[opaque_int(I_L1B)] + (size_t)l * D; const float* rbias = a.in[opaque_int(I_RB)];
            int me0 = 0, me1 = 0, kt = 0, tokb = gw; float mw0 = 1.f, mw1 = 1.f;
#define LN1_FLUSH() do { if (lane < kt) { const int tk_ = tokb + lane * NGW; const float inv_ = 1.f / (mw0 + mw1); \
                gatew[(size_t)tk_ * 2] = mw0 * inv_; gatew[(size_t)tk_ * 2 + 1] = mw1 * inv_; \
                const unsigned s0_ = atomicAdd(&cnt[me0 * CNT_STRIDE], 1u), s1_ = atomicAdd(&cnt[me1 * CNT_STRIDE], 1u); \
                pos[(size_t)tk_ * 2] = (int)(((unsigned)me0 << 16) | s0_); pos[(size_t)tk_ * 2 + 1] = (int)(((unsigned)me1 << 16) | s1_); } } while (0)
            for (int tokp = gw; tokp < NTOK; tokp += 2 * NGW, kt += 2) {
                if (kt == 64) { LN1_FLUSH(); kt = 0; tokb = tokp; }
                const bool two = tokp + NGW < NTOK;
                f32x4 v[2][4]; float sm[2];
#pragma unroll
                for (int u = 0; u < 2; ++u) { const int tok = (u && two) ? tokp + NGW : tokp; const bf16* row = X1 + (size_t)tok * D; sm[u] = 0.f;
#pragma unroll
                    for (int j = 0; j < 4; ++j) { const unsigned long long xw = *(const unsigned long long*)(row + 4 * lane + 256 * j);
                        v[u][j] = (f32x4){__uint_as_float((unsigned)xw << 16), __uint_as_float((unsigned)xw & 0xffff0000u), __uint_as_float((unsigned)(xw >> 32) << 16), __uint_as_float((unsigned)(xw >> 32) & 0xffff0000u)}; sm[u] += (v[u][j].x + v[u][j].y) + (v[u][j].z + v[u][j].w); } }
                float mean[2], s2[2], rstd[2];
#pragma unroll
                for (int u = 0; u < 2; ++u) mean[u] = wsum(sm[u], lane) * (1.f / D);
#pragma unroll
                for (int u = 0; u < 2; ++u) { s2[u] = 0.f;
#pragma unroll
                    for (int j = 0; j < 4; ++j) { v[u][j] = v[u][j] - mean[u]; s2[u] += (v[u][j].x * v[u][j].x + v[u][j].y * v[u][j].y) + (v[u][j].z * v[u][j].z + v[u][j].w * v[u][j].w); } }
#pragma unroll
                for (int u = 0; u < 2; ++u) rstd[u] = rsqrtf(wsum(s2[u], lane) * (1.f / D) + LN_EPS);
#pragma unroll
                for (int j = 0; j < 4; ++j) { const f32x4 g = *(const f32x4*)(lg + 4 * lane + 256 * j), b = *(const f32x4*)(lb + 4 * lane + 256 * j);
#pragma unroll
                    for (int u = 0; u < 2; ++u) v[u][j] = v[u][j] * rstd[u] * g + b; }
#pragma unroll
                for (int u = 0; u < 2; ++u) { if (u && !two) break; const int tok = tokp + u * NGW;
#pragma unroll
                    for (int j = 0; j < 4; ++j) {
                        *(unsigned long long*)(XBp + (size_t)tok * D + 4 * lane + 256 * j) = (unsigned long long)pk2(v[u][j].x, v[u][j].y) | ((unsigned long long)pk2(v[u][j].z, v[u][j].w) << 32); } }
                float p[2][32];
                typedef float f32x2r __attribute__((ext_vector_type(2)));
                f32x2r vv[4][4];
#pragma unroll
                for (int j = 0; j < 4; ++j) { vv[j][0] = (f32x2r){v[0][j].x, v[1][j].x}; vv[j][1] = (f32x2r){v[0][j].y, v[1][j].y}; vv[j][2] = (f32x2r){v[0][j].z, v[1][j].z}; vv[j][3] = (f32x2r){v[0][j].w, v[1][j].w}; }
#pragma unroll
                for (int e = 0; e < 32; ++e) { const LAS f32x4* w = (const LAS f32x4*)(WT + e * ROUTER_LD) + lane; f32x2r a01 = (f32x2r){0.f, 0.f}, b01 = (f32x2r){0.f, 0.f};
#pragma unroll
                    for (int j = 0; j < 4; ++j) { const f32x4 ww = w[64 * j];
                        a01 = vv[j][0] * (f32x2r){ww.x, ww.x} + a01; b01 = vv[j][1] * (f32x2r){ww.y, ww.y} + b01; a01 = vv[j][2] * (f32x2r){ww.z, ww.z} + a01; b01 = vv[j][3] * (f32x2r){ww.w, ww.w} + b01; }
                    a01 = a01 + b01; p[0][e] = a01.x; p[1][e] = a01.y; if ((e & 3) == 3) asm volatile("" ::: "memory"); }
#define RSTEP(N, B) _Pragma("unroll") for (int k = 0; k < (N) / 2; ++k) { _Pragma("unroll") for (int u = 0; u < 2; ++u) { const float send = (lane & (B)) ? p[u][k] : p[u][k + (N) / 2]; const float keep = (lane & (B)) ? p[u][k + (N) / 2] : p[u][k]; p[u][k] = keep + shx(send, (B), lane); } }
                RSTEP(32, 32) RSTEP(16, 16) RSTEP(8, 8) RSTEP(4, 4) RSTEP(2, 2)
#undef RSTEP
                const int e = lane & 31; const float rb_e = rbias[e]; const int gbase = lane & ~7;
#pragma unroll
                for (int u = 0; u < 2; ++u) {
                    p[u][0] += shx(p[u][0], 1, lane);
                    const float logit = shfl_f(p[u][0], 2 * (lane & 31));
                    const float aff = sigmoidf_(logit);
                    const float sel = aff + rb_e;
                    float t1 = -INFINITY, t2 = -INFINITY; int i1 = -1, i2 = -1;
#pragma unroll
                    for (int k = 0; k < 8; ++k) {
                        const float uu = shfl_f(sel, gbase + k); const int ui = (gbase + k) & 31;
                        if (uu > t1) { t2 = t1; i2 = i1; t1 = uu; i1 = ui; } else if (uu > t2) { t2 = uu; i2 = ui; }
                    }
                    const float gs = t1 + t2;
                    float best = -INFINITY; int bg = 0;
#pragma unroll
                    for (int g = 0; g < 4; ++g) { const float uu = shfl_f(gs, g * 8); if (uu > best) { best = uu; bg = g; } }
                    const int e0 = shfl_i(i1, bg * 8), e1 = shfl_i(i2, bg * 8);
                    const float w0 = shfl_f(aff, e0), w1 = shfl_f(aff, e1);
                    if (lane == kt + u && (u == 0 || two)) { me0 = e0; me1 = e1; mw0 = w0; mw1 = w1; }
                }
                if (!two) --kt;
            }
            LN1_FLUSH();
#undef LN1_FLUSH
        }
        if (IN(PH_LN1)) SEAM();
        if (IN(PH_DISPATCH)) { PHASE_IDS;
            unsigned char* ws = opaque_ptr(a.ws);
            LAS int* ltab = (LAS int*)(lds + LTAB_OFF);
            const unsigned* cnt = (const unsigned*)(ws + WS_CTL) + CW_CNT + 1024 * l;
            if (wave == 0) {
                const int c = (lane < 32) ? (int)__hip_atomic_load(cnt + (lane & 31) * CNT_STRIDE, __ATOMIC_RELAXED, __HIP_MEMORY_SCOPE_AGENT) : 0;
                const int nb = (c + 255) >> 8; int inc = nb;
#pragma unroll
                for (int o = 1; o < 64; o <<= 1) { const int u = shfl_i(inc, lane - o); if (lane >= o) inc += u; }
                const int exc = inc - nb;
                if (lane < 32) ltab[lane] = exc * 256;
                if (bx == 0) { int* tab = (int*)(ws + WS_TAB); if (lane == 31) tab[0] = inc; if (lane < 32) for (int b = 0; b < nb; ++b) tab[1 + exc + b] = lane; }
            }
            __syncthreads();
            int* pos = (int*)(ws + WS_POS); int* rowtok = (int*)(ws + WS_ROWTOK);
            for (int tok = gw * 64 + lane; tok < NTOK; tok += NGW * 64) {
                const int p0 = pos[(size_t)tok * 2], p1 = pos[(size_t)tok * 2 + 1];
                const int r0 = ltab[(p0 >> 16) & 31] + (p0 & 0xffff), r1 = ltab[(p1 >> 16) & 31] + (p1 & 0xffff);
                rowtok[r0] = tok; rowtok[r1] = tok; pos[(size_t)tok * 2] = r0; pos[(size_t)tok * 2 + 1] = r1;
            }
        }
        if (IN(PH_DISPATCH)) SEAM();
        if (IN(PH_GU) || IN(PH_DOWN)) { PHASE_IDS;
            unsigned char* ws = opaque_ptr(a.ws);
            LAS int* ltab = (LAS int*)(lds + LTAB_OFF);
            const int* tab = (const int*)(ws + WS_TAB);
            for (int i = tid; i < 1 + MPAD / 256; i += NWAVES * 64) ltab[i] = tab[i];
            __syncthreads();
            if (IN(PH_GU)) { PHASE_IDS;
                LAS int* ltok = (LAS int*)(lds + LTOK_OFF);
                pg8::GroupGatherOrder S; S.tab = ltab; S.ltok = ltok; S.A = (const char*)(ws + WS_XB); S.Bt = (const char*)(ws + WS_WEXP + WEXP_GU); S.tstepA = (size_t)256 * 1024 * 2; S.tstepB = (size_t)256 * 1024 * 2; S.estride = (size_t)1024 * 1024 * 2; S.nN = 4; S.G = G; S.c = bx;
                { const int* rowtok = (const int*)(ws + WS_ROWTOK);
                  const int nbk = __builtin_amdgcn_readfirstlane(ltab[0]);
#pragma unroll 1
                  for (int i = 0; i < LTOK_UNITS; ++i) { const int rb = ((G & 31) == 0) ? i * (G >> 2) + (bx & 7) * (G >> 5) + (bx >> 5) : (i * G + bx) >> 2;
                      if (rb >= nbk) break; if (tid < 256) ltok[256 * i + tid] = rowtok[256 * rb + tid]; }
                  __syncthreads(); }
                pg8::EpiSwiGLU E{(bf16*)(ws + WS_H)};
                pg8::gemm_phase<pg8::EpiSwiGLU, pg8::GroupGatherOrder, true, true>(lds + RING_OFF, D, S, E, wave0);
            }
        }
        if (IN(PH_GU)) SEAM();
        if (IN(PH_DOWN)) { PHASE_IDS;
            unsigned char* ws = opaque_ptr(a.ws);
            LAS int* ltab = (LAS int*)(lds + LTAB_OFF);
            pg8::GroupOrder S; S.tab = ltab; S.A = (const char*)(ws + WS_H); S.Bt = (const char*)(ws + WS_WEXP + WEXP_D); S.tstepA = (size_t)256 * 512 * 2; S.tstepB = (size_t)256 * 512 * 2; S.estride = (size_t)1024 * 512 * 2; S.nN = 4; S.G = G; S.c = bx;
            pg8::EpiBf16<1024> E{(bf16*)(ws + WS_YS)};
            pg8::gemm_phase<pg8::EpiBf16<1024>, pg8::GroupOrder, true, true>(lds + RING_OFF, DEXP, S, E, wave0);
        }
        if (IN(PH_DOWN)) SEAM();
        if (IN(PH_LN2)) { PHASE_IDS;
            unsigned char* ws = opaque_ptr(a.ws);
            const bf16* X1b = (const bf16*)(ws + WS_XB); const bf16* YS = (const bf16*)(ws + WS_YS); bf16* XBXp = (bf16*)a.out; const bool lastl = (l == DEPTH - 1);
            const float* gatew = (const float*)(ws + WS_GATEW); const int* pos = (const int*)(ws + WS_POS);
            const float* lg = a.in[opaque_int(I_L2G)] + (size_t)l * D; const float* lb = a.in[opaque_int(I_L2B)] + (size_t)l * D;
            for (int tokp = gw; tokp < NTOK; tokp += 4 * NGW) {
                f32x4 v[4][4]; float sm[4];
#pragma unroll
                for (int u = 0; u < 4; ++u) {
                    const int tok = (tokp + u * NGW < NTOK) ? tokp + u * NGW : tokp;
                    const float g0 = gatew[(size_t)tok * 2], g1 = gatew[(size_t)tok * 2 + 1];
                    const int r0 = pos[(size_t)tok * 2], r1 = pos[(size_t)tok * 2 + 1];
                    sm[u] = 0.f;
#pragma unroll
                    for (int j = 0; j < 4; ++j) {
                        const int c = 4 * lane + 256 * j;
                        const unsigned long long xw = *(const unsigned long long*)(X1b + (size_t)tok * D + c);
                        const f32x4 xv = (f32x4){__uint_as_float((unsigned)xw << 16), __uint_as_float((unsigned)xw & 0xffff0000u), __uint_as_float((unsigned)(xw >> 32) << 16), __uint_as_float((unsigned)(xw >> 32) & 0xffff0000u)};
                        const unsigned long long ya = *(const unsigned long long*)(YS + (size_t)r0 * D + c), yb = *(const unsigned long long*)(YS + (size_t)r1 * D + c);
                        const f32x4 y0 = (f32x4){__uint_as_float((unsigned)ya << 16), __uint_as_float((unsigned)ya & 0xffff0000u), __uint_as_float((unsigned)(ya >> 32) << 16), __uint_as_float((unsigned)(ya >> 32) & 0xffff0000u)};
                        const f32x4 y1 = (f32x4){__uint_as_float((unsigned)yb << 16), __uint_as_float((unsigned)yb & 0xffff0000u), __uint_as_float((unsigned)(yb >> 32) << 16), __uint_as_float((unsigned)(yb >> 32) & 0xffff0000u)};
                        v[u][j] = xv * ALPHA + (y0 * g0 + y1 * g1);
                        sm[u] += (v[u][j].x + v[u][j].y) + (v[u][j].z + v[u][j].w);
                    }
                }
                float mean[4], s2[4], rstd[4];
#pragma unroll
                for (int u = 0; u < 4; ++u) mean[u] = wsum(sm[u], lane) * (1.f / D);
#pragma unroll
                for (int u = 0; u < 4; ++u) { s2[u] = 0.f;
#pragma unroll
                    for (int j = 0; j < 4; ++j) { v[u][j] = v[u][j] - mean[u]; s2[u] += (v[u][j].x * v[u][j].x + v[u][j].y * v[u][j].y) + (v[u][j].z * v[u][j].z + v[u][j].w * v[u][j].w); } }
#pragma unroll
                for (int u = 0; u < 4; ++u) rstd[u] = rsqrtf(wsum(s2[u], lane) * (1.f / D) + LN_EPS);
#pragma unroll
                for (int u = 0; u < 4; ++u) {
                    const int tok = tokp + u * NGW; if (tok >= NTOK) break;
#pragma unroll
                    for (int j = 0; j < 4; ++j) {
                        const int c = 4 * lane + 256 * j;
                        const f32x4 g = *(const f32x4*)(lg + c), b = *(const f32x4*)(lb + c);
                        const f32x4 o = v[u][j] * rstd[u] * g + b;
                        if (lastl) *(f32x4*)(a.out + (size_t)tok * D + c) = o;
                        else *(unsigned long long*)(XBXp + (size_t)tok * D + c) = (unsigned long long)pk2(o.x, o.y) | ((unsigned long long)pk2(o.z, o.w) << 32);
                    }
                }
            }
        }
        if (IN(PH_LN2)) SEAM();
    }
#undef IN
}

#ifndef MK_ONE_LAUNCH
#define MK_ONE_LAUNCH 1
#endif
static void launch_mk(const Args& base, int grid, hipStream_t stream, int prologue, int l_lo, int l_hi, int ph_lo, int ph_hi) {
    Args a = base; a.prologue = prologue; a.l_lo = l_lo; a.l_hi = l_hi; a.ph_lo = ph_lo; a.ph_hi = ph_hi; a.pad = 0;
    hipLaunchKernelGGL(mk_fwd, dim3(grid), dim3(NWAVES * 64), LDS_BYTES, stream, a);
}
extern "C" void kernel_launch(void* const* d_in, const int* in_sizes, int n_in, void* d_out, int out_size, void* d_ws, size_t ws_size, hipStream_t stream) {
    static int grid = 0;
    if (grid == 0) {
        if (n_in != N_IN || ws_size < WS_END || out_size != NTOK * D) { fprintf(stderr, "kernel_launch: unexpected n_in %d, out_size %d or ws_size %zu\n", n_in, out_size, ws_size); grid = -1; return; }
        int dev = 0, cus = 0;
        if (hipGetDevice(&dev) != hipSuccess || hipDeviceGetAttribute(&cus, hipDeviceAttributeMultiprocessorCount, dev) != hipSuccess) { grid = -1; return; }
        if (hipFuncSetAttribute((const void*)mk_fwd, hipFuncAttributeMaxDynamicSharedMemorySize, LDS_BYTES) != hipSuccess) { fprintf(stderr, "kernel_launch: hipFuncSetAttribute failed\n"); grid = -1; return; }
        int per_cu = 0;
        if (hipOccupancyMaxActiveBlocksPerMultiprocessor(&per_cu, (const void*)mk_fwd, NWAVES * 64, LDS_BYTES) != hipSuccess || per_cu < 1) fprintf(stderr, "kernel_launch: occupancy query reports %d blocks per CU\n", per_cu);
        (void)hipGetLastError();
        grid = cus;
    }
    if (grid < 0) return;
    (void)hipMemsetAsync((char*)d_ws + WS_CTL, 0, CTL_ZERO_BYTES, stream);
    Args base{};
    for (int i = 0; i < N_IN; ++i) base.in[i] = (const float*)d_in[i];
    base.out = (float*)d_out; base.ws = (unsigned char*)d_ws;
#if MK_ONE_LAUNCH
    launch_mk(base, grid, stream, 1, 0, DEPTH, 0, PH_COUNT);
#else
    launch_mk(base, grid, stream, 1, 0, 0, 0, 0);
    for (int l = 0; l < DEPTH; ++l)
        for (int ph = 1; ph < PH_COUNT; ++ph) launch_mk(base, grid, stream, 0, l, l + 1, ph, ph + 1);
#endif
}
```

```cpp
#include <hip/hip_runtime.h>
#include <cstdio>
#include <cstdint>

constexpr int D = 1024, BATCH = 16, SEQ = 2048, DEPTH = 4, NTOK = BATCH * SEQ;
constexpr int FOX_HEADS = 8;
constexpr int SSM_DIM = 1024, SSM_HEADS = 16, SSM_CONV_DIM = 1536;
constexpr int RWKV_COLS = 1792;
constexpr int IN_COLS = 8984;
constexpr int NEXP = 32, DEXP = 512;
constexpr float ALPHA = 1.681792830507429f;
constexpr float LN_EPS = 1e-5f, NORM_EPS = 1e-5f, RWKV_GN_EPS = 64e-5f;
constexpr int PMIX_LD = 5888, PGATE_LD = 3072, NPROJ = 9216;
constexpr int C_RW = 0, C_FQ = 1792, C_FK = 2304, C_FV = 2816, C_SZ = 3328, C_SX = 4352;
enum { I_X = 0, I_WIN, I_MU, I_W0, I_WUP, I_A0, I_AUP, I_GUP, I_KK, I_KA, I_RK, I_GNG, I_GNB, I_FB, I_CW, I_CB, I_DTB, I_ALOG, I_DSK, I_NG, I_GB, I_BRR, I_BRF, I_BRM, I_WO,
       I_L1G, I_L1B, I_RW, I_RB, I_EG, I_EU, I_ED, I_L2G, I_L2B, N_IN };

typedef float f32x4 __attribute__((ext_vector_type(4)));
typedef float f32x16 __attribute__((ext_vector_type(16)));
typedef unsigned short bf16;

__device__ __forceinline__ float sigmoidf_(float x) { return __builtin_amdgcn_rcpf(1.f + __expf(-x)); }
__device__ __forceinline__ float softplusf_(float x) { const float e = __expf(-fabsf(x)); return fmaxf(x, 0.f) + __logf(1.f + e); }
__device__ __forceinline__ float siluf_(float x) { return x * __builtin_amdgcn_rcpf(1.f + __expf(-x)); }
__device__ __forceinline__ float tanhf_(float x) { const float e = __expf(-2.f * fabsf(x)); const float t = (1.f - e) * __builtin_amdgcn_rcpf(1.f + e); return x < 0.f ? -t : t; }
__device__ __forceinline__ float wave_sum(float v) {
#pragma unroll
    for (int o = 1; o < 64; o <<= 1) v += __shfl_xor(v, o);
    return v;
}
__device__ __forceinline__ float bf2f(bf16 b) { return __uint_as_float((unsigned)b << 16); }

namespace pg8 {
#define PG8_LAS __attribute__((address_space(3)))
typedef unsigned short bf16_t;
typedef short bf16x8 __attribute__((ext_vector_type(8)));
typedef float f32x4 __attribute__((ext_vector_type(4)));
typedef unsigned u32x4 __attribute__((ext_vector_type(4)));
constexpr int BM = 256, BK = 64, HALF = 128, HTB = HALF * BK * 2  , STAGE_BYTES = 8 * HTB, NXCD = 8, WGM = 8;

__host__ __device__ __forceinline__ int lds_byte(int r, int c) { const int st = (r >> 4) * 2 + (c >> 5), rr = r & 15, cc = c & 31, ob = rr * 64 + cc * 2; return st * 1024 + (ob ^ (((ob >> 9) & 1) << 5)); }
__host__ __device__ __forceinline__ void stage_rc(int b, int& R, int& C) { const int st = b / 1024, sb = b % 1024, swz = sb ^ (((sb >> 9) & 1) << 5); R = (st >> 1) * 16 + swz / 64; C = (st & 1) * 32 + (swz % 64) / 2; }
__host__ __device__ __forceinline__ int perm32(int rho) { const int n = rho >> 4, i = rho & 15; return 8 * (i >> 2) + 4 * n + (i & 3); }

#define PG8_GAS __attribute__((address_space(1)))
struct Unit { int pm, pn, pb, seg, last; };

typedef float f32x2_t __attribute__((ext_vector_type(2))); typedef __bf16 bf16x2_t __attribute__((ext_vector_type(2)));
__device__ __forceinline__ unsigned cvt_pk_bf16(float lo, float hi) { f32x2_t v = {lo, hi}; bf16x2_t b = __builtin_convertvector(v, bf16x2_t); return __builtin_bit_cast(unsigned, b); }

struct TileMap {
    int nM, nN, nwg, G, c;
    __device__ void init(int M, int N, int G_, int c_) { nM = M / BM; nN = N / BM; nwg = nM * nN; G = G_; c = c_; }
    __device__ bool tile(int i, int& pm, int& pn) const {
        const long L = (long)i * G + c; if (L >= nwg) return false;
        int wgid = (int)L; { const int q = nwg / NXCD, r = nwg % NXCD, xcd = wgid % NXCD, off = wgid / NXCD; wgid = (xcd < r ? xcd * (q + 1) : r * (q + 1) + (xcd - r) * q) + off; }
        const int nig = WGM * nN, gid = wgid / nig, fm = gid * WGM, gsz = (nM - fm) < WGM ? (nM - fm) : WGM;
        pm = fm + ((wgid % nig) % gsz); pn = (wgid % nig) / gsz; return true;
    }
};
struct DenseOrder {
    static constexpr bool GATHER = false;
    TileMap tm; const char* A; const char* Bt; size_t tstep;
    __device__ void init(const void* A_, const void* Bt_, int M, int N, int K, int G, int c) { tm.init(M, N, G, c); A = (const char*)A_; Bt = (const char*)Bt_; tstep = (size_t)BM * K * 2; }
    __device__ bool next(int i, Unit& u) const { if (!tm.tile(i, u.pm, u.pn)) return false; u.pb = 0; u.seg = 0; u.last = 1; return true; }
    __device__ __forceinline__ void addr(const Unit& u, const char*& a, const char*& b) const { a = A + (size_t)u.pm * tstep; b = Bt + (size_t)u.pn * tstep; }
    __device__ __forceinline__ void a_ready(const Unit&) const {}
    __device__ __forceinline__ void done(const Unit&) const {}
};
struct MergeOrder {
    static constexpr bool GATHER = false;
    TileMap tm; const char *A, *Bt; size_t tstep, segA, segB;
    __device__ bool next(int i, Unit& u) const { if (!tm.tile(i >> 2, u.pm, u.pn)) return false; const int sg = i & 3; u.pb = 0; u.seg = sg; u.last = (sg == 3); return true; }
    __device__ __forceinline__ void addr(const Unit& u, const char*& a, const char*& b) const { a = A + (size_t)u.seg * segA + (size_t)u.pm * tstep; b = Bt + (size_t)u.seg * segB + (size_t)u.pn * tstep; }
    __device__ __forceinline__ void a_ready(const Unit&) const {}
    __device__ __forceinline__ void done(const Unit&) const {}
};

__device__ __forceinline__ void unpack8(const u32x4 w, float (&f)[8]) {
    f[0] = __uint_as_float(w.x << 16); f[1] = __uint_as_float(w.x & 0xffff0000u); f[2] = __uint_as_float(w.y << 16); f[3] = __uint_as_float(w.y & 0xffff0000u);
    f[4] = __uint_as_float(w.z << 16); f[5] = __uint_as_float(w.z & 0xffff0000u); f[6] = __uint_as_float(w.w << 16); f[7] = __uint_as_float(w.w & 0xffff0000u);
}
__device__ __forceinline__ u32x4 pack8(const f32x4 v0, const f32x4 v1) { u32x4 w; w.x = cvt_pk_bf16(v0[0], v0[1]); w.y = cvt_pk_bf16(v0[2], v0[3]); w.z = cvt_pk_bf16(v1[0], v1[1]); w.w = cvt_pk_bf16(v1[2], v1[3]); return w; }

template <int LDC> struct EpiBf16 {
    static constexpr bool PERM = true; static constexpr int ldc = LDC;
    bf16_t* O;
    __device__ __forceinline__ void mid(f32x4 (&)[2][2][4][2], const Unit&, int, int, int, int) const {}
    __device__ __forceinline__ void operator()(const f32x4 (&acc)[2][2][4][2], const Unit& u, int wr, int wc, int fr, int fq) const {
        const int row0 = u.pm * BM + wr * 64 + fr, col0 = u.pn * BM + wc * 32 + 8 * fq;
#pragma unroll
        for (int ai = 0; ai < 2; ++ai)
#pragma unroll
            for (int m = 0; m < 4; ++m) { bf16_t* rowp = O + (size_t)(row0 + ai * HALF + m * 16) * ldc + col0;
#pragma unroll
                for (int bj = 0; bj < 2; ++bj) *(PG8_GAS u32x4*)(rowp + bj * HALF) = pack8(acc[ai][bj][m][0], acc[ai][bj][m][1]); }
    }
};
struct EpiProj {
    static constexpr bool PERM = true;
    bf16_t* pmix; bf16_t* pgate; float* misc; const float* gbias;
    __device__ __forceinline__ void mid(f32x4 (&)[2][2][4][2], const Unit&, int, int, int, int) const {}
    __device__ __forceinline__ void operator()(const f32x4 (&acc)[2][2][4][2], const Unit& u, int wr, int wc, int fr, int fq) const {
        const int row0 = u.pm * BM + wr * 64 + fr, cl = wc * 32 + 8 * fq;
        if (u.pn < 23) {
            const float sc = (u.pn == 7 || u.pn == 8) ? 0.18033688011112042f : 1.f;
#pragma unroll
            for (int ai = 0; ai < 2; ++ai)
#pragma unroll
                for (int m = 0; m < 4; ++m) { bf16_t* rowp = pmix + (size_t)(row0 + ai * HALF + m * 16) * PMIX_LD + u.pn * BM + cl;
#pragma unroll
                    for (int bj = 0; bj < 2; ++bj) *(PG8_GAS u32x4*)(rowp + bj * HALF) = pack8(acc[ai][bj][m][0] * sc, acc[ai][bj][m][1] * sc); }
        } else if (u.pn == 23) {
            if (wc == 0 && fq < 3) {
#pragma unroll
                for (int ai = 0; ai < 2; ++ai)
#pragma unroll
                    for (int m = 0; m < 4; ++m) { float* rowp = misc + (size_t)(row0 + ai * HALF + m * 16) * 32 + 8 * fq;
                        *(PG8_GAS f32x4*)rowp = acc[ai][0][m][0]; *(PG8_GAS f32x4*)(rowp + 4) = acc[ai][0][m][1]; }
            }
        } else {
            const int gc = (u.pn - 24) * BM + cl;
            f32x4 bv[2][2];
#pragma unroll
            for (int bj = 0; bj < 2; ++bj)
#pragma unroll
                for (int n = 0; n < 2; ++n) bv[bj][n] = *(const PG8_GAS f32x4*)(gbias + gc + bj * HALF + 4 * n);
#pragma unroll
            for (int ai = 0; ai < 2; ++ai)
#pragma unroll
                for (int m = 0; m < 4; ++m) { bf16_t* rowp = pgate + (size_t)(row0 + ai * HALF + m * 16) * PGATE_LD + gc;
#pragma unroll
                    for (int bj = 0; bj < 2; ++bj) { f32x4 v0 = acc[ai][bj][m][0] + bv[bj][0], v1 = acc[ai][bj][m][1] + bv[bj][1];
#pragma unroll
                        for (int i = 0; i < 4; ++i) { v0[i] = __builtin_amdgcn_rcpf(1.f + __expf(-v0[i])); v1[i] = __builtin_amdgcn_rcpf(1.f + __expf(-v1[i])); }
                        *(PG8_GAS u32x4*)(rowp + bj * HALF) = pack8(v0, v1); } }
        }
    }
};
struct EpiMerge {
    static constexpr bool PERM = true;
    const bf16_t* pgate; bf16_t* O; const float* ssq;
    __device__ __forceinline__ float rs(size_t row, int g) const { const PG8_GAS f32x4* q = (const PG8_GAS f32x4*)(ssq + row * 16 + 8 * g); const f32x4 a = q[0], b = q[1];
        return __builtin_amdgcn_rsqf((((a[0] + a[1]) + (a[2] + a[3])) + ((b[0] + b[1]) + (b[2] + b[3]))) * (1.f / 512.f) + 1e-5f); }
    __device__ __forceinline__ void ld_ssq(size_t row, int g, f32x4& a, f32x4& b) const { const PG8_GAS f32x4* q = (const PG8_GAS f32x4*)(ssq + row * 16 + 8 * g); a = q[0]; b = q[1]; }
    static __device__ __forceinline__ float rs_of(const f32x4 a, const f32x4 b) { return __builtin_amdgcn_rsqf((((a[0] + a[1]) + (a[2] + a[3])) + ((b[0] + b[1]) + (b[2] + b[3]))) * (1.f / 512.f) + 1e-5f); }
    __device__ __forceinline__ void mid(f32x4 (&acc)[2][2][4][2], const Unit& u, int wr, int wc, int fr, int fq) const {
        const int row0 = u.pm * BM + wr * 64 + fr, col0 = u.pn * BM + wc * 32 + 8 * fq;
#pragma unroll
        for (int ai = 0; ai < 2; ++ai)
#pragma unroll
            for (int m0 = 0; m0 < 4; m0 += 2) {
                if (u.seg == 2) {
#pragma unroll
                    for (int mm = 0; mm < 2; ++mm) { const int m = m0 + mm; const size_t r = (size_t)(row0 + ai * HALF + m * 16); const float f = rs(r, 0) * __builtin_amdgcn_rcpf(rs(r, 1));
#pragma unroll
                        for (int bj = 0; bj < 2; ++bj) { acc[ai][bj][m][0] = acc[ai][bj][m][0] * f; acc[ai][bj][m][1] = acc[ai][bj][m][1] * f; } }
                } else {
                    u32x4 GA[2][2], GB[2][2]; float f[2];
#pragma unroll
                    for (int mm = 0; mm < 2; ++mm) { const size_t r = (size_t)(row0 + ai * HALF + (m0 + mm) * 16); const bf16_t* gp = pgate + r * PGATE_LD + u.seg * 1024 + col0;
#pragma unroll
                        for (int bj = 0; bj < 2; ++bj) { GA[mm][bj] = *(const PG8_GAS u32x4*)(gp + bj * HALF); GB[mm][bj] = *(const PG8_GAS u32x4*)(gp + 1024 + bj * HALF); }
                        f[mm] = (u.seg == 1) ? __builtin_amdgcn_rcpf(rs(r, 0)) : 1.f; }
#pragma unroll
                    for (int mm = 0; mm < 2; ++mm) { const int m = m0 + mm;
#pragma unroll
                        for (int bj = 0; bj < 2; ++bj) { float ga[8], gb[8]; unpack8(GA[mm][bj], ga); unpack8(GB[mm][bj], gb);
#pragma unroll
                            for (int i = 0; i < 4; ++i) { acc[ai][bj][m][0][i] *= f[mm] * ga[i] * __builtin_amdgcn_rcpf(fmaxf(gb[i], 1e-20f)); acc[ai][bj][m][1][i] *= f[mm] * ga[4 + i] * __builtin_amdgcn_rcpf(fmaxf(gb[4 + i], 1e-20f)); } } }
                }
#pragma unroll
                for (int mm = 0; mm < 2; ++mm) asm volatile("" : "+v"(acc[ai][0][m0 + mm][0]), "+v"(acc[ai][0][m0 + mm][1]), "+v"(acc[ai][1][m0 + mm][0]), "+v"(acc[ai][1][m0 + mm][1]) :: "memory");
            }
    }
    __device__ __forceinline__ void operator()(const f32x4 (&acc)[2][2][4][2], const Unit& u, int wr, int wc, int fr, int fq) const {
        const int row0 = u.pm * BM + wr * 64 + fr, col0 = u.pn * BM + wc * 32 + 8 * fq;
#pragma unroll
        for (int ai = 0; ai < 2; ++ai)
#pragma unroll
            for (int m0 = 0; m0 < 4; m0 += 2) {
                u32x4 G2[2][2]; f32x4 sa[2], sb[2];
#pragma unroll
                for (int mm = 0; mm < 2; ++mm) { const size_t r = (size_t)(row0 + ai * HALF + (m0 + mm) * 16); ld_ssq(r, 1, sa[mm], sb[mm]);
#pragma unroll
                    for (int bj = 0; bj < 2; ++bj) G2[mm][bj] = *(const PG8_GAS u32x4*)(pgate + r * PGATE_LD + 2048 + col0 + bj * HALF); }
#pragma unroll
                for (int mm = 0; mm < 2; ++mm) { const int m = m0 + mm; const size_t r = (size_t)(row0 + ai * HALF + m * 16); const float f = rs_of(sa[mm], sb[mm]);
#pragma unroll
                    for (int bj = 0; bj < 2; ++bj) { float g[8]; unpack8(G2[mm][bj], g);
                        f32x4 v0 = acc[ai][bj][m][0], v1 = acc[ai][bj][m][1];
#pragma unroll
                        for (int i = 0; i < 4; ++i) { v0[i] *= f * g[i]; v1[i] *= f * g[4 + i]; }
                        *(PG8_GAS u32x4*)(O + r * 1024 + col0 + bj * HALF) = pack8(v0, v1); } }
                asm volatile("" ::: "memory");
            }
    }
};
struct EpiRes {
    static constexpr bool PERM = false;
    const bf16_t* base; bf16_t* out; float alpha;
    __device__ __forceinline__ void mid(f32x4 (&)[2][2][4][2], const Unit&, int, int, int, int) const {}
    __device__ __forceinline__ void operator()(const f32x4 (&acc)[2][2][4][2], const Unit& u, int wr, int wc, int fr, int fq) const {
        const int row0 = u.pm * BM + wr * 64 + fr, col0 = u.pn * BM + wc * 32 + 4 * fq;
#pragma unroll
        for (int ai = 0; ai < 2; ++ai)
#pragma unroll
            for (int m = 0; m < 4; ++m) { const size_t off = (size_t)(row0 + ai * HALF + m * 16) * 1024 + col0;
#pragma unroll
                for (int bj = 0; bj < 2; ++bj)
#pragma unroll
                    for (int n = 0; n < 2; ++n) { const unsigned long long bw = *(const PG8_GAS unsigned long long*)(base + off + bj * HALF + n * 16);
                        const f32x4 b = (f32x4){__uint_as_float((unsigned)bw << 16), __uint_as_float((unsigned)bw & 0xffff0000u), __uint_as_float((unsigned)(bw >> 32) << 16), __uint_as_float((unsigned)(bw >> 32) & 0xffff0000u)};
                        const f32x4 o = b * alpha + acc[ai][bj][m][n];
                        *(PG8_GAS unsigned long long*)(out + off + bj * HALF + n * 16) = (unsigned long long)cvt_pk_bf16(o[0], o[1]) | ((unsigned long long)cvt_pk_bf16(o[2], o[3]) << 32); } }
    }
};

template <bool GATHER_> struct GroupOrderT {
    static constexpr bool GATHER = GATHER_;
    const PG8_LAS int* ltok;
    __device__ __forceinline__ unsigned arow(int ui, int r) const { return (unsigned)ltok[256 * ui + r]; }
    const PG8_LAS int* tab; const char* A; const char* Bt; size_t tstepA, tstepB, estride; int nN, G, c;
    __device__ bool next(int i, Unit& u) const {
        const int nb = __builtin_amdgcn_readfirstlane(tab[0]);
        int rb, pn;
        if ((G & 31) == 0) { const int x = c & 7, j = c >> 3; rb = i * (G >> 2) + x * (G >> 5) + (j >> 2); pn = j & 3; }
        else { const int L = i * G + c; rb = L >> 2; pn = L & 3; }
        if (rb >= nb) return false;
        u.pm = rb; u.pn = pn; u.pb = __builtin_amdgcn_readfirstlane(tab[1 + rb]); u.seg = 0; u.last = 1; return true;
    }
    __device__ __forceinline__ void addr(const Unit& u, const char*& a, const char*& b) const { a = GATHER_ ? A : A + (size_t)u.pm * tstepA; b = Bt + (size_t)u.pb * estride + (size_t)u.pn * tstepB; }
    __device__ __forceinline__ void a_ready(const Unit&) const {}
    __device__ __forceinline__ void done(const Unit&) const {}
};
using GroupOrder = GroupOrderT<false>; using GroupGatherOrder = GroupOrderT<true>;
struct EpiSwiGLU {
    static constexpr bool PERM = true;
    bf16_t* H;
    __device__ __forceinline__ void mid(f32x4 (&)[2][2][4][2], const Unit&, int, int, int, int) const {}
    __device__ __forceinline__ void operator()(const f32x4 (&acc)[2][2][4][2], const Unit& u, int wr, int wc, int fr, int fq) const {
        const int row0 = u.pm * BM + wr * 64 + fr, col0 = u.pn * HALF + wc * 32 + 8 * fq;
#pragma unroll
        for (int ai = 0; ai < 2; ++ai)
#pragma unroll
            for (int m = 0; m < 4; ++m) { f32x4 h0, h1;
#pragma unroll
                for (int i = 0; i < 4; ++i) { const float g0 = acc[ai][0][m][0][i], g1 = acc[ai][0][m][1][i];
                    h0[i] = g0 * __builtin_amdgcn_rcpf(1.f + __expf(-g0)) * acc[ai][1][m][0][i]; h1[i] = g1 * __builtin_amdgcn_rcpf(1.f + __expf(-g1)) * acc[ai][1][m][1][i]; }
                *(PG8_GAS u32x4*)(H + (size_t)(row0 + ai * HALF + m * 16) * 512 + col0) = pack8(h0, h1); }
    }
};

template <class Epi, class Sched, bool ALIGN_EPI = false, bool SP2 = false>
__device__ __forceinline__ void gemm_phase(PG8_LAS unsigned char* lds, const int K, const Sched& S, const Epi& E, const int wave0) {
    int sw_ = wave0; asm volatile("" : "+s"(sw_)); int ln_; asm volatile("v_mbcnt_lo_u32_b32 %0, -1, 0\n\tv_mbcnt_hi_u32_b32 %0, -1, %0" : "=v"(ln_));
    const int tid_ = sw_ * 64 + ln_;
    const int tid = tid_, wid = __builtin_amdgcn_readfirstlane(tid >> 6), lane = tid & 63, wr = wid >> 2, wc = wid & 3, fr = lane & 15, fq = lane >> 4;
    const int nt = K / BK;
    unsigned voffA[2], voffB[2];
#pragma unroll
    for (int i = 0; i < 2; ++i) { int R, C; stage_rc(tid * 16 + i * 8192, R, C); const int Rb = Epi::PERM ? ((R & ~31) + perm32(R & 31)) : R;
        voffA[i] = (unsigned)(R * K + C) * 2u; voffB[i] = (unsigned)(Rb * K + C) * 2u; }
    unsigned gc[2][2] = {{0u, 0u}, {0u, 0u}};
    auto gof = [&](int ui_, unsigned (&g)[2][2]) {
        if constexpr (Sched::GATHER) {
#pragma unroll
        for (int i = 0; i < 2; ++i) { int R, C; stage_rc(tid * 16 + i * 8192, R, C);
#pragma unroll
            for (int h = 0; h < 2; ++h) g[h][i] = S.arow(ui_, h * HALF + R) * (unsigned)(K * 2) + (unsigned)(C * 2); } } };
    const size_t kstep = (size_t)(BK * 2);
    const size_t hstep = (size_t)HALF * K * 2;
    const unsigned ldsw = (unsigned)wid * 1024u;
    const int aoff = lds_byte(wr * 64 + fr, fq * 8), boff = lds_byte(wc * 32 + fr, fq * 8);
#define PG8_SA(b, h) (((b) * 2 + (h)) * HTB)
#define PG8_SB(b, h) ((4 + (b) * 2 + (h)) * HTB)
#define PG8_STAGE(bufoff, gbase, voff) do { _Pragma("unroll") for (int _i = 0; _i < 2; ++_i) \
        __builtin_amdgcn_global_load_lds((const unsigned*)((const char*)(gbase) + (voff)[_i]), (PG8_LAS unsigned*)(lds + (bufoff) + ldsw + _i * 8192), 16, 0, 0); } while (0)
#define PG8_LDA(dst, b, h) do { _Pragma("unroll") for (int m = 0; m < 4; ++m) _Pragma("unroll") for (int k = 0; k < 2; ++k) dst[m][k] = *(const PG8_LAS bf16x8*)(lds + PG8_SA(b, h) + aoff + m * 2048 + k * 1024); } while (0)
#define PG8_LDB(dst, b, h) do { _Pragma("unroll") for (int n = 0; n < 2; ++n) _Pragma("unroll") for (int k = 0; k < 2; ++k) dst[n][k] = *(const PG8_LAS bf16x8*)(lds + PG8_SB(b, h) + boff + n * 2048 + k * 1024); } while (0)
#define PG8_MMA(ai, bj, At, Bt) do { __builtin_amdgcn_s_setprio(1); _Pragma("unroll") for (int m = 0; m < 4; ++m) _Pragma("unroll") for (int n = 0; n < 2; ++n) _Pragma("unroll") for (int k = 0; k < 2; ++k) \
        acc[ai][bj][m][n] = __builtin_amdgcn_mfma_f32_16x16x32_bf16(Bt[n][k], At[m][k], acc[ai][bj][m][n], 0, 0, 0); __builtin_amdgcn_s_setprio(0); } while (0)
#define PG8_WAIT_V(n) asm volatile("s_waitcnt vmcnt(" #n ")" ::: "memory")
#define PG8_WAIT_L(n) asm volatile("s_waitcnt lgkmcnt(" #n ")" ::: "memory")
#define PG8_BAR __builtin_amdgcn_s_barrier()
#define PG8_SCHED __builtin_amdgcn_sched_barrier(0)
    Unit cur, nxt; int ui = 0;
    if (!S.next(0, cur)) return;
    f32x4 acc[2][2][4][2];
#pragma unroll
    for (int a = 0; a < 2; ++a)
#pragma unroll
        for (int b = 0; b < 2; ++b)
#pragma unroll
            for (int m = 0; m < 4; ++m)
#pragma unroll
                for (int n = 0; n < 2; ++n) acc[a][b][m][n] = (f32x4){0.f, 0.f, 0.f, 0.f};
    bf16x8 At[4][2], B0[2][2], B1[2][2];
    const char* cA; const char* cB; S.addr(cur, cA, cB);
    S.a_ready(cur);
    if constexpr (Sched::GATHER) {
        static_assert(SP2, "GATHER schedulers use the SP2 loop");
        gof(0, gc);
        PG8_STAGE(PG8_SB(0, 0), cB, voffB); PG8_STAGE(PG8_SB(0, 1), cB + hstep, voffB); PG8_STAGE(PG8_SA(0, 0), cA, gc[0]); PG8_STAGE(PG8_SA(0, 1), cA, gc[1]);
        if (wr == 1) PG8_BAR;
        PG8_WAIT_V(2); PG8_BAR;
        PG8_STAGE(PG8_SB(1, 0), cB + kstep, voffB); PG8_STAGE(PG8_SA(1, 0), cA + kstep, gc[0]); PG8_STAGE(PG8_SB(1, 1), cB + hstep + kstep, voffB);
        PG8_WAIT_V(6); PG8_BAR;
    } else if constexpr (SP2) {
        PG8_STAGE(PG8_SB(0, 0), cB, voffB); PG8_STAGE(PG8_SB(0, 1), cB + hstep, voffB); PG8_STAGE(PG8_SA(0, 0), cA, voffA); PG8_STAGE(PG8_SA(0, 1), cA + hstep, voffA);
        if (wr == 1) PG8_BAR;
        PG8_WAIT_V(2); PG8_BAR;
        PG8_STAGE(PG8_SB(1, 0), cB + kstep, voffB); PG8_STAGE(PG8_SA(1, 0), cA + kstep, voffA); PG8_STAGE(PG8_SB(1, 1), cB + hstep + kstep, voffB);
        PG8_WAIT_V(6); PG8_BAR;
    } else {
        PG8_STAGE(PG8_SB(0, 0), cB, voffB); PG8_STAGE(PG8_SA(0, 0), cA, voffA); PG8_STAGE(PG8_SB(0, 1), cB + hstep, voffB); PG8_STAGE(PG8_SA(0, 1), cA + hstep, voffA);
        if (wr == 1) PG8_BAR;
        PG8_WAIT_V(4); PG8_BAR;
        PG8_STAGE(PG8_SB(1, 0), cB + kstep, voffB); PG8_STAGE(PG8_SA(1, 0), cA + kstep, voffA); PG8_STAGE(PG8_SB(1, 1), cB + hstep + kstep, voffB);
        PG8_WAIT_V(6); PG8_BAR;
    }
    for (;;) {
        const bool has_next = S.next(ui + 1, nxt);
        const char* nA = cA; const char* nB = cB; if (has_next) S.addr(nxt, nA, nB);
        for (int t = 0; t < nt; t += 2) {
            const bool last = (t == nt - 2);
            const char* a1 = cA + (size_t)(t + 1) * kstep;
            const char* a2 = last ? nA : cA + (size_t)(t + 2) * kstep; const char* b2 = last ? nB : cB + (size_t)(t + 2) * kstep;
            const char* a3 = a2 + kstep; const char* b3 = b2 + kstep;
            if (last && has_next) S.a_ready(nxt);
            if constexpr (Sched::GATHER) {
            unsigned o2[2][2];
            o2[0][0] = gc[0][0]; o2[0][1] = gc[0][1]; o2[1][0] = gc[1][0]; o2[1][1] = gc[1][1];
            if (last && has_next) gof(ui + 1, o2);
            PG8_LDB(B0, 0, 0); PG8_LDB(B1, 0, 1); PG8_SCHED; PG8_LDA(At, 0, 0); PG8_STAGE(PG8_SA(1, 1), a1, gc[1]);
            PG8_WAIT_V(8); PG8_WAIT_L(0); PG8_BAR; PG8_MMA(0, 0, At, B0); PG8_MMA(0, 1, At, B1); PG8_BAR; PG8_SCHED;
            PG8_LDA(At, 0, 1); PG8_STAGE(PG8_SB(0, 0), b2, voffB); PG8_STAGE(PG8_SB(0, 1), b2 + hstep, voffB); PG8_STAGE(PG8_SA(0, 0), a2, o2[0]);
            PG8_WAIT_V(8); PG8_WAIT_L(0); PG8_BAR; PG8_MMA(1, 0, At, B0); PG8_MMA(1, 1, At, B1); PG8_BAR; PG8_SCHED;
            PG8_LDB(B0, 1, 0); PG8_LDB(B1, 1, 1); PG8_SCHED; PG8_LDA(At, 1, 0); PG8_STAGE(PG8_SA(0, 1), a2, o2[1]);
            PG8_WAIT_V(8); PG8_WAIT_L(0); PG8_BAR; PG8_MMA(0, 0, At, B0); PG8_MMA(0, 1, At, B1); PG8_BAR; PG8_SCHED;
            PG8_LDA(At, 1, 1); PG8_STAGE(PG8_SB(1, 0), b3, voffB); PG8_STAGE(PG8_SB(1, 1), b3 + hstep, voffB); PG8_STAGE(PG8_SA(1, 0), a3, o2[0]);
            PG8_WAIT_V(8); PG8_WAIT_L(0); PG8_BAR; PG8_MMA(1, 0, At, B0); PG8_MMA(1, 1, At, B1); PG8_BAR; PG8_SCHED;
            } else if constexpr (SP2) {
            PG8_LDB(B0, 0, 0); PG8_LDB(B1, 0, 1); PG8_SCHED; PG8_LDA(At, 0, 0); PG8_STAGE(PG8_SA(1, 1), a1 + hstep, voffA);
            PG8_WAIT_V(8); PG8_WAIT_L(0); PG8_BAR; PG8_MMA(0, 0, At, B0); PG8_MMA(0, 1, At, B1); PG8_BAR; PG8_SCHED;
            PG8_LDA(At, 0, 1); PG8_STAGE(PG8_SB(0, 0), b2, voffB); PG8_STAGE(PG8_SB(0, 1), b2 + hstep, voffB); PG8_STAGE(PG8_SA(0, 0), a2, voffA);
            PG8_WAIT_V(8); PG8_WAIT_L(0); PG8_BAR; PG8_MMA(1, 0, At, B0); PG8_MMA(1, 1, At, B1); PG8_BAR; PG8_SCHED;
            PG8_LDB(B0, 1, 0); PG8_LDB(B1, 1, 1); PG8_SCHED; PG8_LDA(At, 1, 0); PG8_STAGE(PG8_SA(0, 1), a2 + hstep, voffA);
            PG8_WAIT_V(8); PG8_WAIT_L(0); PG8_BAR; PG8_MMA(0, 0, At, B0); PG8_MMA(0, 1, At, B1); PG8_BAR; PG8_SCHED;
            PG8_LDA(At, 1, 1); PG8_STAGE(PG8_SB(1, 0), b3, voffB); PG8_STAGE(PG8_SB(1, 1), b3 + hstep, voffB); PG8_STAGE(PG8_SA(1, 0), a3, voffA);
            PG8_WAIT_V(8); PG8_WAIT_L(0); PG8_BAR; PG8_MMA(1, 0, At, B0); PG8_MMA(1, 1, At, B1); PG8_BAR; PG8_SCHED;
            } else {
            PG8_LDB(B0, 0, 0); PG8_SCHED; PG8_LDA(At, 0, 0); PG8_STAGE(PG8_SA(1, 1), a1 + hstep, voffA);
            PG8_WAIT_L(8); PG8_BAR; PG8_WAIT_L(0); PG8_MMA(0, 0, At, B0); PG8_BAR; PG8_SCHED;
            PG8_LDB(B1, 0, 1); PG8_STAGE(PG8_SB(0, 0), b2, voffB);
            PG8_BAR; PG8_WAIT_L(0); PG8_MMA(0, 1, At, B1); PG8_BAR;
            PG8_LDA(At, 0, 1); PG8_STAGE(PG8_SA(0, 0), a2, voffA);
            PG8_BAR; PG8_WAIT_L(0); PG8_MMA(1, 0, At, B0); PG8_BAR; PG8_SCHED;
            PG8_STAGE(PG8_SB(0, 1), b2 + hstep, voffB);
            PG8_WAIT_V(6); PG8_BAR; PG8_MMA(1, 1, At, B1); PG8_BAR;
            PG8_LDB(B0, 1, 0); PG8_SCHED; PG8_LDA(At, 1, 0); PG8_STAGE(PG8_SA(0, 1), a2 + hstep, voffA);
            PG8_WAIT_L(8); PG8_BAR; PG8_WAIT_L(0); PG8_MMA(0, 0, At, B0); PG8_BAR; PG8_SCHED;
            PG8_LDB(B1, 1, 1); PG8_STAGE(PG8_SB(1, 0), b3, voffB);
            PG8_BAR; PG8_WAIT_L(0); PG8_MMA(0, 1, At, B1); PG8_BAR;
            PG8_LDA(At, 1, 1); PG8_STAGE(PG8_SA(1, 0), a3, voffA);
            PG8_BAR; PG8_WAIT_L(0); PG8_MMA(1, 0, At, B0); PG8_BAR; PG8_SCHED;
            PG8_STAGE(PG8_SB(1, 1), b3 + hstep, voffB);
            PG8_WAIT_V(6); PG8_BAR; PG8_MMA(1, 1, At, B1); PG8_BAR;
            }
        }
        if constexpr (ALIGN_EPI) { if (wr == 0) PG8_BAR; }
        { int le_; asm volatile("v_mbcnt_lo_u32_b32 %0, -1, 0\n\tv_mbcnt_hi_u32_b32 %0, -1, %0" : "=v"(le_));
          const int fr_e = le_ & 15, fq_e = le_ >> 4;
          if (cur.last) E(acc, cur, wr, wc, fr_e, fq_e); else E.mid(acc, cur, wr, wc, fr_e, fq_e); }
        if (!has_next) break;
        if (cur.last) {
#pragma unroll
        for (int a = 0; a < 2; ++a)
#pragma unroll
            for (int b = 0; b < 2; ++b)
#pragma unroll
                for (int m = 0; m < 4; ++m)
#pragma unroll
                    for (int n = 0; n < 2; ++n) acc[a][b][m][n] = (f32x4){0.f, 0.f, 0.f, 0.f};
        }
        cur = nxt; cA = nA; cB = nB; ++ui;
        if constexpr (Sched::GATHER) gof(ui, gc);
        if constexpr (ALIGN_EPI) { if (wr == 1) PG8_BAR; }
    }
    PG8_WAIT_V(0);
    if constexpr (!ALIGN_EPI) { if (wr == 0) PG8_BAR; }
    PG8_BAR;
#undef PG8_SA
#undef PG8_SB
#undef PG8_STAGE
#undef PG8_LDA
#undef PG8_LDB
#undef PG8_MMA
#undef PG8_WAIT_V
#undef PG8_WAIT_L
#undef PG8_BAR
#undef PG8_SCHED
}
}


#define GAS __attribute__((address_space(1)))
#define LAS __attribute__((address_space(3)))
typedef unsigned short bf16;
typedef unsigned v4u __attribute__((ext_vector_type(4)));
typedef float f32x4 __attribute__((ext_vector_type(4)));
typedef short bf16x8 __attribute__((ext_vector_type(8)));
typedef GAS unsigned gu32;
typedef GAS unsigned long long gu64;
#define RLX_AGENT __ATOMIC_RELAXED, __HIP_MEMORY_SCOPE_AGENT
#define LDS_WAIT() asm volatile("s_waitcnt lgkmcnt(0)" ::: "memory")
#define VM_WAIT() asm volatile("s_waitcnt vmcnt(0)" ::: "memory")
__device__ __forceinline__ unsigned long long rt() { return __builtin_amdgcn_s_memrealtime(); }
__device__ __forceinline__ unsigned f2bf(float f) { unsigned u = __builtin_bit_cast(unsigned, f); return (u + 0x7fffu + ((u >> 16) & 1u)) >> 16; }
__device__ __forceinline__ unsigned pk2(float lo, float hi) { return f2bf(lo) | (f2bf(hi) << 16); }

#define XB_TMO      128
#define XB_XCNT(j)  (256  + 64 * (j))
#define XB_XSUB(j)  (1280 + 64 * (j))
#define XB_XGEN(j)  (2304 + 64 * (j))
#define XB_TOP      3328
#define XB_TOPGEN   3392
#define XCD_BAR_WORDS 3456
#define XB_SPIN_CAP (1u << 18)

__device__ __forceinline__ unsigned xb_ld(unsigned* p)              { return __hip_atomic_load(p, __ATOMIC_RELAXED, __HIP_MEMORY_SCOPE_AGENT); }
__device__ __forceinline__ unsigned xb_add(unsigned* p, unsigned v) { return __hip_atomic_fetch_add(p, v, __ATOMIC_RELAXED, __HIP_MEMORY_SCOPE_AGENT); }
__device__ __forceinline__ unsigned xb_xcc_id() { return (unsigned)__builtin_amdgcn_s_getreg((3 << 11) | 20) & 0xFu; }
#define XB_SPIN(cond, bar) do { unsigned _sp = 0; while (cond) { __builtin_amdgcn_s_sleep(1); \
    if ((++_sp & 255u) == 0u) { if (xb_ld(&(bar)[XB_TMO])) break; if (_sp > XB_SPIN_CAP) { atomicAdd(&(bar)[XB_TMO], 1u); break; } } } } while (0)

struct XcdBarrier {
    unsigned* bar; unsigned x;
    volatile LAS unsigned* st;
};

__device__ __forceinline__ XcdBarrier xcd_barrier_post(unsigned* bar, volatile LAS unsigned* st) {
    XcdBarrier b; b.bar = bar; b.x = xb_xcc_id(); b.st = st;
    if (threadIdx.x == 0) (void)xb_add(&bar[XB_XCNT(b.x)], 1u);
    return b;
}
__device__ __forceinline__ void xcd_barrier_complete(unsigned* bar, unsigned x, unsigned& nloc, unsigned& nx) {
    const unsigned G = gridDim.x * gridDim.y * gridDim.z;
    unsigned sum, cnt, mine, sp = 0u;
    for (;;) {
        sum = 0u; cnt = 0u; mine = 0u;
#pragma unroll
        for (unsigned j = 0; j < 16; ++j) { const unsigned c = xb_ld(&bar[XB_XCNT(j)]); sum += c; cnt += (c > 0u) ? 1u : 0u; mine = (j == x) ? c : mine; }
        if (sum == G) break;
        __builtin_amdgcn_s_sleep(1);
        if ((++sp & 255u) == 0u) { if (xb_ld(&bar[XB_TMO])) break; if (sp > XB_SPIN_CAP) { atomicAdd(&bar[XB_TMO], 1u); break; } }
    }
    nloc = mine > 0u ? mine : 1u; nx = cnt > 0u ? cnt : 1u;
}

__device__ __forceinline__ void xcd_barrier(const XcdBarrier& b) {
    asm volatile("s_waitcnt vmcnt(0)" ::: "memory");
    __syncthreads();
    if (threadIdx.x == 0) {
        unsigned* bar = b.bar;
        __builtin_amdgcn_s_waitcnt(0);
        unsigned nloc = b.st[0], nx = b.st[1];
        if (nloc == 0u) { xcd_barrier_complete(bar, b.x, nloc, nx); b.st[0] = nloc; b.st[1] = nx; }
        const unsigned old = xb_add(&bar[XB_XSUB(b.x)], 1u);
        const unsigned gen = old / nloc;
        if (old + 1u == (gen + 1u) * nloc) {
            __builtin_amdgcn_fence(__ATOMIC_RELEASE, "agent");
            asm volatile("s_waitcnt vmcnt(0)" ::: "memory");
            const unsigned og = xb_add(&bar[XB_TOP], 1u);
            const unsigned tg = og / nx;
            if (og + 1u == (tg + 1u) * nx) xb_add(&bar[XB_TOPGEN], 1u);
            else XB_SPIN(xb_ld(&bar[XB_TOPGEN]) == tg, bar);
            __builtin_amdgcn_fence(__ATOMIC_ACQUIRE, "agent");
            xb_add(&bar[XB_XGEN(b.x)], 1u);
            asm volatile("s_waitcnt vmcnt(0)" ::: "memory");
        } else {
            XB_SPIN(xb_ld(&bar[XB_XGEN(b.x)]) == gen, bar);
            __builtin_amdgcn_fence(__ATOMIC_ACQUIRE, "agent");
            asm volatile("s_waitcnt vmcnt(0)" ::: "memory");
        }
    }
    __syncthreads();
}


#include <hip/hip_bf16.h>
#include <cmath>
#include <hip/hip_bf16.h>
#include <cmath>
namespace attn_body {
using bf16=__hip_bfloat16;
using bf16x8=__attribute__((ext_vector_type(8)))short;
using s16x4=__attribute__((ext_vector_type(4)))short;
using f32x16=__attribute__((ext_vector_type(16)))float;
using u32x4=__attribute__((ext_vector_type(4)))unsigned;
using f32x4_t=__attribute__((ext_vector_type(4)))float;
constexpr int BATCH=16,NHEAD=8,SEQ=2048,D=64,DM=5888,OP=512;
constexpr int NW=8,QBLK=32,QB=QBLK*NW,KVBLK=64,NQB=SEQ/QB;
constexpr int ATTN_PITCH=DM, ATTN_UNIT_ROWS=QB;
__device__ __forceinline__ int crow(int r,int hi){return (r&3)+8*(r>>2)+4*hi;}
#define SBAR() __builtin_amdgcn_sched_barrier(0)
__device__ __forceinline__ void cmask(f32x16&p0,f32x16&p1,int jb,int qrel,int hi){
  const float NEG=-INFINITY; int kb=64*jb+4*hi;
  #pragma unroll
  for(int r=0;r<16;++r){int kv=kb+(r&3)+8*(r>>2); if(kv>qrel)p0[r]=NEG; if(kv+32>qrel)p1[r]=NEG;}
}

constexpr int NSLOT=3, SLOTB=8192;
constexpr int LDS_K=0, LDS_V=NSLOT*SLOTB, LDS_WS=2*NSLOT*SLOTB, LDS_OST=LDS_WS+NW*64*4, LDS_CB=LDS_OST+NW*4096, LDS_BYTES=LDS_CB+SEQ*4;
constexpr float C2=0.125f*1.4426950408889634f;
__device__ __forceinline__ void glds16(const void*gsrc,unsigned lds_dst){unsigned keep;
  asm volatile("s_mov_b32 %0, m0\n\ts_mov_b32 m0, %2\n\ts_nop 0\n\tglobal_load_lds_dwordx4 %1, off\n\ts_mov_b32 m0, %0":"=&s"(keep):"v"(gsrc),"s"(lds_dst):"memory");}
__device__ __forceinline__ float max3f(float a,float b,float c){float r;asm("v_max3_f32 %0, %1, %2, %3":"=v"(r):"v"(a),"v"(b),"v"(c));return r;}
__device__ __forceinline__ float max2f(float a,float b){float r;asm("v_max_f32_e32 %0, %1, %2":"=v"(r):"v"(a),"v"(b));return r;}
__device__ __forceinline__ float fadd_s(float a,float b){float r;asm("v_add_f32_e32 %0, %1, %2":"=v"(r):"v"(a),"v"(b));return r;}
__device__ __forceinline__ float fsub_s(float a,float b){float r;asm("v_sub_f32_e32 %0, %1, %2":"=v"(r):"v"(a),"v"(b));return r;}
typedef float f32x2_t __attribute__((ext_vector_type(2))); typedef __bf16 bf16x2_t __attribute__((ext_vector_type(2)));
__device__ __forceinline__ unsigned cvtpk_s(float lo,float hi){f32x2_t v={lo,hi};bf16x2_t b=__builtin_convertvector(v,bf16x2_t);return __builtin_bit_cast(unsigned,b);}
#define WAIT_BAR(N) asm volatile("s_waitcnt vmcnt(" #N ") lgkmcnt(0)\n\ts_barrier":::"memory")

__device__ __forceinline__ void qkt(f32x16&p0,f32x16&p1,const char*Kslot,const bf16x8*qr,int r32,int hi){
  const char*kb=Kslot+hi*1024+r32*16;
  #pragma unroll
  for(int d0=0;d0<4;++d0){
    const bf16x8 b0=*reinterpret_cast<const bf16x8*>(kb+d0*2048);
    const bf16x8 b1=*reinterpret_cast<const bf16x8*>(kb+d0*2048+512);
    if(d0==0){p0=__builtin_amdgcn_mfma_f32_32x32x16_bf16(b0,qr[0],p0,0,0,0);p1=__builtin_amdgcn_mfma_f32_32x32x16_bf16(b1,qr[0],p1,0,0,0);}
    else{p0=__builtin_amdgcn_mfma_f32_32x32x16_bf16(b0,qr[d0],p0,0,0,0);p1=__builtin_amdgcn_mfma_f32_32x32x16_bf16(b1,qr[d0],p1,0,0,0);}}
}
typedef __attribute__((address_space(3))) const char* lds_cptr;
typedef short v4i16_t __attribute__((ext_vector_type(4)));
__device__ __forceinline__ void kload8(bf16x8*kf,lds_cptr kp){
  kf[0]=*(const __attribute__((address_space(3))) bf16x8*)(kp);      kf[1]=*(const __attribute__((address_space(3))) bf16x8*)(kp+512);
  kf[2]=*(const __attribute__((address_space(3))) bf16x8*)(kp+2048); kf[3]=*(const __attribute__((address_space(3))) bf16x8*)(kp+2560);
  kf[4]=*(const __attribute__((address_space(3))) bf16x8*)(kp+4096); kf[5]=*(const __attribute__((address_space(3))) bf16x8*)(kp+4608);
  kf[6]=*(const __attribute__((address_space(3))) bf16x8*)(kp+6144); kf[7]=*(const __attribute__((address_space(3))) bf16x8*)(kp+6656);
}
__device__ __forceinline__ void kload2(bf16x8*kf,lds_cptr kp,int j){ kf[2*j]=*(const __attribute__((address_space(3))) bf16x8*)(kp+j*2048); kf[2*j+1]=*(const __attribute__((address_space(3))) bf16x8*)(kp+j*2048+512); }
__device__ __forceinline__ s16x4 vtr(lds_cptr p){ return __builtin_bit_cast(s16x4,__builtin_amdgcn_ds_read_tr16_b64_v4i16((__attribute__((address_space(3))) v4i16_t*)p)); }
__device__ __forceinline__ float rowmax(const f32x16&p0,const f32x16&p1){
  float a=max3f(p0[0],p0[1],p1[0]),b=max3f(p0[2],p0[3],p1[1]);a=max3f(a,p1[2],p1[3]);
  #pragma unroll
  for(int r=4;r<16;r+=4){a=max3f(a,p0[r],p0[r+1]);b=max3f(b,p0[r+2],p0[r+3]);a=max3f(a,p1[r],p1[r+1]);b=max3f(b,p1[r+2],p1[r+3]);}
  const float m=max2f(a,b);
  auto rr=__builtin_amdgcn_permlane32_swap(__float_as_uint(m),__float_as_uint(m),false,false);
  return max2f(__uint_as_float(rr[0]),__uint_as_float(rr[1]));
}
__device__ __forceinline__ void pv(f32x16*o,int vb,bf16x8 pa0,bf16x8 pa1,bf16x8 pa2,bf16x8 pa3){
  #pragma unroll
  for(int d0=0;d0<2;++d0){s16x4 lo[4],hi[4];
    #pragma unroll
    for(int ks=0;ks<4;++ks){
      asm volatile("ds_read_b64_tr_b16 %0,%1 offset:%c2":"=&v"(lo[ks]):"v"(vb),"i"(d0*4096+ks*1024):"memory");
      asm volatile("ds_read_b64_tr_b16 %0,%1 offset:%c2":"=&v"(hi[ks]):"v"(vb),"i"(d0*4096+ks*1024+512):"memory");}
    asm volatile("s_waitcnt lgkmcnt(0)":::"memory");SBAR();
    #define PK(k) (bf16x8){lo[k][0],lo[k][1],lo[k][2],lo[k][3],hi[k][0],hi[k][1],hi[k][2],hi[k][3]}
    o[d0]=__builtin_amdgcn_mfma_f32_32x32x16_bf16(pa0,PK(0),o[d0],0,0,0);
    o[d0]=__builtin_amdgcn_mfma_f32_32x32x16_bf16(pa1,PK(1),o[d0],0,0,0);
    o[d0]=__builtin_amdgcn_mfma_f32_32x32x16_bf16(pa2,PK(2),o[d0],0,0,0);
    o[d0]=__builtin_amdgcn_mfma_f32_32x32x16_bf16(pa3,PK(3),o[d0],0,0,0);
    #undef PK
  }
}

#ifndef ATTN_STORE16
#define ATTN_STORE16(p,v) (*(u32x4*)(p)=(v))
#endif
template<int THRL> __device__ __forceinline__ void attn_unit(int b,int h,int qb,const bf16*Q,const bf16*__restrict__ K,const bf16*__restrict__ V,bf16*O,const float*__restrict__ ck,char*shm,const int wave0){
  int sw_=wave0; asm volatile("":"+s"(sw_)); int ln_; asm volatile("v_mbcnt_lo_u32_b32 %0, -1, 0\n\tv_mbcnt_hi_u32_b32 %0, -1, %0":"=v"(ln_)); const int tid=sw_*64+ln_,lane=tid&63,r32=lane&31,hi=lane>>5; const int wid=__builtin_amdgcn_readfirstlane(tid>>6);
  const long rowbase=(long)b*SEQ; const int q0=qb*QB;
  const bf16*Qw=Q+(rowbase+q0+wid*QBLK)*DM+h*D;
  const bf16*Kh=K+rowbase*DM+h*D,*Vh=V+rowbase*DM+h*D;
  const unsigned lds0=(unsigned)(uintptr_t)shm;
  float*wsf=(float*)(shm+LDS_WS)+wid*64;
  const bf16*ksrc=Kh+(long)lane*DM+wid*8;
  const bf16*vsrc=Vh+(long)(16*(wid&3)+(lane>>2))*DM+(wid>>2)*32+(lane&3)*8;
  const unsigned kdst=lds0+LDS_K+wid*1024, vdst=lds0+LDS_V+wid*1024;
  #define DMA_K(t,slot) glds16(ksrc+(long)(t)*KVBLK*DM,(unsigned)__builtin_amdgcn_readfirstlane(kdst+(slot)))
  #define DMA_V(t,slot) glds16(vsrc+(long)(t)*KVBLK*DM,(unsigned)__builtin_amdgcn_readfirstlane(vdst+(slot)))
  const int vb0=(int)(lds0+LDS_V)+((lane>>4)&1)*32+(lane&3)*8+(4*hi+((lane&15)>>2))*64;
  const char*Kbase=shm+LDS_K; bf16x8 kf[8];
  const lds_cptr shm3=(lds_cptr)shm; const lds_cptr kp0=shm3+LDS_K+hi*1024+r32*16; const lds_cptr vp0=shm3+LDS_V+((lane>>4)&1)*32+(lane&3)*8+(4*hi+((lane&15)>>2))*64;
  const int NT=(q0+QB)/KVBLK;
  { __attribute__((address_space(3))) float*cbl=(__attribute__((address_space(3))) float*)((__attribute__((address_space(3))) char*)shm+LDS_CB); const float cref=ck[q0+QB-1]; for(int i=tid;i<q0+QB;i+=NW*64)cbl[i]=cref-ck[i]; }
  typedef __attribute__((address_space(3))) const f32x4_t* lds_f4p; const lds_f4p cbp=(lds_f4p)((lds_cptr)shm+LDS_CB)+hi;
  #define BIASLD(X0,X1,t) do{ const lds_f4p c_=cbp+16*(t); _Pragma("unroll") for(int g_=0;g_<4;++g_){ const f32x4_t a_=c_[2*g_],b_=c_[8+2*g_]; X0[4*g_]=a_[0];X0[4*g_+1]=a_[1];X0[4*g_+2]=a_[2];X0[4*g_+3]=a_[3]; X1[4*g_]=b_[0];X1[4*g_+1]=b_[1];X1[4*g_+2]=b_[2];X1[4*g_+3]=b_[3]; } }while(0)
  DMA_K(0,0);DMA_V(0,0);DMA_K(1,SLOTB);
  bf16x8 qr[4];
  #pragma unroll
  for(int d0=0;d0<4;++d0)qr[d0]=*reinterpret_cast<const bf16x8*>(&Qw[(long)r32*DM+d0*16+hi*8]);
  float mhat=0.f,l_reg=0.f;f32x16 o[2];o[0]=f32x16{};o[1]=f32x16{};
  const int qrel=wid*QBLK+r32;
  #define CMASK(P0,P1,t) do{int jb_=(t)-(NT-4); if(jb_>=0)cmask(P0,P1,jb_,qrel,hi);}while(0)
  bool resc=false;
  #define START(P0,P1) do{ const float rm=rowmax(P0,P1); resc=false; \
    { const float dl=rm; mhat=fadd_s(mhat,dl); \
      _Pragma("unroll") for(int r=0;r<16;++r){P0[r]=fsub_s(P0[r],dl);P1[r]=fsub_s(P1[r],dl);} } \
    _Pragma("unroll") for(int r=0;r<16;++r)P0[r]=__builtin_amdgcn_exp2f(P0[r]); }while(0)
  #define RESC() do{ if(resc){ asm volatile("s_waitcnt lgkmcnt(0)":::"memory"); \
      _Pragma("unroll") for(int d_=0;d_<2;++d_) _Pragma("unroll") for(int r=0;r<16;++r)o[d_][r]*=wsf[crow(r,hi)]; } }while(0)
  f32x16 pA0,pA1,pB0,pB1;
  int sl_prev=0,sl_cur=0,sl_next=SLOTB;
  #define ROT() do{sl_prev=sl_cur;sl_cur=sl_next;sl_next=(sl_next==(NSLOT-1)*SLOTB)?0:sl_next+SLOTB;}while(0)
  DMA_K(2,2*SLOTB);
  WAIT_BAR(3);
  BIASLD(pA0,pA1,0);
  qkt(pA0,pA1,Kbase,qr,r32,hi);asm volatile("s_nop 15\n\ts_nop 7":"+v"(pA0),"+v"(pA1));CMASK(pA0,pA1,0);
  START(pA0,pA1);
  _Pragma("unroll") for(int r=0;r<16;++r)pA1[r]=__builtin_amdgcn_exp2f(pA1[r]);
  WAIT_BAR(0);
  DMA_K(3,0);DMA_V(1,SLOTB);
  ROT();
  kload8(kf,kp0+sl_cur);
  BIASLD(pB0,pB1,1);
  WAIT_BAR(2);
  s16x4 vlo[8],vhi[8]; u32x4 pw0,pw1,pw2,pw3;
  #define PKW(P,B) cvtpk_s(P[B],P[B+1])
  #define PAF(k) __builtin_bit_cast(bf16x8,pw##k)
  #define VFR(i) (bf16x8){vlo[i][0],vlo[i][1],vlo[i][2],vlo[i][3],vhi[i][0],vhi[i][1],vhi[i][2],vhi[i][3]}
  #define PIN(x) asm volatile("":"+v"(x))
  #define MX3(a,b,c) __builtin_fmaxf(__builtin_fmaxf((a),(b)),(c))
  #define GAPA(MF,A0,A1,A2,A3,W0,W1,PW) do{ MF; sacc+=A0; sacc+=A1; sacc+=A2; sacc+=A3; PIN(sacc); W0; W1; PIN(PW); SBAR(); }while(0)
  #define EX(v) __builtin_amdgcn_exp2f(v)
  #define GAPB(MF,X,B) do{ MF; X[B]=EX(X[B]); X[B+1]=EX(X[B+1]); X[B+2]=EX(X[B+2]); X[B+3]=EX(X[B+3]); PIN(X); SBAR(); }while(0)
  #define VRD(i) do{ vlo[i]=vtr(vp_+(((i)>>2)*4096+((i)&3)*1024)); vhi[i]=vtr(vp_+(((i)>>2)*4096+((i)&3)*1024+512)); }while(0)
  #define KRD(G,j) do{ if(G){ kload2(kf,kp0+sl_next,j); SBAR(); } }while(0)
  #define STEP(C0,C1,P0,P1,t,GK,GV,GL) do{ SBAR(); \
    _Pragma("unroll") for(int r=0;r<16;++r){C0[r]-=mhat;C1[r]-=mhat;} \
    const lds_cptr vp_=vp0+sl_prev; \
    VRD(0); SBAR(); float sacc=(P0[0]+P0[1]); \
    GAPA(C0=__builtin_amdgcn_mfma_f32_32x32x16_bf16(kf[0],qr[0],C0,0,0,0), P0[2],P0[3],P0[4],P0[5],     pw0[0]=PKW(P0,0), pw0[1]=PKW(P0,2), pw0); \
    VRD(4); SBAR(); GAPA(C1=__builtin_amdgcn_mfma_f32_32x32x16_bf16(kf[1],qr[0],C1,0,0,0), P0[6],P0[7],P0[8],P0[9],     pw0[2]=PKW(P0,4), pw0[3]=PKW(P0,6), pw0); \
    VRD(1); SBAR(); GAPA(C0=__builtin_amdgcn_mfma_f32_32x32x16_bf16(kf[2],qr[1],C0,0,0,0),   P0[10],P0[11],P0[12],P0[13], pw1[0]=PKW(P0,8), pw1[1]=PKW(P0,10), pw1); \
    VRD(5); SBAR(); GAPA(C1=__builtin_amdgcn_mfma_f32_32x32x16_bf16(kf[3],qr[1],C1,0,0,0),   P0[14],P0[15],P1[0],P1[1],   pw1[2]=PKW(P0,12),pw1[3]=PKW(P0,14), pw1); \
    VRD(2); SBAR(); GAPA(C0=__builtin_amdgcn_mfma_f32_32x32x16_bf16(kf[4],qr[2],C0,0,0,0),   P1[2],P1[3],P1[4],P1[5],     pw2[0]=PKW(P1,0), pw2[1]=PKW(P1,2), pw2); \
    VRD(6); SBAR(); GAPA(C1=__builtin_amdgcn_mfma_f32_32x32x16_bf16(kf[5],qr[2],C1,0,0,0),   P1[6],P1[7],P1[8],P1[9],     pw2[2]=PKW(P1,4), pw2[3]=PKW(P1,6), pw2); \
    VRD(3); SBAR(); GAPA(C0=__builtin_amdgcn_mfma_f32_32x32x16_bf16(kf[6],qr[3],C0,0,0,0),   P1[10],P1[11],P1[12],P1[13], pw3[0]=PKW(P1,8), pw3[1]=PKW(P1,10), pw3); \
    VRD(7); SBAR(); GAPA(C1=__builtin_amdgcn_mfma_f32_32x32x16_bf16(kf[7],qr[3],C1,0,0,0),   P1[14],P1[15],0.f,0.f,       pw3[2]=PKW(P1,12),pw3[3]=PKW(P1,14), pw3); \
    l_reg+=sacc; \
    if(GK){DMA_K((t)+3,sl_cur);} if(GV){DMA_V((t)+1,sl_next);} \
    CMASK(C0,C1,t); \
    { float a=MX3(C0[0],C0[1],C1[0]),b=MX3(C0[2],C0[3],C1[1]); a=MX3(a,C1[2],C1[3]); \
      _Pragma("unroll") for(int r=4;r<16;r+=4){a=MX3(a,C0[r],C0[r+1]);b=MX3(b,C0[r+2],C0[r+3]);a=MX3(a,C1[r],C1[r+1]);b=MX3(b,C1[r+2],C1[r+3]);} \
      float rm=__builtin_fmaxf(a,b); { auto rr=__builtin_amdgcn_permlane32_swap(__float_as_uint(rm),__float_as_uint(rm),false,false); rm=__builtin_fmaxf(__uint_as_float(rr[0]),__uint_as_float(rr[1])); } \
      resc=false; \
      if(__builtin_expect(__any(rm>(float)THRL),0)){ const float dl=__builtin_fmaxf(rm,0.f); mhat+=dl; \
        _Pragma("unroll") for(int r=0;r<16;++r){C0[r]-=dl;C1[r]-=dl;} \
        const float f=__builtin_amdgcn_exp2f(-dl); l_reg*=f; if(hi==0)wsf[r32]=f; resc=true; } } \
    SBAR(); \
    GAPB(o[0]=__builtin_amdgcn_mfma_f32_32x32x16_bf16(PAF(0),VFR(0),o[0],0,0,0), C0,0); \
    GAPB(o[1]=__builtin_amdgcn_mfma_f32_32x32x16_bf16(PAF(0),VFR(4),o[1],0,0,0), C0,4); \
    KRD(GL,0); GAPB(o[0]=__builtin_amdgcn_mfma_f32_32x32x16_bf16(PAF(1),VFR(1),o[0],0,0,0), C0,8); \
    KRD(GL,1); GAPB(o[1]=__builtin_amdgcn_mfma_f32_32x32x16_bf16(PAF(1),VFR(5),o[1],0,0,0), C0,12); \
    KRD(GL,2); GAPB(o[0]=__builtin_amdgcn_mfma_f32_32x32x16_bf16(PAF(2),VFR(2),o[0],0,0,0), C1,0); \
    KRD(GL,3); GAPB(o[1]=__builtin_amdgcn_mfma_f32_32x32x16_bf16(PAF(2),VFR(6),o[1],0,0,0), C1,4); \
    GAPB(o[0]=__builtin_amdgcn_mfma_f32_32x32x16_bf16(PAF(3),VFR(3),o[0],0,0,0), C1,8); \
    GAPB(o[1]=__builtin_amdgcn_mfma_f32_32x32x16_bf16(PAF(3),VFR(7),o[1],0,0,0), C1,12); \
    if((t)+1<NT){ BIASLD(P0,P1,(t)+1); } \
    }while(0)
  int t=1;
  #undef CMASK
  #define CMASK(P0,P1,t) do{}while(0)
  for(;t+5<NT;t+=2){
    STEP(pB0,pB1,pA0,pA1,t,true,true,true);     WAIT_BAR(2); RESC(); ROT();
    STEP(pA0,pA1,pB0,pB1,t+1,true,true,true);   WAIT_BAR(2); RESC(); ROT();
  }
  #undef CMASK
  #define CMASK(P0,P1,t) do{int jb_=(t)-(NT-4); if(jb_>=0)cmask(P0,P1,jb_,qrel,hi);}while(0)
  #define ENDW(tt) do{ if((tt)+3<NT){WAIT_BAR(2);} else if((tt)+2<NT){WAIT_BAR(1);} else {WAIT_BAR(0);} }while(0)
  for(;t+1<NT;t+=2){
    STEP(pB0,pB1,pA0,pA1,t,(t+3<NT),(t+1<NT),(t+1<NT));       ENDW(t);   RESC(); ROT();
    STEP(pA0,pA1,pB0,pB1,t+1,(t+4<NT),(t+2<NT),(t+2<NT));     ENDW(t+1); RESC(); ROT();
  }
  STEP(pB0,pB1,pA0,pA1,NT-1,false,false,false); RESC();
  { float sacc=pB0[0]+pB0[1]; _Pragma("unroll") for(int r=2;r<16;++r)sacc+=pB0[r]; _Pragma("unroll") for(int r=0;r<16;++r)sacc+=pB1[r]; l_reg+=sacc;
    pw0=(u32x4){PKW(pB0,0),PKW(pB0,2),PKW(pB0,4),PKW(pB0,6)};pw1=(u32x4){PKW(pB0,8),PKW(pB0,10),PKW(pB0,12),PKW(pB0,14)};pw2=(u32x4){PKW(pB1,0),PKW(pB1,2),PKW(pB1,4),PKW(pB1,6)};pw3=(u32x4){PKW(pB1,8),PKW(pB1,10),PKW(pB1,12),PKW(pB1,14)};
    SBAR(); pv(o,vb0+sl_cur,PAF(0),PAF(1),PAF(2),PAF(3)); }
  #undef PKW
  #undef PAF
  #undef VFR
  #undef PIN
  #undef MX3
  #undef GAPA
  #undef GAPB
  #undef EX
  #undef VRD
  #undef KRD
  #undef STEP
  #undef ENDW
  {auto rr=__builtin_amdgcn_permlane32_swap(__float_as_uint(l_reg),__float_as_uint(l_reg),false,false);l_reg=__uint_as_float(rr[0])+__uint_as_float(rr[1]);}
  if(hi==0)wsf[32+r32]=l_reg;asm volatile("s_waitcnt lgkmcnt(0)":::"memory");
  float rli[16];
  #pragma unroll
  for(int r=0;r<16;++r)rli[r]=__builtin_amdgcn_rcpf(wsf[32+crow(r,hi)]);
  bf16*Ow=O+(rowbase+q0+wid*QBLK)*OP+h*D;
  { bf16*stg=(bf16*)(shm+LDS_OST)+wid*2048;
    #pragma unroll
    for(int r=0;r<16;++r){const int orow=crow(r,hi);
      #pragma unroll
      for(int d0=0;d0<2;++d0)stg[orow*64+d0*32+r32]=__float2bfloat16(o[d0][r]*rli[r]);}
    asm volatile("s_waitcnt lgkmcnt(0)":::"memory");
    #pragma unroll
    for(int i=0;i<4;++i){const int row=i*8+(lane>>3),ch=lane&7; const u32x4 v=*(const u32x4*)(stg+row*64+ch*8); ATTN_STORE16(Ow+(long)row*OP+ch*8,v);} }
  asm volatile("s_waitcnt lgkmcnt(0)\n\ts_barrier":::"memory");
  #undef DMA_K
  #undef DMA_V
  #undef BIASLD
  #undef CMASK
  #undef START
  #undef RESC
  #undef ROT
}
constexpr int ATTN_LDS_BYTES=LDS_BYTES;
#undef SBAR
#undef WAIT_BAR
}


constexpr size_t MiB = 1u << 20;
constexpr size_t WS_CTL = 0, CTL_ZERO_BYTES = 1 * MiB;
constexpr size_t WS_WSMALL = 1 * MiB;
constexpr size_t WL_WIN = 0, WL_LORA = 18 * MiB, WL_BR = WL_LORA + 768 * 1024, WL_WOUT = WL_BR + 4 * MiB, WL_STRIDE = WL_WOUT + 2 * MiB;
constexpr size_t WS_WEXP = 100 * MiB;
constexpr size_t WS_PMIX = 196 * MiB;
constexpr size_t WS_MISC = 564 * MiB;
constexpr size_t WS_PGATE = 568 * MiB;
constexpr size_t WS_RA = 760 * MiB;
constexpr size_t WS_RB = 888 * MiB;
constexpr size_t WS_ROUTE = 1016 * MiB;
constexpr size_t WS_END = 1024 * MiB;
static_assert(WS_WSMALL + 4 * WL_STRIDE <= WS_WEXP, "small weights");
constexpr size_t WS_MERGED = WS_PMIX;
constexpr size_t WS_X1 = WS_RA;
constexpr size_t WS_LIN = WS_RA, WS_LOUT = WS_RA + 16 * MiB, WS_CK = WS_RA + 112 * MiB, WS_SSQ = WS_RA + 113 * MiB;
constexpr size_t WS_DTCS = WS_RA + 115 * MiB;
constexpr size_t WS_HALO = WS_ROUTE + 1 * MiB;
constexpr int CW_QUEUE = 12288;
constexpr size_t WS_OR = WS_RB, WS_OF = WS_RB + 32 * MiB, WS_OM0 = WS_RB + 64 * MiB, WS_OM1 = WS_RB + 96 * MiB, WS_XB = WS_RB;
constexpr size_t WS_GATEW = WS_ROUTE, WS_CNT = WS_ROUTE + 512 * 1024;
constexpr size_t WS_POS = WS_ROUTE + 256 * 1024;
constexpr size_t WS_ROWTOK = WS_ROUTE + 6 * MiB;
constexpr size_t WS_TAB = WS_ROUTE + 768 * 1024;
constexpr int MPAD = 73728;
constexpr size_t WS_XG = 196 * MiB, WS_H = 340 * MiB, WS_YS = 412 * MiB;
constexpr size_t WEXP_GU = 0, WEXP_D = 64 * MiB;
constexpr int CW_BAR = 1024;
constexpr int CW_CNT = 16384, CNT_STRIDE = 32;

constexpr int RING_OFF = 0, RING_BYTES = 131072;
constexpr int LDS_BYTES = 147456;
constexpr int LDSCTL_OFF = LDS_BYTES - 4096, MISC_OFF = LDSCTL_OFF;
constexpr int LTOK_OFF = RING_OFF + RING_BYTES, LTOK_UNITS = 11;
static_assert(LTOK_OFF + LTOK_UNITS * 1024 <= LDSCTL_OFF, "ltok");
constexpr int LTAB_OFF = LDSCTL_OFF + 256;
constexpr int ROUTER_LD = 1028;
static_assert(NEXP * ROUTER_LD * 4 <= LDSCTL_OFF, "router table");
constexpr int NWAVES = 8;

__device__ __forceinline__ void tr_item(const float* W, size_t ldw, int k0, int srccol, bf16* WT, size_t Kd, int drow0, int dk0, LAS float* scr, int lane, const float* kscale = nullptr) {
#pragma unroll 8
    for (int i = 0; i < 32; ++i) { const int kk = 2 * i + (lane >> 5); float wv = srccol >= 0 ? W[(size_t)(k0 + kk) * ldw + srccol] : 0.f; if (kscale) wv *= kscale[k0 + kk]; scr[kk * 33 + (lane & 31)] = wv; }
    LDS_WAIT(); asm volatile("" ::: "memory");
    const int c = lane & 7;
#pragma unroll
    for (int j = 0; j < 4; ++j) { const int n = (lane >> 3) + 8 * j; const LAS float* s = scr + (8 * c) * 33 + n;
        v4u o; o.x = pk2(s[0 * 33], s[1 * 33]); o.y = pk2(s[2 * 33], s[3 * 33]); o.z = pk2(s[4 * 33], s[5 * 33]); o.w = pk2(s[6 * 33], s[7 * 33]);
        *(GAS v4u*)(WT + (size_t)(drow0 + n) * Kd + dk0 + 8 * c) = o; }
    LDS_WAIT(); asm volatile("" ::: "memory");
}
__device__ __forceinline__ void tr4_load(f32x4 (&v)[8], const float* W, size_t ldw, int k0, int n0, int lane, const float* kscale) {
    const int rr = lane >> 3, c4 = (lane & 7) * 4;
#pragma unroll
    for (int i = 0; i < 8; ++i) v[i] = *(const GAS f32x4*)(W + (size_t)(k0 + 8 * i + rr) * ldw + n0 + c4);
    if (kscale) {
#pragma unroll
        for (int i = 0; i < 8; ++i) v[i] = v[i] * kscale[k0 + 8 * i + rr]; }
}
__device__ __forceinline__ void tr4_store(const f32x4 (&v)[8], bf16* WT, size_t Kd, int drow0, int dk0, LAS float* scr, int lane) {
    const int rr = lane >> 3, c4 = (lane & 7) * 4;
#pragma unroll
    for (int i = 0; i < 8; ++i) { LAS float* d = scr + (8 * i + rr) * 33 + c4; d[0] = v[i].x; d[1] = v[i].y; d[2] = v[i].z; d[3] = v[i].w; }
    LDS_WAIT(); asm volatile("" ::: "memory");
    const int c = lane & 7;
#pragma unroll
    for (int j = 0; j < 4; ++j) { const int n = (lane >> 3) + 8 * j; const LAS float* sp = scr + (8 * c) * 33 + n;
        v4u o; o.x = pk2(sp[0 * 33], sp[1 * 33]); o.y = pk2(sp[2 * 33], sp[3 * 33]); o.z = pk2(sp[4 * 33], sp[5 * 33]); o.w = pk2(sp[6 * 33], sp[7 * 33]);
        *(GAS v4u*)(WT + (size_t)(drow0 + n) * Kd + dk0 + 8 * c) = o; }
    LDS_WAIT(); asm volatile("" ::: "memory");
}
__device__ __forceinline__ void tr_item4(const float* W, size_t ldw, int k0, int n0, bf16* WT, size_t Kd, int drow0, int dk0, LAS float* scr, int lane, const float* kscale = nullptr) {
    f32x4 v[8]; tr4_load(v, W, ldw, k0, n0, lane, kscale); tr4_store(v, WT, Kd, drow0, dk0, scr, lane);
}
__device__ __forceinline__ int win_srccol(int r) { return r < 3328 ? r : r < 5888 ? r + 8 : r < 5896 ? r - 2560 : r < 5912 ? r : r < 6144 ? -1 : r - 232; }

__device__ __forceinline__ unsigned char* opaque_ptr(unsigned char* p) { GAS unsigned char* g = (GAS unsigned char*)p; asm volatile("" : "+s"(g)); return (unsigned char*)g; }
__device__ __forceinline__ int lane_id() { int x; asm volatile("v_mbcnt_lo_u32_b32 %0, -1, 0\n\tv_mbcnt_hi_u32_b32 %0, -1, %0" : "=v"(x)); return x; }
__device__ __forceinline__ float shfl_f(float v, int src) { return __int_as_float(__builtin_amdgcn_ds_bpermute(src << 2, __float_as_int(v))); }
__device__ __forceinline__ int shfl_i(int v, int src) { return __builtin_amdgcn_ds_bpermute(src << 2, v); }
__device__ __forceinline__ float shx(float v, int m, int lane) { return shfl_f(v, lane ^ m); }
template <int CTRL> __device__ __forceinline__ float dpp_f(float v) { return __builtin_bit_cast(float, __builtin_amdgcn_update_dpp(0, __builtin_bit_cast(int, v), CTRL, 0xF, 0xF, false)); }
__device__ __forceinline__ float sum8(float v) { v += dpp_f<0xB1>(v); v += dpp_f<0x4E>(v); v += dpp_f<0x141>(v); return v; }
__device__ __forceinline__ float sum16(float v) { v = sum8(v); v += dpp_f<0x140>(v); return v; }
template <int CTRL, int RMASK> __device__ __forceinline__ float dpp_fm(float v) { return __builtin_bit_cast(float, __builtin_amdgcn_update_dpp(0, __builtin_bit_cast(int, v), CTRL, RMASK, 0xF, true)); }
__device__ __forceinline__ float wave_scan(float v) {
    v += dpp_fm<0x111, 0xF>(v); v += dpp_fm<0x112, 0xF>(v); v += dpp_fm<0x114, 0xF>(v); v += dpp_fm<0x118, 0xF>(v);
    v += __builtin_bit_cast(float, __builtin_amdgcn_update_dpp(0, __builtin_bit_cast(int, v), 0x142, 0xA, 0xF, false));
    v += __builtin_bit_cast(float, __builtin_amdgcn_update_dpp(0, __builtin_bit_cast(int, v), 0x143, 0xC, 0xF, false));
    return v;
}
__device__ __forceinline__ float wsum(float v, int lane) {
    v = sum16(v); (void)lane;
    const float r0 = __builtin_bit_cast(float, __builtin_amdgcn_readlane(__builtin_bit_cast(int, v), 0)), r1 = __builtin_bit_cast(float, __builtin_amdgcn_readlane(__builtin_bit_cast(int, v), 16));
    const float r2 = __builtin_bit_cast(float, __builtin_amdgcn_readlane(__builtin_bit_cast(int, v), 32)), r3 = __builtin_bit_cast(float, __builtin_amdgcn_readlane(__builtin_bit_cast(int, v), 48));
    return (r0 + r1) + (r2 + r3);
}
#define LBAR() asm volatile("s_waitcnt lgkmcnt(0)\n\ts_barrier" ::: "memory")
#define PHASE_IDS const int wave = opaque_int(wave0), lane = lane_id(), tid = wave * 64 + lane; const int G = opaque_int((int)gridDim.x), bx = opaque_int((int)blockIdx.x); \
    const int vcu = (G % 8 == 0) ? (bx % 8) * (G / 8) + bx / 8 : bx; const int gw = vcu * NWAVES + wave, NGW = G * NWAVES; LAS float* scr = (LAS float*)(lds + RING_OFF + wave * 16384); (void)tid; (void)gw; (void)NGW; (void)scr; (void)lane
struct Args;
__device__ __forceinline__ int opaque_int(int i) { asm volatile("" : "+s"(i)); return i; }
struct Args { const float* in[N_IN]; float* out; unsigned char* ws; int prologue, l_lo, l_hi, ph_lo, ph_hi, pad; };
enum { PH_EXPW = 0, PH_INPROJ = 1, PH_PREP = 2, PH_LORA = 3, PH_MIX = 4, PH_FIN = 5, PH_MERGE = 6, PH_WOUT = 7, PH_LN1 = 8, PH_DISPATCH = 9, PH_GU = 10, PH_DOWN = 11, PH_LN2 = 12, PH_COUNT = 13 };

__global__ void __launch_bounds__(NWAVES * 64, 2) mk_fwd(Args a) {
    extern __shared__ __attribute__((aligned(16))) unsigned char lds_raw[];
    LAS unsigned char* lds = (LAS unsigned char*)lds_raw;
    const int wave0 = __builtin_amdgcn_readfirstlane((int)threadIdx.x >> 6);
    const int wave = wave0, lane = lane_id(), tid = wave * 64 + lane;
    const int G = gridDim.x; const int bx = blockIdx.x; const int vcu = (G % 8 == 0) ? (bx % 8) * (G / 8) + bx / 8 : bx;
    unsigned char* ws = a.ws;
    for (int u = tid; u < (LDS_BYTES - LDSCTL_OFF) / 4; u += NWAVES * 64) ((LAS unsigned*)(lds + LDSCTL_OFF))[u] = 0u;
    __syncthreads();
    const bool one_launch = a.prologue && (a.l_hi - a.l_lo) * (a.ph_hi - a.ph_lo) > 1;
    unsigned bar_x = 0u;
    if (one_launch) bar_x = xcd_barrier_post((unsigned*)(a.ws + WS_CTL) + CW_BAR, (volatile LAS unsigned*)(lds + MISC_OFF) + 8).x;
#define SEAM() do { if (a.prologue && (a.l_hi - a.l_lo) * (a.ph_hi - a.ph_lo) > 1) { XcdBarrier b2_; b2_.bar = (unsigned*)(opaque_ptr(a.ws) + WS_CTL) + CW_BAR; b2_.x = (unsigned)opaque_int((int)bar_x); b2_.st = (volatile LAS unsigned*)(lds + MISC_OFF) + 8; xcd_barrier(b2_); } } while (0)
    const int gw = vcu * NWAVES + wave, NGW = G * NWAVES;
    LAS float* scr = (LAS float*)(lds + RING_OFF + wave * 16384);

    if (a.prologue) {
        constexpr int I_WINI = 16 * 280, I_BRI = 8 * 32, I_WOI = 16 * 32, I_LAYER = I_WINI + 4 * I_BRI + I_WOI;
        auto dsc = [&](int it, const float*& W, size_t& ldw, int& k0, int& n0, bf16*& WT, size_t& Kd, int& drow0, int& dk0, const float*& ks) {
            const int l = it / I_LAYER; int r = it % I_LAYER; unsigned char* wl = ws + WS_WSMALL + (size_t)l * WL_STRIDE; ks = nullptr;
            if (r < I_WINI) { const int kb = r / 280, q = r % 280, nb = q < 184 ? q : q + 8;
                W = a.in[opaque_int(I_WIN)] + (size_t)l * D * IN_COLS; ldw = IN_COLS; k0 = 64 * kb; n0 = win_srccol(32 * nb); WT = (bf16*)(wl + WL_WIN); Kd = 1024; drow0 = 32 * nb; dk0 = 64 * kb; return; }
            r -= I_WINI;
            if (r < 4 * I_BRI) { const int sg = r / I_BRI, q = r % I_BRI, kb = q / 32, nb = q % 32;
                W = sg == 0 ? a.in[opaque_int(I_BRR)] + (size_t)l * 512 * D : sg == 1 ? a.in[opaque_int(I_BRF)] + (size_t)l * 512 * D : a.in[opaque_int(I_BRM)] + (size_t)l * 1024 * D + (size_t)(sg - 2) * 512 * D;
                ldw = D; k0 = 64 * kb; n0 = 32 * nb; WT = (bf16*)(wl + WL_BR + (size_t)sg * MiB); Kd = 512; drow0 = 32 * nb; dk0 = 64 * kb;
                if (sg >= 2) ks = a.in[I_NG] + (size_t)l * SSM_DIM + (size_t)(sg - 2) * 512; return; }
            r -= 4 * I_BRI;
            { const int kb = r / 32, nb = r % 32;
              W = a.in[opaque_int(I_WO)] + (size_t)l * D * D; ldw = D; k0 = 64 * kb; n0 = 32 * nb; WT = (bf16*)(wl + WL_WOUT); Kd = 1024; drow0 = 32 * nb; dk0 = 64 * kb; }
        };
        for (int it = gw; it < DEPTH * I_LAYER; it += 2 * NGW) {
            const float *W0, *W1, *ks0, *ks1; size_t ldw0, ldw1, Kd0, Kd1; int k00, k01, n00, n01, dr0, dr1, dk00, dk01; bf16 *WT0, *WT1;
            const bool two = it + NGW < DEPTH * I_LAYER;
            dsc(it, W0, ldw0, k00, n00, WT0, Kd0, dr0, dk00, ks0); dsc(two ? it + NGW : it, W1, ldw1, k01, n01, WT1, Kd1, dr1, dk01, ks1);
            f32x4 v0[8], v1[8];
            tr4_load(v0, W0, ldw0, k00, n00, lane, ks0); tr4_load(v1, W1, ldw1, k01, n01, lane, ks1);
            tr4_store(v0, WT0, Kd0, dr0, dk00, scr, lane);
            if (two) tr4_store(v1, WT1, Kd1, dr1, dk01, scr, lane);
        }
        for (int it = gw; it < DEPTH * 16 * 8; it += NGW) { const int l = it >> 7, kb = (it >> 3) & 15, nb = 184 + (it & 7);
            tr_item(a.in[opaque_int(I_WIN)] + (size_t)l * D * IN_COLS, IN_COLS, 64 * kb, win_srccol(32 * nb + (lane & 31)), (bf16*)(ws + WS_WSMALL + (size_t)l * WL_STRIDE + WL_WIN), 1024, 32 * nb, 64 * kb, scr, lane); }
        for (int it = gw; it < DEPTH * 64; it += NGW) {
            const int l = it >> 6, r = it & 63; bf16* LT = (bf16*)(ws + WS_WSMALL + (size_t)l * WL_STRIDE + WL_LORA);
            if (r < 16) tr_item4(a.in[I_WUP] + (size_t)l * 64 * 512, 512, 0, 32 * r, LT, 256, 32 * r, 0, scr, lane);
            else if (r < 32) tr_item4(a.in[I_AUP] + (size_t)l * 64 * 512, 512, 0, 32 * (r - 16), LT, 256, 512 + 32 * (r - 16), 64, scr, lane);
            else { const int q = r - 32, kb = q >> 4, nb = q & 15; tr_item4(a.in[I_GUP] + (size_t)l * 128 * 512, 512, 64 * kb, 32 * nb, LT, 256, 1024 + 32 * nb, 128 + 64 * kb, scr, lane); }
        }
        for (int idx = gw * 64 + lane; idx < DEPTH * 1536 * 32; idx += NGW * 64) {
            const int l = idx / (1536 * 32), r = idx % (1536 * 32), n = r >> 5, k8 = (r & 31) * 8;
            const bool nz = (n < 512) ? (k8 < 64) : (n < 1024) ? (k8 >= 64 && k8 < 128) : (k8 >= 128);
            if (!nz) *(GAS v4u*)((bf16*)(ws + WS_WSMALL + (size_t)l * WL_STRIDE + WL_LORA) + (size_t)n * 256 + k8) = (v4u){0u, 0u, 0u, 0u};
        }
        for (int m = gw; m < NTOK; m += 4 * NGW) {
            f32x4 v[4][4];
#pragma unroll
            for (int u = 0; u < 4; ++u) { const int mm = (m + u * NGW < NTOK) ? m + u * NGW : m; const GAS f32x4* xr = (const GAS f32x4*)(a.in[opaque_int(I_X)] + (size_t)mm * D) + lane;
#pragma unroll
                for (int j = 0; j < 4; ++j) v[u][j] = xr[64 * j]; }
#pragma unroll
            for (int u = 0; u < 4; ++u) { if (m + u * NGW >= NTOK) break; GAS unsigned long long* o8 = (GAS unsigned long long*)((bf16*)a.out + (size_t)(m + u * NGW) * D) + lane;
#pragma unroll
                for (int j = 0; j < 4; ++j) o8[64 * j] = (unsigned long long)pk2(v[u][j].x, v[u][j].y) | ((unsigned long long)pk2(v[u][j].z, v[u][j].w) << 32); }
        }
        SEAM();
    }
#define IN(k) (opaque_int(a.ph_lo) <= (k) && (k) < opaque_int(a.ph_hi))
    for (int l = a.l_lo; l < a.l_hi; ++l) {
        if (IN(PH_PREP)) { PHASE_IDS;
            unsigned char* ws = opaque_ptr(a.ws);
            constexpr int I_G = NEXP * 16 * 16, I_D = NEXP * 8 * 32;
            for (int it = gw; it < 2 * I_G + I_D; it += NGW) {
                if (it < 2 * I_G) { const int up = it >= I_G, r = it - up * I_G, e = r >> 8, q = r & 255, kb = q >> 4, nb = q & 15, n0 = 32 * nb;
                    const float* W = (up ? a.in[opaque_int(I_EU)] : a.in[opaque_int(I_EG)]) + ((size_t)l * NEXP + e) * D * DEXP;
                    tr_item4(W, DEXP, 64 * kb, n0, (bf16*)(ws + WS_WEXP + WEXP_GU) + (size_t)e * 1024 * 1024, 1024, 256 * (n0 >> 7) + (n0 & 127) + 128 * up, 64 * kb, scr, lane);
                } else { const int r = it - 2 * I_G, e = r >> 8, q = r & 255, kb = q >> 5, nb = q & 31;
                    const float* W = a.in[opaque_int(I_ED)] + ((size_t)l * NEXP + e) * DEXP * D;
                    tr_item4(W, D, 64 * kb, 32 * nb, (bf16*)(ws + WS_WEXP + WEXP_D) + (size_t)e * 1024 * 512, 512, 32 * nb, 64 * kb, scr, lane); }
            }
            __syncthreads();
        }
        if (IN(PH_INPROJ)) { PHASE_IDS;
            unsigned char* ws = opaque_ptr(a.ws); unsigned char* wl = ws + WS_WSMALL + (size_t)l * WL_STRIDE;
            pg8::DenseOrder S; S.init(a.out, wl + WL_WIN, NTOK, NPROJ, D, G, bx);
            pg8::EpiProj E{(bf16*)(ws + WS_PMIX), (bf16*)(ws + WS_PGATE), (float*)(ws + WS_MISC), a.in[opaque_int(I_GB)] + (size_t)l * 3 * D};
            pg8::gemm_phase<pg8::EpiProj, pg8::DenseOrder, true, true>(lds + RING_OFF, D, S, E, wave0);
        }
        if (IN(PH_INPROJ)) SEAM();
        if (IN(PH_PREP)) { PHASE_IDS;
            unsigned char* ws = opaque_ptr(a.ws);
            const bf16* pmix = (const bf16*)(ws + WS_PMIX);
            { const float* mu = a.in[I_MU] + (size_t)l * RWKV_COLS + 1536 + 4 * lane; const f32x4 m4 = *(const f32x4*)mu;
              bf16* lin = (bf16*)(ws + WS_LIN);
              for (int tokp = gw; tokp < NTOK; tokp += 4 * NGW) {
                  unsigned long long cw[4], pw[4];
#pragma unroll
                  for (int u = 0; u < 4; ++u) { const int tok = (tokp + u * NGW < NTOK) ? tokp + u * NGW : tokp;
                      cw[u] = *(const unsigned long long*)(pmix + (size_t)tok * PMIX_LD + C_RW + 1536 + 4 * lane);
                      pw[u] = 0ull; if (tok % SEQ) pw[u] = *(const unsigned long long*)(pmix + (size_t)(tok - 1) * PMIX_LD + C_RW + 1536 + 4 * lane); }
#pragma unroll
                  for (int u = 0; u < 4; ++u) { const int tok = tokp + u * NGW; if (tok >= NTOK) break;
                      float c[4], q[4];
                      c[0] = __uint_as_float((unsigned)cw[u] << 16); c[1] = __uint_as_float((unsigned)cw[u] & 0xffff0000u); c[2] = __uint_as_float((unsigned)(cw[u] >> 32) << 16); c[3] = __uint_as_float((unsigned)(cw[u] >> 32) & 0xffff0000u);
                      q[0] = __uint_as_float((unsigned)pw[u] << 16); q[1] = __uint_as_float((unsigned)pw[u] & 0xffff0000u); q[2] = __uint_as_float((unsigned)(pw[u] >> 32) << 16); q[3] = __uint_as_float((unsigned)(pw[u] >> 32) & 0xffff0000u);
#pragma unroll
                      for (int i = 0; i < 4; ++i) { float x = c[i] + m4[i] * (q[i] - c[i]); if (lane < 16) x = tanhf_(x); else if (lane >= 32) x = sigmoidf_(x); c[i] = x; }
                      *(unsigned long long*)(lin + (size_t)tok * 256 + 4 * lane) = (unsigned long long)pk2(c[0], c[1]) | ((unsigned long long)pk2(c[2], c[3]) << 32); }
              } }
            if (gw < BATCH * FOX_HEADS) {
                const int b = gw >> 3, h = gw & 7; const float fb = a.in[I_FB][l * FOX_HEADS + h];
                const float* misc = (const float*)(ws + WS_MISC); float* ck = (float*)(ws + WS_CK) + (size_t)gw * SEQ;
                float carry = 0.f;
#pragma unroll 4
                for (int s0 = 0; s0 < SEQ; s0 += 64) {
                    float v = -softplusf_(-(misc[((size_t)b * SEQ + s0 + lane) * 32 + h] + fb)) * 1.4426950408889634f;
                    v = wave_scan(v) + carry; ck[s0 + lane] = v; carry = __builtin_bit_cast(float, __builtin_amdgcn_readlane(__builtin_bit_cast(int, v), 63));
                }
            }
            for (int task = gw; task < BATCH * 16 * 16; task += NGW) {
                const int c = task & 15, h = (task >> 4) & 15, bb = task >> 8;
                const float A = -__expf(a.in[opaque_int(I_ALOG)][l * SSM_HEADS + h]), dtb = a.in[opaque_int(I_DTB)][l * SSM_HEADS + h];
                const float* misc = (const float*)(ws + WS_MISC); const size_t tok0 = (size_t)bb * SEQ + c * 128;
                const float d0 = softplusf_(misc[(tok0 + 2 * lane) * 32 + 8 + h] + dtb), d1 = softplusf_(misc[(tok0 + 2 * lane + 1) * 32 + 8 + h] + dtb);
                const float a0 = d0 * A, a1 = d1 * A; const float sc = wave_scan(a0 + a1);
                *(f32x4*)((float*)(ws + WS_DTCS) + (((size_t)(bb * 16 + h) * SEQ + c * 128 + 2 * lane) * 2)) = (f32x4){d0, sc - a1, d1, sc};
            }
            { int* rowtok = (int*)(ws + WS_ROWTOK); for (int idx = gw * 64 + lane; idx < MPAD; idx += NGW * 64) rowtok[idx] = 0; }
            for (int it = gw; it < BATCH * 32 * 3; it += NGW) {
                const int bb = it / 96, r = it % 96, c = r / 3, k = r % 3;
                if (c == 0) continue;
                const bf16* src = (const bf16*)(ws + WS_PMIX) + ((size_t)bb * SEQ + c * 64 - 3 + k) * PMIX_LD + C_SX;
                bf16* dst = (bf16*)(ws + WS_HALO) + (size_t)it * SSM_CONV_DIM;
#pragma unroll
                for (int j = 0; j < 3; ++j) *((v4u*)dst + lane + 64 * j) = *((const v4u*)src + lane + 64 * j);
            }
        }
        if (IN(PH_PREP)) SEAM();
        if (IN(PH_LORA)) { PHASE_IDS;
            unsigned char* ws = opaque_ptr(a.ws); unsigned char* wl = ws + WS_WSMALL + (size_t)l * WL_STRIDE;
            pg8::DenseOrder S; S.init(ws + WS_LIN, wl + WL_LORA, NTOK, 1536, 256, G, bx);
            pg8::EpiBf16<1536> E{(bf16*)(ws + WS_LOUT)};
            pg8::gemm_phase<pg8::EpiBf16<1536>, pg8::DenseOrder, true, true>(lds + RING_OFF, 256, S, E, wave0);
            {   const int lane = lane_id(), tid = wave * 64 + lane;
                const float* cwp = a.in[opaque_int(I_CW)] + (size_t)l * 4 * SSM_CONV_DIM; const float* cbp = a.in[opaque_int(I_CB)] + (size_t)l * SSM_CONV_DIM;
                for (int task = vcu * 384 + tid; tid < 384 && task < BATCH * 16 * 384; task += G * 384) {
                    const int oc = task % 192, r = task / 192, c = r & 31, bb = r >> 5;
                    float cw[4][8], cb[8];
#pragma unroll
                    for (int i = 0; i < 8; ++i) { cb[i] = cbp[8 * oc + i];
#pragma unroll
                        for (int w = 0; w < 4; ++w) cw[w][i] = cwp[w * SSM_CONV_DIM + 8 * oc + i]; }
                    bf16* rowp = (bf16*)(ws + WS_PMIX) + ((size_t)bb * SEQ + c * 64) * PMIX_LD + C_SX + 8 * oc;
                    float w1[8], w2[8], w3[8];
                    if (c == 0) {
#pragma unroll
                        for (int i = 0; i < 8; ++i) { w1[i] = 0.f; w2[i] = 0.f; w3[i] = 0.f; } }
                    else { const bf16* hp = (const bf16*)(ws + WS_HALO) + (size_t)((bb * 32 + c) * 3) * SSM_CONV_DIM + 8 * oc;
                        pg8::unpack8(*(const pg8::u32x4*)hp, w1); pg8::unpack8(*(const pg8::u32x4*)(hp + SSM_CONV_DIM), w2); pg8::unpack8(*(const pg8::u32x4*)(hp + 2 * SSM_CONV_DIM), w3); }
                    pg8::u32x4 raw[8], nxt[8];
#pragma unroll
                    for (int j = 0; j < 8; ++j) raw[j] = *(const pg8::u32x4*)(rowp + (size_t)j * PMIX_LD);
#pragma unroll 1
                    for (int t0 = 0; t0 < 64; t0 += 8) {
                        { const int tn = (t0 + 8 < 64) ? t0 + 8 : t0;
#pragma unroll
                          for (int j = 0; j < 8; ++j) nxt[j] = *(const pg8::u32x4*)(rowp + (size_t)(tn + j) * PMIX_LD); }
#pragma unroll
                        for (int j = 0; j < 8; ++j) {
                            float w0[8], o8[8];
#pragma unroll
                            for (int i = 0; i < 8; ++i) { w0[i] = w1[i]; w1[i] = w2[i]; w2[i] = w3[i]; }
                            pg8::unpack8(raw[j], w3);
#pragma unroll
                            for (int i = 0; i < 8; ++i) o8[i] = siluf_(cb[i] + cw[0][i] * w0[i] + cw[1][i] * w1[i] + cw[2][i] * w2[i] + cw[3][i] * w3[i]);
                            pg8::u32x4 pk; pk.x = pk2(o8[0], o8[1]); pk.y = pk2(o8[2], o8[3]); pk.z = pk2(o8[4], o8[5]); pk.w = pk2(o8[6], o8[7]);
                            *(pg8::u32x4*)(rowp + (size_t)(t0 + j) * PMIX_LD) = pk;
                        }
#pragma unroll
                        for (int j = 0; j < 8; ++j) raw[j] = nxt[j];
                    }
                }
            }
        }
        if (IN(PH_LORA)) SEAM();
        if (IN(PH_MIX)) { PHASE_IDS;
            unsigned char* ws = opaque_ptr(a.ws);
            unsigned* qhead = (unsigned*)(ws + WS_CTL) + CW_QUEUE + 64 * l;
            LAS int* qslot = (LAS int*)(lds + LDSCTL_OFF + 64);
            for (;;) {
                __syncthreads();
                if (tid == 0) qslot[0] = (int)atomicAdd(qhead, 1u);
                __syncthreads();
                const int unit = __builtin_amdgcn_readfirstlane(qslot[0]);
                if (unit >= 128 + 1024 + 256) break;
                if (unit < 128) {
                    constexpr int T = 32, BUF = 8 * T * 64;
                    const int wave = opaque_int(wave0), lane = lane_id();
                    const int b = unit >> 3, h = unit & 7;
                    LAS float* L0 = (LAS float*)lds;
                    const bf16* pmix = (const bf16*)(ws + WS_PMIX); const bf16* lout = (const bf16*)(ws + WS_LOUT); bf16* o_r = (bf16*)(ws + WS_OR);
                    __syncthreads();
                    if (wave >= 4) {
                        const int a4 = wave - 4, c4 = (lane & 15) * 4, ch = h * 64 + c4, tq = lane >> 4;
                        const f32x4 mu_r = *(const f32x4*)(a.in[opaque_int(I_MU)] + (size_t)l * RWKV_COLS + ch), mu_k = *(const f32x4*)(a.in[opaque_int(I_MU)] + (size_t)l * RWKV_COLS + 512 + ch), mu_v = *(const f32x4*)(a.in[opaque_int(I_MU)] + (size_t)l * RWKV_COLS + 1024 + ch);
                        const f32x4 w0 = *(const f32x4*)(a.in[opaque_int(I_W0)] + l * 512 + ch), a0 = *(const f32x4*)(a.in[opaque_int(I_A0)] + l * 512 + ch), kkw = *(const f32x4*)(a.in[opaque_int(I_KK)] + l * 512 + ch), kaw = *(const f32x4*)(a.in[opaque_int(I_KA)] + l * 512 + ch);
                        const f32x4 rk4 = *(const f32x4*)(a.in[opaque_int(I_RK)] + l * 512 + ch), gg4 = *(const f32x4*)(a.in[opaque_int(I_GNG)] + l * 512 + ch), gb4 = *(const f32x4*)(a.in[opaque_int(I_GNB)] + l * 512 + ch);
                        auto up4 = [](unsigned long long w, float* f) { f[0] = __uint_as_float((unsigned)w << 16); f[1] = __uint_as_float((unsigned)w & 0xffff0000u); f[2] = __uint_as_float((unsigned)(w >> 32) << 16); f[3] = __uint_as_float((unsigned)(w >> 32) & 0xffff0000u); };
                        unsigned long long R[2][9];
                        auto dload = [&](int c0) {
#pragma unroll
                            for (int u = 0; u < 2; ++u) { const int tt = 16 * u + 4 * a4 + tq; const size_t tok = (size_t)b * SEQ + c0 + tt; const bf16* pc = pmix + tok * PMIX_LD + C_RW + ch; const bf16* lo = lout + tok * 1536 + ch;
                                R[u][0] = *(const unsigned long long*)pc; R[u][1] = *(const unsigned long long*)(pc + 512); R[u][2] = *(const unsigned long long*)(pc + 1024);
                                if (c0 + tt > 0) { R[u][3] = *(const unsigned long long*)(pc - PMIX_LD); R[u][4] = *(const unsigned long long*)(pc - PMIX_LD + 512); R[u][5] = *(const unsigned long long*)(pc - PMIX_LD + 1024); } else { R[u][3] = 0ull; R[u][4] = 0ull; R[u][5] = 0ull; }
                                R[u][6] = *(const unsigned long long*)lo; R[u][7] = *(const unsigned long long*)(lo + 512); R[u][8] = *(const unsigned long long*)(lo + 1024); }
                        };
                        auto dcomp = [&](LAS float* Lb_) {
                            LAS float* Lr = Lb_; LAS float* Lw = Lr + T * 64; LAS float* Lk = Lw + T * 64; LAS float* Lv = Lk + T * 64; LAS float* La = Lv + T * 64; LAS float* Lbb = La + T * 64; LAS float* Lg = Lbb + T * 64;
#pragma unroll
                            for (int u = 0; u < 2; ++u) { const int tt = 16 * u + 4 * a4 + tq;
                                float cr[4], ck_[4], cv[4], pr[4], pk[4], pv[4], lw[4], la[4], lg[4];
                                up4(R[u][0], cr); up4(R[u][1], ck_); up4(R[u][2], cv); up4(R[u][3], pr); up4(R[u][4], pk); up4(R[u][5], pv); up4(R[u][6], lw); up4(R[u][7], la); up4(R[u][8], lg);
                                float kk[4], av[4], ss = 0.f;
#pragma unroll
                                for (int i = 0; i < 4; ++i) {
                                    cr[i] += mu_r[i] * (pr[i] - cr[i]); ck_[i] += mu_k[i] * (pk[i] - ck_[i]); cv[i] += mu_v[i] * (pv[i] - cv[i]);
                                    lw[i] = __expf(-0.6065306597126334f * sigmoidf_(w0[i] + lw[i]));
                                    av[i] = sigmoidf_(a0[i] + la[i]);
                                    kk[i] = ck_[i] * kkw[i]; ss += kk[i] * kk[i];
                                }
                                ss = sum16(ss);
                                const float inv = 1.f / fmaxf(sqrtf(ss), 1e-12f);
                                f32x4 o_r4, o_w4, o_k4, o_v4, o_a4, o_b4, o_g4;
#pragma unroll
                                for (int i = 0; i < 4; ++i) { const float kkn = kk[i] * inv; o_r4[i] = cr[i]; o_w4[i] = lw[i]; o_k4[i] = ck_[i] * (1.f + (av[i] - 1.f) * kaw[i]); o_v4[i] = cv[i]; o_a4[i] = -kkn; o_b4[i] = kkn * av[i]; o_g4[i] = lg[i]; }
                                *(LAS f32x4*)(Lr + tt * 64 + c4) = o_r4; *(LAS f32x4*)(Lw + tt * 64 + c4) = o_w4; *(LAS f32x4*)(Lk + tt * 64 + c4) = o_k4; *(LAS f32x4*)(Lv + tt * 64 + c4) = o_v4;
                                *(LAS f32x4*)(La + tt * 64 + c4) = o_a4; *(LAS f32x4*)(Lbb + tt * 64 + c4) = o_b4; *(LAS f32x4*)(Lg + tt * 64 + c4) = o_g4; }
                        };
                        auto post = [&](int c0, LAS float* Lb_) {
                            LAS float* Lr = Lb_; LAS float* Lk = Lr + 2 * T * 64; LAS float* Lv = Lk + T * 64; LAS float* Lg = Lr + 6 * T * 64; LAS float* Ly = Lg + T * 64;
#pragma unroll
                            for (int u = 0; u < 2; ++u) { const int tt = 16 * u + 4 * a4 + tq; const size_t tok = (size_t)b * SEQ + c0 + tt;
                                const f32x4 y4 = *(const LAS f32x4*)(Ly + tt * 64 + c4), r4 = *(const LAS f32x4*)(Lr + tt * 64 + c4), k4 = *(const LAS f32x4*)(Lk + tt * 64 + c4), v4 = *(const LAS f32x4*)(Lv + tt * 64 + c4), g4 = *(const LAS f32x4*)(Lg + tt * 64 + c4);
                                const float mean = sum16((y4[0] + y4[1]) + (y4[2] + y4[3])) * (1.f / 64.f);
                                float d[4], q = 0.f, pb = 0.f;
#pragma unroll
                                for (int i = 0; i < 4; ++i) { d[i] = y4[i] - mean; q += d[i] * d[i]; pb += r4[i] * k4[i] * rk4[i]; }
                                const float rs = rsqrtf(sum16(q) * (1.f / 64.f) + RWKV_GN_EPS);
                                const float bonus = sum16(pb);
                                float o[4];
#pragma unroll
                                for (int i = 0; i < 4; ++i) o[i] = (d[i] * rs * gg4[i] + gb4[i] + bonus * v4[i]) * g4[i];
                                *(unsigned long long*)(o_r + tok * 512 + ch) = (unsigned long long)pk2(o[0], o[1]) | ((unsigned long long)pk2(o[2], o[3]) << 32);
                            }
                        };
                        dload(0); dcomp(L0);
                        LBAR();
                        for (int c = 0; c < SEQ / T; ++c) {
                            if (c + 1 < SEQ / T) dload((c + 1) * T);
                            if (c > 0) post((c - 1) * T, L0 + ((c - 1) & 1) * BUF);
                            if (c + 1 < SEQ / T) dcomp(L0 + ((c + 1) & 1) * BUF);
                            LBAR();
                        }
                        post(SEQ - T, L0 + ((SEQ / T - 1) & 1) * BUF);
                    } else {
                        const int rg = lane >> 3, seg = lane & 7, row0 = 16 * wave + 2 * rg;
                        typedef float f32x2 __attribute__((ext_vector_type(2)));
                        f32x2 S0[4], S1[4];
#pragma unroll
                        for (int j = 0; j < 4; ++j) { S0[j] = (f32x2){0.f, 0.f}; S1[j] = (f32x2){0.f, 0.f}; }
                        LBAR();
                        __builtin_amdgcn_s_setprio(3);
                        for (int c = 0; c < SEQ / T; ++c) {
                            LAS float* Lr = L0 + (c & 1) * BUF; LAS float* Lw = Lr + T * 64; LAS float* Lk = Lw + T * 64; LAS float* Lv = Lk + T * 64; LAS float* La = Lv + T * 64; LAS float* Lbb = La + T * 64; LAS float* Ly = Lr + 7 * T * 64;
#define RW_LOAD(P, t) do { \
                                { const f32x4 x0 = *(const LAS f32x4*)(Lw + (t) * 64 + seg * 8), x1 = *(const LAS f32x4*)(Lw + (t) * 64 + seg * 8 + 4); P##w[0] = (f32x2){x0[0], x0[1]}; P##w[1] = (f32x2){x0[2], x0[3]}; P##w[2] = (f32x2){x1[0], x1[1]}; P##w[3] = (f32x2){x1[2], x1[3]}; } \
                                { const f32x4 x0 = *(const LAS f32x4*)(La + (t) * 64 + seg * 8), x1 = *(const LAS f32x4*)(La + (t) * 64 + seg * 8 + 4); P##a[0] = (f32x2){x0[0], x0[1]}; P##a[1] = (f32x2){x0[2], x0[3]}; P##a[2] = (f32x2){x1[0], x1[1]}; P##a[3] = (f32x2){x1[2], x1[3]}; } \
                                { const f32x4 x0 = *(const LAS f32x4*)(Lbb + (t) * 64 + seg * 8), x1 = *(const LAS f32x4*)(Lbb + (t) * 64 + seg * 8 + 4); P##b[0] = (f32x2){x0[0], x0[1]}; P##b[1] = (f32x2){x0[2], x0[3]}; P##b[2] = (f32x2){x1[0], x1[1]}; P##b[3] = (f32x2){x1[2], x1[3]}; } \
                                { const f32x4 x0 = *(const LAS f32x4*)(Lk + (t) * 64 + seg * 8), x1 = *(const LAS f32x4*)(Lk + (t) * 64 + seg * 8 + 4); P##k[0] = (f32x2){x0[0], x0[1]}; P##k[1] = (f32x2){x0[2], x0[3]}; P##k[2] = (f32x2){x1[0], x1[1]}; P##k[3] = (f32x2){x1[2], x1[3]}; } \
                                { const f32x4 x0 = *(const LAS f32x4*)(Lr + (t) * 64 + seg * 8), x1 = *(const LAS f32x4*)(Lr + (t) * 64 + seg * 8 + 4); P##r[0] = (f32x2){x0[0], x0[1]}; P##r[1] = (f32x2){x0[2], x0[3]}; P##r[2] = (f32x2){x1[0], x1[1]}; P##r[3] = (f32x2){x1[2], x1[3]}; } \
                                P##v0 = Lv[(t) * 64 + row0]; P##v1 = Lv[(t) * 64 + row0 + 1]; } while (0)
#define RW_STEP(P, t) do { \
                                f32x2 d0 = S0[0] * P##a[0], d1 = S1[0] * P##a[0]; \
                                _Pragma("unroll") for (int j = 1; j < 4; ++j) { d0 = S0[j] * P##a[j] + d0; d1 = S1[j] * P##a[j] + d1; } \
                                const float sa0 = sum8(d0.x + d0.y), sa1 = sum8(d1.x + d1.y); \
                                const f32x2 sa0v = (f32x2){sa0, sa0}, sa1v = (f32x2){sa1, sa1}, v0v = (f32x2){P##v0, P##v0}, v1v = (f32x2){P##v1, P##v1}; \
                                f32x2 y0 = (f32x2){0.f, 0.f}, y1 = (f32x2){0.f, 0.f}; \
                                _Pragma("unroll") for (int j = 0; j < 4; ++j) { \
                                    S0[j] = S0[j] * P##w[j] + (sa0v * P##b[j] + v0v * P##k[j]); \
                                    S1[j] = S1[j] * P##w[j] + (sa1v * P##b[j] + v1v * P##k[j]); \
                                    y0 = S0[j] * P##r[j] + y0; y1 = S1[j] * P##r[j] + y1; } \
                                float yy0 = sum8(y0.x + y0.y), yy1 = sum8(y1.x + y1.y); asm("" : "+v"(yy0), "+v"(yy1));     \
                                if (seg == 0) { Ly[(t) * 64 + row0] = yy0; Ly[(t) * 64 + row0 + 1] = yy1; } } while (0)
                            f32x2 Aw[4], Aa[4], Ab[4], Ak[4], Ar[4], Bw[4], Ba[4], Bb[4], Bk[4], Br[4]; float Av0, Av1, Bv0, Bv1;
                            RW_LOAD(A, 0);
                            for (int t = 0; t < T; t += 2) {
                                RW_LOAD(B, t + 1);
                                RW_STEP(A, t);
                                if (t + 2 < T) RW_LOAD(A, t + 2);
                                RW_STEP(B, t + 1);
                            }
#undef RW_LOAD
#undef RW_STEP
                            LBAR();
                        }
                        __builtin_amdgcn_s_setprio(0);
                    }
                } else if (unit >= 128 + 256) {
                    const int u2 = unit - 384, qb = 7 - (u2 >> 7), bh = u2 & 127;
                    attn_body::attn_unit<24>(bh >> 3, bh & 7, qb, (const attn_body::bf16*)(ws + WS_PMIX) + C_FQ, (const attn_body::bf16*)(ws + WS_PMIX) + C_FK, (const attn_body::bf16*)(ws + WS_PMIX) + C_FV,
                                            (attn_body::bf16*)(ws + WS_OF), (const float*)(ws + WS_CK) + (size_t)bh * SEQ, (char*)lds_raw, wave0);
                } else {
                    constexpr int LD = 136, XLD = 72;
                    typedef short bf16x8 __attribute__((ext_vector_type(8))); typedef short s16x4 __attribute__((ext_vector_type(4))); typedef float f32x2_t __attribute__((ext_vector_type(2)));
                    const int wave = opaque_int(wave0), lane = lane_id(), tid = wave * 64 + lane;
                    const int u3 = unit - 128, b = u3 >> 4, h = u3 & 15, g = h >> 3;
                    LAS bf16* Cm = (LAS bf16*)lds; LAS bf16* Bm = Cm + 128 * LD; LAS bf16* Xm = Bm + 128 * LD; LAS bf16* Xw = Xm + 128 * XLD; LAS bf16* St = Xw + 128 * XLD;
                    LAS float* Fd = (LAS float*)(St + 64 * LD); LAS float* Fc = Fd + 128;
                    const bf16* pmix = (const bf16*)(ws + WS_PMIX);
                    bf16* om = (bf16*)(ws + (g ? WS_OM1 : WS_OM0)); float* ssq = (float*)(ws + WS_SSQ);
                    const float* dtcs = (const float*)(ws + WS_DTCS) + (size_t)(b * 16 + h) * SEQ * 2;
                    const float Dh = a.in[opaque_int(I_DSK)][l * SSM_HEADS + h];
                    f32x4 accS[4];
#pragma unroll
                    for (int nt = 0; nt < 4; ++nt) accS[nt] = (f32x4){0.f, 0.f, 0.f, 0.f};
                    __syncthreads();
                    for (int i = tid; i < 64 * LD / 2; i += NWAVES * 64) ((LAS unsigned*)St)[i] = 0u;
                    pg8::u32x4 tb[8], tx[2]; f32x2_t tdc = (f32x2_t){0.f, 0.f};
                    auto request = [&](int c0) { const size_t tok0 = (size_t)b * SEQ + c0; const int o_bc = tid & 31;
#pragma unroll
                        for (int j = 0; j < 8; ++j) { const int ll = (tid >> 5) + 16 * j; tb[j] = *(const pg8::u32x4*)(pmix + (tok0 + ll) * PMIX_LD + C_SX + ((o_bc < 16) ? (1024 + g * 128 + 8 * o_bc) : (1280 + g * 128 + 8 * (o_bc - 16)))); }
#pragma unroll
                        for (int j = 0; j < 2; ++j) { const int ll = (tid >> 3) + 64 * j; tx[j] = *(const pg8::u32x4*)(pmix + (tok0 + ll) * PMIX_LD + C_SX + h * 64 + 8 * (tid & 7)); }
                        if (tid < 128) tdc = *(const f32x2_t*)(dtcs + (size_t)(c0 + tid) * 2); };
                    request(0);
                    for (int c0 = 0; c0 < SEQ; c0 += 128) {
                        LBAR();
                        const int lane = lane_id(), tid = wave * 64 + lane, fr = lane & 15, fq = lane >> 4;
                        const size_t tok0 = (size_t)b * SEQ + c0;
                        { const int o_bc = tid & 31;
#pragma unroll
                          for (int j = 0; j < 8; ++j) { const int ll = (tid >> 5) + 16 * j; *(LAS pg8::u32x4*)((o_bc < 16 ? Bm : Cm) + ll * LD + 8 * (o_bc & 15)) = tb[j]; }
#pragma unroll
                          for (int j = 0; j < 2; ++j) { const int ll = (tid >> 3) + 64 * j; *(LAS pg8::u32x4*)(Xm + ll * XLD + 8 * (tid & 7)) = tx[j]; }
                          if (tid < 128) { Fd[tid] = tdc.x; Fc[tid] = tdc.y; } }
                        if (c0 + 128 < SEQ) request(c0 + 128);
                        unsigned long long zr[4];
#pragma unroll
                        for (int nt = 0; nt < 4; ++nt) zr[nt] = *(const unsigned long long*)(pmix + (tok0 + 16 * wave + fr) * PMIX_LD + C_SZ + h * 64 + 16 * nt + 4 * fq);
                        LBAR();
                        const float cs_last = Fc[127];
#pragma unroll
                        for (int jj = 0; jj < 2; ++jj) {
                            const int idx = tid + NWAVES * 64 * jj, ll = idx >> 3, ox = idx & 7; const float wgt = __expf(cs_last - Fc[ll]) * Fd[ll];
                            float x8[8]; pg8::unpack8(*(const LAS pg8::u32x4*)(Xm + ll * XLD + 8 * ox), x8);
                            pg8::u32x4 pk; pk.x = pk2(x8[0] * wgt, x8[1] * wgt); pk.y = pk2(x8[2] * wgt, x8[3] * wgt); pk.z = pk2(x8[4] * wgt, x8[5] * wgt); pk.w = pk2(x8[6] * wgt, x8[7] * wgt);
                            *(LAS pg8::u32x4*)(Xw + ll * XLD + 8 * ox) = pk;
                        }
                        const int sbp = (int)((0x31322010u >> (4 * wave)) & 3u), lq = (int)((0x8Bu >> wave) & 1u), d0 = 2 * sbp - 4 * lq;
                        const int m1 = 32 * sbp, n1 = 64 * lq, m4 = 16 * wave;
                        f32x4 acc1[2][4];
#pragma unroll
                        for (int mt = 0; mt < 2; ++mt)
#pragma unroll
                            for (int nt = 0; nt < 4; ++nt) acc1[mt][nt] = (f32x4){0.f, 0.f, 0.f, 0.f};
                        if (d0 <= 3) {
#pragma unroll
                        for (int k0 = 0; k0 < 128; k0 += 32) {
                            bf16x8 af[2], bfv[4];
#pragma unroll
                            for (int mt = 0; mt < 2; ++mt) af[mt] = *(const LAS bf16x8*)(Bm + (m1 + 16 * mt + fr) * LD + k0 + 8 * fq);
#pragma unroll
                            for (int nt = 0; nt < 4; ++nt) bfv[nt] = *(const LAS bf16x8*)(Cm + (n1 + 16 * nt + fr) * LD + k0 + 8 * fq);
#pragma unroll
                            for (int mt = 0; mt < 2; ++mt)
#pragma unroll
                                for (int nt = 0; nt < 4; ++nt) if (nt >= d0 + mt) acc1[mt][nt] = __builtin_amdgcn_mfma_f32_16x16x32_bf16(af[mt], bfv[nt], acc1[mt][nt], 0, 0, 0);
                        }
                        }
                        f32x4 acc2[4];
#pragma unroll
                        for (int nt = 0; nt < 4; ++nt) acc2[nt] = (f32x4){0.f, 0.f, 0.f, 0.f};
#pragma unroll
                        for (int k0 = 0; k0 < 128; k0 += 32) {
                            const bf16x8 af = *(const LAS bf16x8*)(Cm + (m4 + fr) * LD + k0 + 8 * fq);
#pragma unroll
                            for (int nt = 0; nt < 4; ++nt) { const bf16x8 bfv = *(const LAS bf16x8*)(St + (16 * nt + fr) * LD + k0 + 8 * fq); acc2[nt] = __builtin_amdgcn_mfma_f32_16x16x32_bf16(bfv, af, acc2[nt], 0, 0, 0); }
                        }
                        LBAR();
                        if (d0 <= 4) {   float csl[4]; f32x4 css[2], dts[2];
#pragma unroll
                            for (int nt = 0; nt < 4; ++nt) csl[nt] = Fc[n1 + 16 * nt + fr];
#pragma unroll
                            for (int mt = 0; mt < 2; ++mt) { css[mt] = *(const LAS f32x4*)(Fc + m1 + 16 * mt + 4 * fq); dts[mt] = *(const LAS f32x4*)(Fd + m1 + 16 * mt + 4 * fq); }
#pragma unroll
                            for (int mt = 0; mt < 2; ++mt)
#pragma unroll
                                for (int nt = 0; nt < 4; ++nt) { const int ll = n1 + 16 * nt + fr, s0 = m1 + 16 * mt + 4 * fq;
                                    if (nt > d0 + mt) {
                                        float v[4];
#pragma unroll
                                        for (int r = 0; r < 4; ++r) v[r] = acc1[mt][nt][r] * __expf(csl[nt] - css[mt][r]) * dts[mt][r];
                                        *(LAS unsigned long long*)(Cm + ll * LD + s0) = (unsigned long long)pk2(v[0], v[1]) | ((unsigned long long)pk2(v[2], v[3]) << 32);
                                    } else if (nt == d0 + mt) {
                                        float v[4];
#pragma unroll
                                        for (int r = 0; r < 4; ++r) v[r] = (s0 + r <= ll) ? acc1[mt][nt][r] * __expf(csl[nt] - css[mt][r]) * dts[mt][r] + ((s0 + r == ll) ? Dh : 0.f) : 0.f;
                                        *(LAS unsigned long long*)(Cm + ll * LD + s0) = (unsigned long long)pk2(v[0], v[1]) | ((unsigned long long)pk2(v[2], v[3]) << 32);
                                    } else if (nt + 1 == d0 + mt) {
                                        *(LAS unsigned long long*)(Cm + ll * LD + s0) = 0ull;
                                    } }
                        }
                        LBAR();
                        const int q4 = (lane & 15) >> 2, p4 = lane & 3;
                        f32x4 acc3[4];
#pragma unroll
                        for (int nt = 0; nt < 4; ++nt) acc3[nt] = (f32x4){0.f, 0.f, 0.f, 0.f};
                        for (int k0 = 0; k0 < m4 + 16; k0 += 32) {
                            const bf16x8 af = *(const LAS bf16x8*)(Cm + (m4 + fr) * LD + k0 + 8 * fq);
#pragma unroll
                            for (int nt = 0; nt < 4; ++nt) {
                                const s16x4 lo = __builtin_bit_cast(s16x4, __builtin_amdgcn_ds_read_tr16_b64_v4i16((LAS s16x4*)(Xm + (k0 + 8 * fq + q4) * XLD + 16 * nt + 4 * p4)));
                                const s16x4 hi = __builtin_bit_cast(s16x4, __builtin_amdgcn_ds_read_tr16_b64_v4i16((LAS s16x4*)(Xm + (k0 + 8 * fq + 4 + q4) * XLD + 16 * nt + 4 * p4)));
                                const bf16x8 bfv = (bf16x8){lo[0], lo[1], lo[2], lo[3], hi[0], hi[1], hi[2], hi[3]};
                                acc3[nt] = __builtin_amdgcn_mfma_f32_16x16x32_bf16(bfv, af, acc3[nt], 0, 0, 0);
                            }
                        }
                        { const float dec = __expf(cs_last);
#pragma unroll
                          for (int nt = 0; nt < 4; ++nt) accS[nt] = accS[nt] * dec; }
#pragma unroll
                        for (int k0 = 0; k0 < 128; k0 += 32) {
                            const s16x4 alo = __builtin_bit_cast(s16x4, __builtin_amdgcn_ds_read_tr16_b64_v4i16((LAS s16x4*)(Bm + (k0 + 8 * fq + q4) * LD + m4 + 4 * p4)));
                            const s16x4 ahi = __builtin_bit_cast(s16x4, __builtin_amdgcn_ds_read_tr16_b64_v4i16((LAS s16x4*)(Bm + (k0 + 8 * fq + 4 + q4) * LD + m4 + 4 * p4)));
                            const bf16x8 af = (bf16x8){alo[0], alo[1], alo[2], alo[3], ahi[0], ahi[1], ahi[2], ahi[3]};
#pragma unroll
                            for (int nt = 0; nt < 4; ++nt) {
                                const s16x4 lo = __builtin_bit_cast(s16x4, __builtin_amdgcn_ds_read_tr16_b64_v4i16((LAS s16x4*)(Xw + (k0 + 8 * fq + q4) * XLD + 16 * nt + 4 * p4)));
                                const s16x4 hi = __builtin_bit_cast(s16x4, __builtin_amdgcn_ds_read_tr16_b64_v4i16((LAS s16x4*)(Xw + (k0 + 8 * fq + 4 + q4) * XLD + 16 * nt + 4 * p4)));
                                const bf16x8 bfv = (bf16x8){lo[0], lo[1], lo[2], lo[3], hi[0], hi[1], hi[2], hi[3]};
                                accS[nt] = __builtin_amdgcn_mfma_f32_16x16x32_bf16(af, bfv, accS[nt], 0, 0, 0);
                            }
                        }
                        {   const int ll = m4 + fr; const size_t tok = tok0 + ll; const float ecs = __expf(Fc[ll]);
                            float s2 = 0.f;
#pragma unroll
                            for (int nt = 0; nt < 4; ++nt) {
                                const float z4[4] = {__uint_as_float((unsigned)zr[nt] << 16), __uint_as_float((unsigned)zr[nt] & 0xffff0000u), __uint_as_float((unsigned)(zr[nt] >> 32) << 16), __uint_as_float((unsigned)(zr[nt] >> 32) & 0xffff0000u)};
                                float v[4];
#pragma unroll
                                for (int r = 0; r < 4; ++r) { const float y = acc3[nt][r] + ecs * acc2[nt][r]; v[r] = y * siluf_(z4[r]); s2 += v[r] * v[r]; }
                                *(unsigned long long*)(om + tok * 512 + (h & 7) * 64 + 16 * nt + 4 * fq) = (unsigned long long)pk2(v[0], v[1]) | ((unsigned long long)pk2(v[2], v[3]) << 32);
                            }
                            s2 += shx(s2, 16, lane); s2 += shx(s2, 32, lane);
                            if (fq == 0) ssq[tok * 16 + h] = s2;
                        }
#pragma unroll
                        for (int nt = 0; nt < 4; ++nt) *(LAS unsigned long long*)(St + (16 * nt + fr) * LD + m4 + 4 * fq) = (unsigned long long)pk2(accS[nt][0], accS[nt][1]) | ((unsigned long long)pk2(accS[nt][2], accS[nt][3]) << 32);
                    }
                }
            }
        }
        if (IN(PH_MIX)) SEAM();
        if (IN(PH_MERGE)) { PHASE_IDS;
            unsigned char* ws = opaque_ptr(a.ws); unsigned char* wl = ws + WS_WSMALL + (size_t)l * WL_STRIDE;
            pg8::MergeOrder S; S.tm.init(NTOK, D, G, bx); S.tstep = (size_t)256 * 512 * 2; S.segA = 32 * MiB; S.segB = MiB;
            S.A = (const char*)(ws + WS_OR); S.Bt = (const char*)(wl + WL_BR);
            pg8::EpiMerge E{(const bf16*)(ws + WS_PGATE), (bf16*)(ws + WS_MERGED), (const float*)(ws + WS_SSQ)};
            pg8::gemm_phase<pg8::EpiMerge, pg8::MergeOrder, true, true>(lds + RING_OFF, 512, S, E, wave0);
        }
        if (IN(PH_MERGE)) SEAM();
        if (IN(PH_WOUT)) { PHASE_IDS;
            unsigned char* ws = opaque_ptr(a.ws); unsigned char* wl = ws + WS_WSMALL + (size_t)l * WL_STRIDE;
            pg8::DenseOrder S; S.init(ws + WS_MERGED, wl + WL_WOUT, NTOK, D, D, G, bx);
            pg8::EpiRes E{(const bf16*)a.out, (bf16*)(ws + WS_X1), ALPHA};
            pg8::gemm_phase<pg8::EpiRes, pg8::DenseOrder, true, true>(lds + RING_OFF, D, S, E, wave0);
        }
        if (IN(PH_WOUT)) SEAM();
        if (IN(PH_LN1)) { PHASE_IDS;
            unsigned char* ws = opaque_ptr(a.ws);
            LAS float* WT = (LAS float*)lds;
            { const float* rw = a.in[opaque_int(I_RW)];
              f32x4 rv[16];
#pragma unroll
              for (int i = 0; i < 16; ++i) rv[i] = *(const f32x4*)(rw + 4 * (tid + 512 * i));
#pragma unroll
              for (int i = 0; i < 16; ++i) { const int q = tid + 512 * i, d = q >> 3, e0 = (q & 7) * 4; LAS float* wp = WT + e0 * ROUTER_LD + d;
                  wp[0] = rv[i].x; wp[ROUTER_LD] = rv[i].y; wp[2 * ROUTER_LD] = rv[i].z; wp[3 * ROUTER_LD] = rv[i].w; } }
            __syncthreads();
            const bf16* X1 = (const bf16*)(ws + WS_X1); bf16* XBp = (bf16*)(ws + WS_XB);
            float* gatew = (float*)(ws + WS_GATEW); int* pos = (int*)(ws + WS_POS);
            unsigned* cnt = (unsigned*)(ws + WS_CTL) + CW_CNT + 1024 * l;
            const float* lg = a.in[opaque_int(I_L1G)] + (size_t)l * D; const float* lb = a.in[opaque_int(I_L1B)] + (size_t)l * D; const float* rbias = a.in[opaque_int(I_RB)];
            int me0 = 0, me1 = 0, kt = 0, tokb = gw; float mw0 = 1.f, mw1 = 1.f;
#define LN1_FLUSH() do { if (lane < kt) { const int tk_ = tokb + lane * NGW; const float inv_ = 1.f / (mw0 + mw1); \
                gatew[(size_t)tk_ * 2] = mw0 * inv_; gatew[(size_t)tk_ * 2 + 1] = mw1 * inv_; \
                const unsigned s0_ = atomicAdd(&cnt[me0 * CNT_STRIDE], 1u), s1_ = atomicAdd(&cnt[me1 * CNT_STRIDE], 1u); \
                pos[(size_t)tk_ * 2] = (int)(((unsigned)me0 << 16) | s0_); pos[(size_t)tk_ * 2 + 1] = (int)(((unsigned)me1 << 16) | s1_); } } while (0)
            for (int tokp = gw; tokp < NTOK; tokp += 2 * NGW, kt += 2) {
                if (kt == 64) { LN1_FLUSH(); kt = 0; tokb = tokp; }
                const bool two = tokp + NGW < NTOK;
                f32x4 v[2][4]; float sm[2];
#pragma unroll
                for (int u = 0; u < 2; ++u) { const int tok = (u && two) ? tokp + NGW : tokp; const bf16* row = X1 + (size_t)tok * D; sm[u] = 0.f;
#pragma unroll
                    for (int j = 0; j < 4; ++j) { const unsigned long long xw = *(const unsigned long long*)(row + 4 * lane + 256 * j);
                        v[u][j] = (f32x4){__uint_as_float((unsigned)xw << 16), __uint_as_float((unsigned)xw & 0xffff0000u), __uint_as_float((unsigned)(xw >> 32) << 16), __uint_as_float((unsigned)(xw >> 32) & 0xffff0000u)}; sm[u] += (v[u][j].x + v[u][j].y) + (v[u][j].z + v[u][j].w); } }
                float mean[2], s2[2], rstd[2];
#pragma unroll
                for (int u = 0; u < 2; ++u) mean[u] = wsum(sm[u], lane) * (1.f / D);
#pragma unroll
                for (int u = 0; u < 2; ++u) { s2[u] = 0.f;
#pragma unroll
                    for (int j = 0; j < 4; ++j) { v[u][j] = v[u][j] - mean[u]; s2[u] += (v[u][j].x * v[u][j].x + v[u][j].y * v[u][j].y) + (v[u][j].z * v[u][j].z + v[u][j].w * v[u][j].w); } }
#pragma unroll
                for (int u = 0; u < 2; ++u) rstd[u] = rsqrtf(wsum(s2[u], lane) * (1.f / D) + LN_EPS);
#pragma unroll
                for (int j = 0; j < 4; ++j) { const f32x4 g = *(const f32x4*)(lg + 4 * lane + 256 * j), b = *(const f32x4*)(lb + 4 * lane + 256 * j);
#pragma unroll
                    for (int u = 0; u < 2; ++u) v[u][j] = v[u][j] * rstd[u] * g + b; }
#pragma unroll
                for (int u = 0; u < 2; ++u) { if (u && !two) break; const int tok = tokp + u * NGW;
#pragma unroll
                    for (int j = 0; j < 4; ++j) {
                        *(unsigned long long*)(XBp + (size_t)tok * D + 4 * lane + 256 * j) = (unsigned long long)pk2(v[u][j].x, v[u][j].y) | ((unsigned long long)pk2(v[u][j].z, v[u][j].w) << 32); } }
                float p[2][32];
                typedef float f32x2r __attribute__((ext_vector_type(2)));
                f32x2r vv[4][4];
#pragma unroll
                for (int j = 0; j < 4; ++j) { vv[j][0] = (f32x2r){v[0][j].x, v[1][j].x}; vv[j][1] = (f32x2r){v[0][j].y, v[1][j].y}; vv[j][2] = (f32x2r){v[0][j].z, v[1][j].z}; vv[j][3] = (f32x2r){v[0][j].w, v[1][j].w}; }
#pragma unroll
                for (int e = 0; e < 32; ++e) { const LAS f32x4* w = (const LAS f32x4*)(WT + e * ROUTER_LD) + lane; f32x2r a01 = (f32x2r){0.f, 0.f}, b01 = (f32x2r){0.f, 0.f};
#pragma unroll
                    for (int j = 0; j < 4; ++j) { const f32x4 ww = w[64 * j];
                        a01 = vv[j][0] * (f32x2r){ww.x, ww.x} + a01; b01 = vv[j][1] * (f32x2r){ww.y, ww.y} + b01; a01 = vv[j][2] * (f32x2r){ww.z, ww.z} + a01; b01 = vv[j][3] * (f32x2r){ww.w, ww.w} + b01; }
                    a01 = a01 + b01; p[0][e] = a01.x; p[1][e] = a01.y; if ((e & 3) == 3) asm volatile("" ::: "memory"); }
#define RSTEP(N, B) _Pragma("unroll") for (int k = 0; k < (N) / 2; ++k) { _Pragma("unroll") for (int u = 0; u < 2; ++u) { const float send = (lane & (B)) ? p[u][k] : p[u][k + (N) / 2]; const float keep = (lane & (B)) ? p[u][k + (N) / 2] : p[u][k]; p[u][k] = keep + shx(send, (B), lane); } }
                RSTEP(32, 32) RSTEP(16, 16) RSTEP(8, 8) RSTEP(4, 4) RSTEP(2, 2)
#undef RSTEP
                const int e = lane & 31; const float rb_e = rbias[e]; const int gbase = lane & ~7;
#pragma unroll
                for (int u = 0; u < 2; ++u) {
                    p[u][0] += shx(p[u][0], 1, lane);
                    const float logit = shfl_f(p[u][0], 2 * (lane & 31));
                    const float aff = sigmoidf_(logit);
                    const float sel = aff + rb_e;
                    float t1 = -INFINITY, t2 = -INFINITY; int i1 = -1, i2 = -1;
#pragma unroll
                    for (int k = 0; k < 8; ++k) {
                        const float uu = shfl_f(sel, gbase + k); const int ui = (gbase + k) & 31;
                        if (uu > t1) { t2 = t1; i2 = i1; t1 = uu; i1 = ui; } else if (uu > t2) { t2 = uu; i2 = ui; }
                    }
                    const float gs = t1 + t2;
                    float best = -INFINITY; int bg = 0;
#pragma unroll
                    for (int g = 0; g < 4; ++g) { const float uu = shfl_f(gs, g * 8); if (uu > best) { best = uu; bg = g; } }
                    const int e0 = shfl_i(i1, bg * 8), e1 = shfl_i(i2, bg * 8);
                    const float w0 = shfl_f(aff, e0), w1 = shfl_f(aff, e1);
                    if (lane == kt + u && (u == 0 || two)) { me0 = e0; me1 = e1; mw0 = w0; mw1 = w1; }
                }
                if (!two) --kt;
            }
            LN1_FLUSH();
#undef LN1_FLUSH
        }
        if (IN(PH_LN1)) SEAM();
        if (IN(PH_DISPATCH)) { PHASE_IDS;
            unsigned char* ws = opaque_ptr(a.ws);
            LAS int* ltab = (LAS int*)(lds + LTAB_OFF);
            const unsigned* cnt = (const unsigned*)(ws + WS_CTL) + CW_CNT + 1024 * l;
            if (wave == 0) {
                const int c = (lane < 32) ? (int)__hip_atomic_load(cnt + (lane & 31) * CNT_STRIDE, __ATOMIC_RELAXED, __HIP_MEMORY_SCOPE_AGENT) : 0;
                const int nb = (c + 255) >> 8; int inc = nb;
#pragma unroll
                for (int o = 1; o < 64; o <<= 1) { const int u = shfl_i(inc, lane - o); if (lane >= o) inc += u; }
                const int exc = inc - nb;
                if (lane < 32) ltab[lane] = exc * 256;
                if (bx == 0) { int* tab = (int*)(ws + WS_TAB); if (lane == 31) tab[0] = inc; if (lane < 32) for (int b = 0; b < nb; ++b) tab[1 + exc + b] = lane; }
            }
            __syncthreads();
            int* pos = (int*)(ws + WS_POS); int* rowtok = (int*)(ws + WS_ROWTOK);
            for (int tok = gw * 64 + lane; tok < NTOK; tok += NGW * 64) {
                const int p0 = pos[(size_t)tok * 2], p1 = pos[(size_t)tok * 2 + 1];
                const int r0 = ltab[(p0 >> 16) & 31] + (p0 & 0xffff), r1 = ltab[(p1 >> 16) & 31] + (p1 & 0xffff);
                rowtok[r0] = tok; rowtok[r1] = tok; pos[(size_t)tok * 2] = r0; pos[(size_t)tok * 2 + 1] = r1;
            }
        }
        if (IN(PH_DISPATCH)) SEAM();
        if (IN(PH_GU) || IN(PH_DOWN)) { PHASE_IDS;
            unsigned char* ws = opaque_ptr(a.ws);
            LAS int* ltab = (LAS int*)(lds + LTAB_OFF);
            const int* tab = (const int*)(ws + WS_TAB);
            for (int i = tid; i < 1 + MPAD / 256; i += NWAVES * 64) ltab[i] = tab[i];
            __syncthreads();
            if (IN(PH_GU)) { PHASE_IDS;
                LAS int* ltok = (LAS int*)(lds + LTOK_OFF);
                pg8::GroupGatherOrder S; S.tab = ltab; S.ltok = ltok; S.A = (const char*)(ws + WS_XB); S.Bt = (const char*)(ws + WS_WEXP + WEXP_GU); S.tstepA = (size_t)256 * 1024 * 2; S.tstepB = (size_t)256 * 1024 * 2; S.estride = (size_t)1024 * 1024 * 2; S.nN = 4; S.G = G; S.c = bx;
                { const int* rowtok = (const int*)(ws + WS_ROWTOK);
                  const int nbk = __builtin_amdgcn_readfirstlane(ltab[0]);
#pragma unroll 1
                  for (int i = 0; i < LTOK_UNITS; ++i) { const int rb = ((G & 31) == 0) ? i * (G >> 2) + (bx & 7) * (G >> 5) + (bx >> 5) : (i * G + bx) >> 2;
                      if (rb >= nbk) break; if (tid < 256) ltok[256 * i + tid] = rowtok[256 * rb + tid]; }
                  __syncthreads(); }
                pg8::EpiSwiGLU E{(bf16*)(ws + WS_H)};
                pg8::gemm_phase<pg8::EpiSwiGLU, pg8::GroupGatherOrder, true, true>(lds + RING_OFF, D, S, E, wave0);
            }
        }
        if (IN(PH_GU)) SEAM();
        if (IN(PH_DOWN)) { PHASE_IDS;
            unsigned char* ws = opaque_ptr(a.ws);
            LAS int* ltab = (LAS int*)(lds + LTAB_OFF);
            pg8::GroupOrder S; S.tab = ltab; S.A = (const char*)(ws + WS_H); S.Bt = (const char*)(ws + WS_WEXP + WEXP_D); S.tstepA = (size_t)256 * 512 * 2; S.tstepB = (size_t)256 * 512 * 2; S.estride = (size_t)1024 * 512 * 2; S.nN = 4; S.G = G; S.c = bx;
            pg8::EpiBf16<1024> E{(bf16*)(ws + WS_YS)};
            pg8::gemm_phase<pg8::EpiBf16<1024>, pg8::GroupOrder, true, true>(lds + RING_OFF, DEXP, S, E, wave0);
        }
        if (IN(PH_DOWN)) SEAM();
        if (IN(PH_LN2)) { PHASE_IDS;
            unsigned char* ws = opaque_ptr(a.ws);
            const bf16* X1b = (const bf16*)(ws + WS_XB); const bf16* YS = (const bf16*)(ws + WS_YS); bf16* XBXp = (bf16*)a.out; const bool lastl = (l == DEPTH - 1);
            const float* gatew = (const float*)(ws + WS_GATEW); const int* pos = (const int*)(ws + WS_POS);
            const float* lg = a.in[opaque_int(I_L2G)] + (size_t)l * D; const float* lb = a.in[opaque_int(I_L2B)] + (size_t)l * D;
            for (int tokp = gw; tokp < NTOK; tokp += 4 * NGW) {
                f32x4 v[4][4]; float sm[4];
#pragma unroll
                for (int u = 0; u < 4; ++u) {
                    const int tok = (tokp + u * NGW < NTOK) ? tokp + u * NGW : tokp;
                    const float g0 = gatew[(size_t)tok * 2], g1 = gatew[(size_t)tok * 2 + 1];
                    const int r0 = pos[(size_t)tok * 2], r1 = pos[(size_t)tok * 2 + 1];
                    sm[u] = 0.f;
#pragma unroll
                    for (int j = 0; j < 4; ++j) {
                        const int c = 4 * lane + 256 * j;
                        const unsigned long long xw = *(const unsigned long long*)(X1b + (size_t)tok * D + c);
                        const f32x4 xv = (f32x4){__uint_as_float((unsigned)xw << 16), __uint_as_float((unsigned)xw & 0xffff0000u), __uint_as_float((unsigned)(xw >> 32) << 16), __uint_as_float((unsigned)(xw >> 32) & 0xffff0000u)};
                        const unsigned long long ya = *(const unsigned long long*)(YS + (size_t)r0 * D + c), yb = *(const unsigned long long*)(YS + (size_t)r1 * D + c);
                        const f32x4 y0 = (f32x4){__uint_as_float((unsigned)ya << 16), __uint_as_float((unsigned)ya & 0xffff0000u), __uint_as_float((unsigned)(ya >> 32) << 16), __uint_as_float((unsigned)(ya >> 32) & 0xffff0000u)};
                        const f32x4 y1 = (f32x4){__uint_as_float((unsigned)yb << 16), __uint_as_float((unsigned)yb & 0xffff0000u), __uint_as_float((unsigned)(yb >> 32) << 16), __uint_as_float((unsigned)(yb >> 32) & 0xffff0000u)};
                        v[u][j] = xv * ALPHA + (y0 * g0 + y1 * g1);
                        sm[u] += (v[u][j].x + v[u][j].y) + (v[u][j].z + v[u][j].w);
                    }
                }
                float mean[4], s2[4], rstd[4];
#pragma unroll
                for (int u = 0; u < 4; ++u) mean[u] = wsum(sm[u], lane) * (1.f / D);
#pragma unroll
                for (int u = 0; u < 4; ++u) { s2[u] = 0.f;
#pragma unroll
                    for (int j = 0; j < 4; ++j) { v[u][j] = v[u][j] - mean[u]; s2[u] += (v[u][j].x * v[u][j].x + v[u][j].y * v[u][j].y) + (v[u][j].z * v[u][j].z + v[u][j].w * v[u][j].w); } }
#pragma unroll
                for (int u = 0; u < 4; ++u) rstd[u] = rsqrtf(wsum(s2[u], lane) * (1.f / D) + LN_EPS);
#pragma unroll
                for (int u = 0; u < 4; ++u) {
                    const int tok = tokp + u * NGW; if (tok >= NTOK) break;
#pragma unroll
                    for (int j = 0; j < 4; ++j) {
                        const int c = 4 * lane + 256 * j;
                        const f32x4 g = *(const f32x4*)(lg + c), b = *(const f32x4*)(lb + c);
                        const f32x4 o = v[u][j] * rstd[u] * g + b;
                        if (lastl) *(f32x4*)(a.out + (size_t)tok * D + c) = o;
                        else *(unsigned long long*)(XBXp + (size_t)tok * D + c) = (unsigned long long)pk2(o.x, o.y) | ((unsigned long long)pk2(o.z, o.w) << 32);
                    }
                }
            }
        }
        if (IN(PH_LN2)) SEAM();
    }
#undef IN
}

#ifndef MK_ONE_LAUNCH
#define MK_ONE_LAUNCH 1
#endif
static void launch_mk(const Args& base, int grid, hipStream_t stream, int prologue, int l_lo, int l_hi, int ph_lo, int ph_hi) {
    Args a = base; a.prologue = prologue; a.l_lo = l_lo; a.l_hi = l_hi; a.ph_lo = ph_lo; a.ph_hi = ph_hi; a.pad = 0;
    hipLaunchKernelGGL(mk_fwd, dim3(grid), dim3(NWAVES * 64), LDS_BYTES, stream, a);
}
extern "C" void kernel_launch(void* const* d_in, const int* in_sizes, int n_in, void* d_out, int out_size, void* d_ws, size_t ws_size, hipStream_t stream) {
    static int grid = 0;
    if (grid == 0) {
        if (n_in != N_IN || ws_size < WS_END || out_size != NTOK * D) { fprintf(stderr, "kernel_launch: unexpected n_in %d, out_size %d or ws_size %zu\n", n_in, out_size, ws_size); grid = -1; return; }
        int dev = 0, cus = 0;
        if (hipGetDevice(&dev) != hipSuccess || hipDeviceGetAttribute(&cus, hipDeviceAttributeMultiprocessorCount, dev) != hipSuccess) { grid = -1; return; }
        if (hipFuncSetAttribute((const void*)mk_fwd, hipFuncAttributeMaxDynamicSharedMemorySize, LDS_BYTES) != hipSuccess) { fprintf(stderr, "kernel_launch: hipFuncSetAttribute failed\n"); grid = -1; return; }
        int per_cu = 0;
        if (hipOccupancyMaxActiveBlocksPerMultiprocessor(&per_cu, (const void*)mk_fwd, NWAVES * 64, LDS_BYTES) != hipSuccess || per_cu < 1) fprintf(stderr, "kernel_launch: occupancy query reports %d blocks per CU\n", per_cu);
        (void)hipGetLastError();
        grid = cus;
    }
    if (grid < 0) return;
    (void)hipMemsetAsync((char*)d_ws + WS_CTL, 0, CTL_ZERO_BYTES, stream);
    Args base{};
    for (int i = 0; i < N_IN; ++i) base.in[i] = (const float*)d_in[i];
    base.out = (float*)d_out; base.ws = (unsigned char*)d_ws;
#if MK_ONE_LAUNCH
    launch_mk(base, grid, stream, 1, 0, DEPTH, 0, PH_COUNT);
#else
    launch_mk(base, grid, stream, 1, 0, 0, 0, 0);
    for (int l = 0; l < DEPTH; ++l)
        for (int ph = 1; ph < PH_COUNT; ++ph) launch_mk(base, grid, stream, 0, l, l + 1, ph, ph + 1);
#endif
}
```

```cpp
#include <hip/hip_runtime.h>
#include <cstdio>
#include <cstdint>

constexpr int D = 1024, BATCH = 16, SEQ = 2048, DEPTH = 4, NTOK = BATCH * SEQ;
constexpr int FOX_HEADS = 8;
constexpr int SSM_DIM = 1024, SSM_HEADS = 16, SSM_CONV_DIM = 1536;
constexpr int RWKV_COLS = 1792;
constexpr int IN_COLS = 8984;
constexpr int NEXP = 32, DEXP = 512;
constexpr float ALPHA = 1.681792830507429f;
constexpr float LN_EPS = 1e-5f, NORM_EPS = 1e-5f, RWKV_GN_EPS = 64e-5f;
constexpr int PMIX_LD = 5888, PGATE_LD = 3072, NPROJ = 9216;
constexpr int C_RW = 0, C_FQ = 1792, C_FK = 2304, C_FV = 2816, C_SZ = 3328, C_SX = 4352;
enum { I_X = 0, I_WIN, I_MU, I_W0, I_WUP, I_A0, I_AUP, I_GUP, I_KK, I_KA, I_RK, I_GNG, I_GNB, I_FB, I_CW, I_CB, I_DTB, I_ALOG, I_DSK, I_NG, I_GB, I_BRR, I_BRF, I_BRM, I_WO,
       I_L1G, I_L1B, I_RW, I_RB, I_EG, I_EU, I_ED, I_L2G, I_L2B, N_IN };

typedef float f32x4 __attribute__((ext_vector_type(4)));
typedef float f32x16 __attribute__((ext_vector_type(16)));
typedef unsigned short bf16;

__device__ __forceinline__ float sigmoidf_(float x) { return __builtin_amdgcn_rcpf(1.f + __expf(-x)); }
__device__ __forceinline__ float softplusf_(float x) { const float e = __expf(-fabsf(x)); return fmaxf(x, 0.f) + __logf(1.f + e); }
__device__ __forceinline__ float siluf_(float x) { return x * __builtin_amdgcn_rcpf(1.f + __expf(-x)); }
__device__ __forceinline__ float tanhf_(float x) { const float e = __expf(-2.f * fabsf(x)); const float t = (1.f - e) * __builtin_amdgcn_rcpf(1.f + e); return x < 0.f ? -t : t; }
__device__ __forceinline__ float wave_sum(float v) {
#pragma unroll
    for (int o = 1; o < 64; o <<= 1) v += __shfl_xor(v, o);
    return v;
}
__device__ __forceinline__ float bf2f(bf16 b) { return __uint_as_float((unsigned)b << 16); }

namespace pg8 {
#define PG8_LAS __attribute__((address_space(3)))
typedef unsigned short bf16_t;
typedef short bf16x8 __attribute__((ext_vector_type(8)));
typedef float f32x4 __attribute__((ext_vector_type(4)));
typedef unsigned u32x4 __attribute__((ext_vector_type(4)));
constexpr int BM = 256, BK = 64, HALF = 128, HTB = HALF * BK * 2  , STAGE_BYTES = 8 * HTB, NXCD = 8, WGM = 8;

__host__ __device__ __forceinline__ int lds_byte(int r, int c) { const int st = (r >> 4) * 2 + (c >> 5), rr = r & 15, cc = c & 31, ob = rr * 64 + cc * 2; return st * 1024 + (ob ^ (((ob >> 9) & 1) << 5)); }
__host__ __device__ __forceinline__ void stage_rc(int b, int& R, int& C) { const int st = b / 1024, sb = b % 1024, swz = sb ^ (((sb >> 9) & 1) << 5); R = (st >> 1) * 16 + swz / 64; C = (st & 1) * 32 + (swz % 64) / 2; }
__host__ __device__ __forceinline__ int perm32(int rho) { const int n = rho >> 4, i = rho & 15; return 8 * (i >> 2) + 4 * n + (i & 3); }

#define PG8_GAS __attribute__((address_space(1)))
struct Unit { int pm, pn, pb, seg, last; };

typedef float f32x2_t __attribute__((ext_vector_type(2))); typedef __bf16 bf16x2_t __attribute__((ext_vector_type(2)));
__device__ __forceinline__ unsigned cvt_pk_bf16(float lo, float hi) { f32x2_t v = {lo, hi}; bf16x2_t b = __builtin_convertvector(v, bf16x2_t); return __builtin_bit_cast(unsigned, b); }

struct TileMap {
    int nM, nN, nwg, G, c;
    __device__ void init(int M, int N, int G_, int c_) { nM = M / BM; nN = N / BM; nwg = nM * nN; G = G_; c = c_; }
    __device__ bool tile(int i, int& pm, int& pn) const {
        const long L = (long)i * G + c; if (L >= nwg) return false;
        int wgid = (int)L; { const int q = nwg / NXCD, r = nwg % NXCD, xcd = wgid % NXCD, off = wgid / NXCD; wgid = (xcd < r ? xcd * (q + 1) : r * (q + 1) + (xcd - r) * q) + off; }
        const int nig = WGM * nN, gid = wgid / nig, fm = gid * WGM, gsz = (nM - fm) < WGM ? (nM - fm) : WGM;
        pm = fm + ((wgid % nig) % gsz); pn = (wgid % nig) / gsz; return true;
    }
};
struct DenseOrder {
    static constexpr bool GATHER = false;
    TileMap tm; const char* A; const char* Bt; size_t tstep;
    __device__ void init(const void* A_, const void* Bt_, int M, int N, int K, int G, int c) { tm.init(M, N, G, c); A = (const char*)A_; Bt = (const char*)Bt_; tstep = (size_t)BM * K * 2; }
    __device__ bool next(int i, Unit& u) const { if (!tm.tile(i, u.pm, u.pn)) return false; u.pb = 0; u.seg = 0; u.last = 1; return true; }
    __device__ __forceinline__ void addr(const Unit& u, const char*& a, const char*& b) const { a = A + (size_t)u.pm * tstep; b = Bt + (size_t)u.pn * tstep; }
    __device__ __forceinline__ void a_ready(const Unit&) const {}
    __device__ __forceinline__ void done(const Unit&) const {}
};
struct MergeOrder {
    static constexpr bool GATHER = false;
    TileMap tm; const char *A, *Bt; size_t tstep, segA, segB;
    __device__ bool next(int i, Unit& u) const { if (!tm.tile(i >> 2, u.pm, u.pn)) return false; const int sg = i & 3; u.pb = 0; u.seg = sg; u.last = (sg == 3); return true; }
    __device__ __forceinline__ void addr(const Unit& u, const char*& a, const char*& b) const { a = A + (size_t)u.seg * segA + (size_t)u.pm * tstep; b = Bt + (size_t)u.seg * segB + (size_t)u.pn * tstep; }
    __device__ __forceinline__ void a_ready(const Unit&) const {}
    __device__ __forceinline__ void done(const Unit&) const {}
};

__device__ __forceinline__ void unpack8(const u32x4 w, float (&f)[8]) {
    f[0] = __uint_as_float(w.x << 16); f[1] = __uint_as_float(w.x & 0xffff0000u); f[2] = __uint_as_float(w.y << 16); f[3] = __uint_as_float(w.y & 0xffff0000u);
    f[4] = __uint_as_float(w.z << 16); f[5] = __uint_as_float(w.z & 0xffff0000u); f[6] = __uint_as_float(w.w << 16); f[7] = __uint_as_float(w.w & 0xffff0000u);
}
__device__ __forceinline__ void st_wt16(PG8_GAS void* p, const u32x4 v) { asm volatile("global_store_dwordx4 %0, %1, off sc0 sc1\n\ts_nop 2" :: "v"(p), "v"(v) : "memory"); }
__device__ __forceinline__ u32x4 pack8(const f32x4 v0, const f32x4 v1) { u32x4 w; w.x = cvt_pk_bf16(v0[0], v0[1]); w.y = cvt_pk_bf16(v0[2], v0[3]); w.z = cvt_pk_bf16(v1[0], v1[1]); w.w = cvt_pk_bf16(v1[2], v1[3]); return w; }

template <int LDC> struct EpiBf16 {
    static constexpr bool PERM = true; static constexpr int ldc = LDC;
    bf16_t* O;
    __device__ __forceinline__ void mid(f32x4 (&)[2][2][4][2], const Unit&, int, int, int, int) const {}
    __device__ __forceinline__ void operator()(const f32x4 (&acc)[2][2][4][2], const Unit& u, int wr, int wc, int fr, int fq) const {
        const int row0 = u.pm * BM + wr * 64 + fr, col0 = u.pn * BM + wc * 32 + 8 * fq;
#pragma unroll
        for (int ai = 0; ai < 2; ++ai)
#pragma unroll
            for (int m = 0; m < 4; ++m) { bf16_t* rowp = O + (size_t)(row0 + ai * HALF + m * 16) * ldc + col0;
#pragma unroll
                for (int bj = 0; bj < 2; ++bj) *(PG8_GAS u32x4*)(rowp + bj * HALF) = pack8(acc[ai][bj][m][0], acc[ai][bj][m][1]); }
    }
};
struct EpiProj {
    static constexpr bool PERM = true;
    bf16_t* pmix; bf16_t* pgate; float* misc; const float* gbias;
    __device__ __forceinline__ void mid(f32x4 (&)[2][2][4][2], const Unit&, int, int, int, int) const {}
    __device__ __forceinline__ void operator()(const f32x4 (&acc)[2][2][4][2], const Unit& u, int wr, int wc, int fr, int fq) const {
        const int row0 = u.pm * BM + wr * 64 + fr, cl = wc * 32 + 8 * fq;
        if (u.pn < 23) {
            const float sc = (u.pn == 7 || u.pn == 8) ? 0.18033688011112042f : 1.f;
#pragma unroll
            for (int ai = 0; ai < 2; ++ai)
#pragma unroll
                for (int m = 0; m < 4; ++m) { bf16_t* rowp = pmix + (size_t)(row0 + ai * HALF + m * 16) * PMIX_LD + u.pn * BM + cl;
#pragma unroll
                    for (int bj = 0; bj < 2; ++bj) st_wt16((PG8_GAS void*)(rowp + bj * HALF), pack8(acc[ai][bj][m][0] * sc, acc[ai][bj][m][1] * sc)); }
        } else if (u.pn == 23) {
            if (wc == 0 && fq < 3) {
#pragma unroll
                for (int ai = 0; ai < 2; ++ai)
#pragma unroll
                    for (int m = 0; m < 4; ++m) { float* rowp = misc + (size_t)(row0 + ai * HALF + m * 16) * 32 + 8 * fq;
                        *(PG8_GAS f32x4*)rowp = acc[ai][0][m][0]; *(PG8_GAS f32x4*)(rowp + 4) = acc[ai][0][m][1]; }
            }
        } else {
            const int gc = (u.pn - 24) * BM + cl;
            f32x4 bv[2][2];
#pragma unroll
            for (int bj = 0; bj < 2; ++bj)
#pragma unroll
                for (int n = 0; n < 2; ++n) bv[bj][n] = *(const PG8_GAS f32x4*)(gbias + gc + bj * HALF + 4 * n);
#pragma unroll
            for (int ai = 0; ai < 2; ++ai)
#pragma unroll
                for (int m = 0; m < 4; ++m) { bf16_t* rowp = pgate + (size_t)(row0 + ai * HALF + m * 16) * PGATE_LD + gc;
#pragma unroll
                    for (int bj = 0; bj < 2; ++bj) { f32x4 v0 = acc[ai][bj][m][0] + bv[bj][0], v1 = acc[ai][bj][m][1] + bv[bj][1];
#pragma unroll
                        for (int i = 0; i < 4; ++i) { v0[i] = __builtin_amdgcn_rcpf(1.f + __expf(-v0[i])); v1[i] = __builtin_amdgcn_rcpf(1.f + __expf(-v1[i])); }
                        st_wt16((PG8_GAS void*)(rowp + bj * HALF), pack8(v0, v1)); } }
        }
    }
};
struct EpiMerge {
    static constexpr bool PERM = true;
    const bf16_t* pgate; bf16_t* O; const float* ssq;
    __device__ __forceinline__ float rs(size_t row, int g) const { const PG8_GAS f32x4* q = (const PG8_GAS f32x4*)(ssq + row * 16 + 8 * g); const f32x4 a = q[0], b = q[1];
        return __builtin_amdgcn_rsqf((((a[0] + a[1]) + (a[2] + a[3])) + ((b[0] + b[1]) + (b[2] + b[3]))) * (1.f / 512.f) + 1e-5f); }
    __device__ __forceinline__ void ld_ssq(size_t row, int g, f32x4& a, f32x4& b) const { const PG8_GAS f32x4* q = (const PG8_GAS f32x4*)(ssq + row * 16 + 8 * g); a = q[0]; b = q[1]; }
    static __device__ __forceinline__ float rs_of(const f32x4 a, const f32x4 b) { return __builtin_amdgcn_rsqf((((a[0] + a[1]) + (a[2] + a[3])) + ((b[0] + b[1]) + (b[2] + b[3]))) * (1.f / 512.f) + 1e-5f); }
    __device__ __forceinline__ void mid(f32x4 (&acc)[2][2][4][2], const Unit& u, int wr, int wc, int fr, int fq) const {
        const int row0 = u.pm * BM + wr * 64 + fr, col0 = u.pn * BM + wc * 32 + 8 * fq;
#pragma unroll
        for (int ai = 0; ai < 2; ++ai)
#pragma unroll
            for (int m0 = 0; m0 < 4; m0 += 2) {
                if (u.seg == 2) {
#pragma unroll
                    for (int mm = 0; mm < 2; ++mm) { const int m = m0 + mm; const size_t r = (size_t)(row0 + ai * HALF + m * 16); const float f = rs(r, 0) * __builtin_amdgcn_rcpf(rs(r, 1));
#pragma unroll
                        for (int bj = 0; bj < 2; ++bj) { acc[ai][bj][m][0] = acc[ai][bj][m][0] * f; acc[ai][bj][m][1] = acc[ai][bj][m][1] * f; } }
                } else {
                    u32x4 GA[2][2], GB[2][2]; float f[2];
#pragma unroll
                    for (int mm = 0; mm < 2; ++mm) { const size_t r = (size_t)(row0 + ai * HALF + (m0 + mm) * 16); const bf16_t* gp = pgate + r * PGATE_LD + u.seg * 1024 + col0;
#pragma unroll
                        for (int bj = 0; bj < 2; ++bj) { GA[mm][bj] = *(const PG8_GAS u32x4*)(gp + bj * HALF); GB[mm][bj] = *(const PG8_GAS u32x4*)(gp + 1024 + bj * HALF); }
                        f[mm] = (u.seg == 1) ? __builtin_amdgcn_rcpf(rs(r, 0)) : 1.f; }
#pragma unroll
                    for (int mm = 0; mm < 2; ++mm) { const int m = m0 + mm;
#pragma unroll
                        for (int bj = 0; bj < 2; ++bj) { float ga[8], gb[8]; unpack8(GA[mm][bj], ga); unpack8(GB[mm][bj], gb);
#pragma unroll
                            for (int i = 0; i < 4; ++i) { acc[ai][bj][m][0][i] *= f[mm] * ga[i] * __builtin_amdgcn_rcpf(fmaxf(gb[i], 1e-20f)); acc[ai][bj][m][1][i] *= f[mm] * ga[4 + i] * __builtin_amdgcn_rcpf(fmaxf(gb[4 + i], 1e-20f)); } } }
                }
#pragma unroll
                for (int mm = 0; mm < 2; ++mm) asm volatile("" : "+v"(acc[ai][0][m0 + mm][0]), "+v"(acc[ai][0][m0 + mm][1]), "+v"(acc[ai][1][m0 + mm][0]), "+v"(acc[ai][1][m0 + mm][1]) :: "memory");
            }
    }
    __device__ __forceinline__ void operator()(const f32x4 (&acc)[2][2][4][2], const Unit& u, int wr, int wc, int fr, int fq) const {
        const int row0 = u.pm * BM + wr * 64 + fr, col0 = u.pn * BM + wc * 32 + 8 * fq;
#pragma unroll
        for (int ai = 0; ai < 2; ++ai)
#pragma unroll
            for (int m0 = 0; m0 < 4; m0 += 2) {
                u32x4 G2[2][2]; f32x4 sa[2], sb[2];
#pragma unroll
                for (int mm = 0; mm < 2; ++mm) { const size_t r = (size_t)(row0 + ai * HALF + (m0 + mm) * 16); ld_ssq(r, 1, sa[mm], sb[mm]);
#pragma unroll
                    for (int bj = 0; bj < 2; ++bj) G2[mm][bj] = *(const PG8_GAS u32x4*)(pgate + r * PGATE_LD + 2048 + col0 + bj * HALF); }
#pragma unroll
                for (int mm = 0; mm < 2; ++mm) { const int m = m0 + mm; const size_t r = (size_t)(row0 + ai * HALF + m * 16); const float f = rs_of(sa[mm], sb[mm]);
#pragma unroll
                    for (int bj = 0; bj < 2; ++bj) { float g[8]; unpack8(G2[mm][bj], g);
                        f32x4 v0 = acc[ai][bj][m][0], v1 = acc[ai][bj][m][1];
#pragma unroll
                        for (int i = 0; i < 4; ++i) { v0[i] *= f * g[i]; v1[i] *= f * g[4 + i]; }
                        *(PG8_GAS u32x4*)(O + r * 1024 + col0 + bj * HALF) = pack8(v0, v1); } }
                asm volatile("" ::: "memory");
            }
    }
};
struct EpiRes {
    static constexpr bool PERM = false;
    const bf16_t* base; bf16_t* out; float alpha;
    __device__ __forceinline__ void mid(f32x4 (&)[2][2][4][2], const Unit&, int, int, int, int) const {}
    __device__ __forceinline__ void operator()(const f32x4 (&acc)[2][2][4][2], const Unit& u, int wr, int wc, int fr, int fq) const {
        const int row0 = u.pm * BM + wr * 64 + fr, col0 = u.pn * BM + wc * 32 + 4 * fq;
#pragma unroll
        for (int ai = 0; ai < 2; ++ai)
#pragma unroll
            for (int m = 0; m < 4; ++m) { const size_t off = (size_t)(row0 + ai * HALF + m * 16) * 1024 + col0;
#pragma unroll
                for (int bj = 0; bj < 2; ++bj)
#pragma unroll
                    for (int n = 0; n < 2; ++n) { const unsigned long long bw = *(const PG8_GAS unsigned long long*)(base + off + bj * HALF + n * 16);
                        const f32x4 b = (f32x4){__uint_as_float((unsigned)bw << 16), __uint_as_float((unsigned)bw & 0xffff0000u), __uint_as_float((unsigned)(bw >> 32) << 16), __uint_as_float((unsigned)(bw >> 32) & 0xffff0000u)};
                        const f32x4 o = b * alpha + acc[ai][bj][m][n];
                        *(PG8_GAS unsigned long long*)(out + off + bj * HALF + n * 16) = (unsigned long long)cvt_pk_bf16(o[0], o[1]) | ((unsigned long long)cvt_pk_bf16(o[2], o[3]) << 32); } }
    }
};

template <bool GATHER_> struct GroupOrderT {
    static constexpr bool GATHER = GATHER_;
    const PG8_LAS int* ltok;
    __device__ __forceinline__ unsigned arow(int ui, int r) const { return (unsigned)ltok[256 * ui + r]; }
    const PG8_LAS int* tab; const char* A; const char* Bt; size_t tstepA, tstepB, estride; int nN, G, c;
    __device__ bool next(int i, Unit& u) const {
        const int nb = __builtin_amdgcn_readfirstlane(tab[0]);
        int rb, pn;
        if ((G & 31) == 0) { const int x = c & 7, j = c >> 3; rb = i * (G >> 2) + x * (G >> 5) + (j >> 2); pn = j & 3; }
        else { const int L = i * G + c; rb = L >> 2; pn = L & 3; }
        if (rb >= nb) return false;
        u.pm = rb; u.pn = pn; u.pb = __builtin_amdgcn_readfirstlane(tab[1 + rb]); u.seg = 0; u.last = 1; return true;
    }
    __device__ __forceinline__ void addr(const Unit& u, const char*& a, const char*& b) const { a = GATHER_ ? A : A + (size_t)u.pm * tstepA; b = Bt + (size_t)u.pb * estride + (size_t)u.pn * tstepB; }
    __device__ __forceinline__ void a_ready(const Unit&) const {}
    __device__ __forceinline__ void done(const Unit&) const {}
};
using GroupOrder = GroupOrderT<false>; using GroupGatherOrder = GroupOrderT<true>;
struct EpiSwiGLU {
    static constexpr bool PERM = true;
    bf16_t* H;
    __device__ __forceinline__ void mid(f32x4 (&)[2][2][4][2], const Unit&, int, int, int, int) const {}
    __device__ __forceinline__ void operator()(const f32x4 (&acc)[2][2][4][2], const Unit& u, int wr, int wc, int fr, int fq) const {
        const int row0 = u.pm * BM + wr * 64 + fr, col0 = u.pn * HALF + wc * 32 + 8 * fq;
#pragma unroll
        for (int ai = 0; ai < 2; ++ai)
#pragma unroll
            for (int m = 0; m < 4; ++m) { f32x4 h0, h1;
#pragma unroll
                for (int i = 0; i < 4; ++i) { const float g0 = acc[ai][0][m][0][i], g1 = acc[ai][0][m][1][i];
                    h0[i] = g0 * __builtin_amdgcn_rcpf(1.f + __expf(-g0)) * acc[ai][1][m][0][i]; h1[i] = g1 * __builtin_amdgcn_rcpf(1.f + __expf(-g1)) * acc[ai][1][m][1][i]; }
                *(PG8_GAS u32x4*)(H + (size_t)(row0 + ai * HALF + m * 16) * 512 + col0) = pack8(h0, h1); }
    }
};

template <class Epi, class Sched, bool ALIGN_EPI = false, bool SP2 = false>
__device__ __forceinline__ void gemm_phase(PG8_LAS unsigned char* lds, const int K, const Sched& S, const Epi& E, const int wave0) {
    int sw_ = wave0; asm volatile("" : "+s"(sw_)); int ln_; asm volatile("v_mbcnt_lo_u32_b32 %0, -1, 0\n\tv_mbcnt_hi_u32_b32 %0, -1, %0" : "=v"(ln_));
    const int tid_ = sw_ * 64 + ln_;
    const int tid = tid_, wid = __builtin_amdgcn_readfirstlane(tid >> 6), lane = tid & 63, wr = wid >> 2, wc = wid & 3, fr = lane & 15, fq = lane >> 4;
    const int nt = K / BK;
    unsigned voffA[2], voffB[2];
#pragma unroll
    for (int i = 0; i < 2; ++i) { int R, C; stage_rc(tid * 16 + i * 8192, R, C); const int Rb = Epi::PERM ? ((R & ~31) + perm32(R & 31)) : R;
        voffA[i] = (unsigned)(R * K + C) * 2u; voffB[i] = (unsigned)(Rb * K + C) * 2u; }
    unsigned gc[2][2] = {{0u, 0u}, {0u, 0u}};
    auto gof = [&](int ui_, unsigned (&g)[2][2]) {
        if constexpr (Sched::GATHER) {
#pragma unroll
        for (int i = 0; i < 2; ++i) { int R, C; stage_rc(tid * 16 + i * 8192, R, C);
#pragma unroll
            for (int h = 0; h < 2; ++h) g[h][i] = S.arow(ui_, h * HALF + R) * (unsigned)(K * 2) + (unsigned)(C * 2); } } };
    const size_t kstep = (size_t)(BK * 2);
    const size_t hstep = (size_t)HALF * K * 2;
    const unsigned ldsw = (unsigned)wid * 1024u;
    const int aoff = lds_byte(wr * 64 + fr, fq * 8), boff = lds_byte(wc * 32 + fr, fq * 8);
#define PG8_SA(b, h) (((b) * 2 + (h)) * HTB)
#define PG8_SB(b, h) ((4 + (b) * 2 + (h)) * HTB)
#define PG8_STAGE(bufoff, gbase, voff) do { _Pragma("unroll") for (int _i = 0; _i < 2; ++_i) \
        __builtin_amdgcn_global_load_lds((const unsigned*)((const char*)(gbase) + (voff)[_i]), (PG8_LAS unsigned*)(lds + (bufoff) + ldsw + _i * 8192), 16, 0, 0); } while (0)
#define PG8_LDA(dst, b, h) do { _Pragma("unroll") for (int m = 0; m < 4; ++m) _Pragma("unroll") for (int k = 0; k < 2; ++k) dst[m][k] = *(const PG8_LAS bf16x8*)(lds + PG8_SA(b, h) + aoff + m * 2048 + k * 1024); } while (0)
#define PG8_LDB(dst, b, h) do { _Pragma("unroll") for (int n = 0; n < 2; ++n) _Pragma("unroll") for (int k = 0; k < 2; ++k) dst[n][k] = *(const PG8_LAS bf16x8*)(lds + PG8_SB(b, h) + boff + n * 2048 + k * 1024); } while (0)
#define PG8_MMA(ai, bj, At, Bt) do { __builtin_amdgcn_s_setprio(1); _Pragma("unroll") for (int m = 0; m < 4; ++m) _Pragma("unroll") for (int n = 0; n < 2; ++n) _Pragma("unroll") for (int k = 0; k < 2; ++k) \
        acc[ai][bj][m][n] = __builtin_amdgcn_mfma_f32_16x16x32_bf16(Bt[n][k], At[m][k], acc[ai][bj][m][n], 0, 0, 0); __builtin_amdgcn_s_setprio(0); } while (0)
#define PG8_WAIT_V(n) asm volatile("s_waitcnt vmcnt(" #n ")" ::: "memory")
#define PG8_WAIT_L(n) asm volatile("s_waitcnt lgkmcnt(" #n ")" ::: "memory")
#define PG8_BAR __builtin_amdgcn_s_barrier()
#define PG8_SCHED __builtin_amdgcn_sched_barrier(0)
    Unit cur, nxt; int ui = 0;
    if (!S.next(0, cur)) return;
    f32x4 acc[2][2][4][2];
#pragma unroll
    for (int a = 0; a < 2; ++a)
#pragma unroll
        for (int b = 0; b < 2; ++b)
#pragma unroll
            for (int m = 0; m < 4; ++m)
#pragma unroll
                for (int n = 0; n < 2; ++n) acc[a][b][m][n] = (f32x4){0.f, 0.f, 0.f, 0.f};
    bf16x8 At[4][2], B0[2][2], B1[2][2];
    const char* cA; const char* cB; S.addr(cur, cA, cB);
    S.a_ready(cur);
    if constexpr (Sched::GATHER) {
        static_assert(SP2, "GATHER schedulers use the SP2 loop");
        gof(0, gc);
        PG8_STAGE(PG8_SB(0, 0), cB, voffB); PG8_STAGE(PG8_SB(0, 1), cB + hstep, voffB); PG8_STAGE(PG8_SA(0, 0), cA, gc[0]); PG8_STAGE(PG8_SA(0, 1), cA, gc[1]);
        if (wr == 1) PG8_BAR;
        PG8_WAIT_V(2); PG8_BAR;
        PG8_STAGE(PG8_SB(1, 0), cB + kstep, voffB); PG8_STAGE(PG8_SA(1, 0), cA + kstep, gc[0]); PG8_STAGE(PG8_SB(1, 1), cB + hstep + kstep, voffB);
        PG8_WAIT_V(6); PG8_BAR;
    } else if constexpr (SP2) {
        PG8_STAGE(PG8_SB(0, 0), cB, voffB); PG8_STAGE(PG8_SB(0, 1), cB + hstep, voffB); PG8_STAGE(PG8_SA(0, 0), cA, voffA); PG8_STAGE(PG8_SA(0, 1), cA + hstep, voffA);
        if (wr == 1) PG8_BAR;
        PG8_WAIT_V(2); PG8_BAR;
        PG8_STAGE(PG8_SB(1, 0), cB + kstep, voffB); PG8_STAGE(PG8_SA(1, 0), cA + kstep, voffA); PG8_STAGE(PG8_SB(1, 1), cB + hstep + kstep, voffB);
        PG8_WAIT_V(6); PG8_BAR;
    } else {
        PG8_STAGE(PG8_SB(0, 0), cB, voffB); PG8_STAGE(PG8_SA(0, 0), cA, voffA); PG8_STAGE(PG8_SB(0, 1), cB + hstep, voffB); PG8_STAGE(PG8_SA(0, 1), cA + hstep, voffA);
        if (wr == 1) PG8_BAR;
        PG8_WAIT_V(4); PG8_BAR;
        PG8_STAGE(PG8_SB(1, 0), cB + kstep, voffB); PG8_STAGE(PG8_SA(1, 0), cA + kstep, voffA); PG8_STAGE(PG8_SB(1, 1), cB + hstep + kstep, voffB);
        PG8_WAIT_V(6); PG8_BAR;
    }
    for (;;) {
        const bool has_next = S.next(ui + 1, nxt);
        const char* nA = cA; const char* nB = cB; if (has_next) S.addr(nxt, nA, nB);
        for (int t = 0; t < nt; t += 2) {
            const bool last = (t == nt - 2);
            const char* a1 = cA + (size_t)(t + 1) * kstep;
            const char* a2 = last ? nA : cA + (size_t)(t + 2) * kstep; const char* b2 = last ? nB : cB + (size_t)(t + 2) * kstep;
            const char* a3 = a2 + kstep; const char* b3 = b2 + kstep;
            if (last && has_next) S.a_ready(nxt);
            if constexpr (Sched::GATHER) {
            unsigned o2[2][2];
            o2[0][0] = gc[0][0]; o2[0][1] = gc[0][1]; o2[1][0] = gc[1][0]; o2[1][1] = gc[1][1];
            if (last && has_next) gof(ui + 1, o2);
            PG8_LDB(B0, 0, 0); PG8_LDB(B1, 0, 1); PG8_SCHED; PG8_LDA(At, 0, 0); PG8_STAGE(PG8_SA(1, 1), a1, gc[1]);
            PG8_WAIT_V(8); PG8_WAIT_L(0); PG8_BAR; PG8_MMA(0, 0, At, B0); PG8_MMA(0, 1, At, B1); PG8_BAR; PG8_SCHED;
            PG8_LDA(At, 0, 1); PG8_STAGE(PG8_SB(0, 0), b2, voffB); PG8_STAGE(PG8_SB(0, 1), b2 + hstep, voffB); PG8_STAGE(PG8_SA(0, 0), a2, o2[0]);
            PG8_WAIT_V(8); PG8_WAIT_L(0); PG8_BAR; PG8_MMA(1, 0, At, B0); PG8_MMA(1, 1, At, B1); PG8_BAR; PG8_SCHED;
            PG8_LDB(B0, 1, 0); PG8_LDB(B1, 1, 1); PG8_SCHED; PG8_LDA(At, 1, 0); PG8_STAGE(PG8_SA(0, 1), a2, o2[1]);
            PG8_WAIT_V(8); PG8_WAIT_L(0); PG8_BAR; PG8_MMA(0, 0, At, B0); PG8_MMA(0, 1, At, B1); PG8_BAR; PG8_SCHED;
            PG8_LDA(At, 1, 1); PG8_STAGE(PG8_SB(1, 0), b3, voffB); PG8_STAGE(PG8_SB(1, 1), b3 + hstep, voffB); PG8_STAGE(PG8_SA(1, 0), a3, o2[0]);
            PG8_WAIT_V(8); PG8_WAIT_L(0); PG8_BAR; PG8_MMA(1, 0, At, B0); PG8_MMA(1, 1, At, B1); PG8_BAR; PG8_SCHED;
            } else if constexpr (SP2) {
            PG8_LDB(B0, 0, 0); PG8_LDB(B1, 0, 1); PG8_SCHED; PG8_LDA(At, 0, 0); PG8_STAGE(PG8_SA(1, 1), a1 + hstep, voffA);
            PG8_WAIT_V(8); PG8_WAIT_L(0); PG8_BAR; PG8_MMA(0, 0, At, B0); PG8_MMA(0, 1, At, B1); PG8_BAR; PG8_SCHED;
            PG8_LDA(At, 0, 1); PG8_STAGE(PG8_SB(0, 0), b2, voffB); PG8_STAGE(PG8_SB(0, 1), b2 + hstep, voffB); PG8_STAGE(PG8_SA(0, 0), a2, voffA);
            PG8_WAIT_V(8); PG8_WAIT_L(0); PG8_BAR; PG8_MMA(1, 0, At, B0); PG8_MMA(1, 1, At, B1); PG8_BAR; PG8_SCHED;
            PG8_LDB(B0, 1, 0); PG8_LDB(B1, 1, 1); PG8_SCHED; PG8_LDA(At, 1, 0); PG8_STAGE(PG8_SA(0, 1), a2 + hstep, voffA);
            PG8_WAIT_V(8); PG8_WAIT_L(0); PG8_BAR; PG8_MMA(0, 0, At, B0); PG8_MMA(0, 1, At, B1); PG8_BAR; PG8_SCHED;
            PG8_LDA(At, 1, 1); PG8_STAGE(PG8_SB(1, 0), b3, voffB); PG8_STAGE(PG8_SB(1, 1), b3 + hstep, voffB); PG8_STAGE(PG8_SA(1, 0), a3, voffA);
            PG8_WAIT_V(8); PG8_WAIT_L(0); PG8_BAR; PG8_MMA(1, 0, At, B0); PG8_MMA(1, 1, At, B1); PG8_BAR; PG8_SCHED;
            } else {
            PG8_LDB(B0, 0, 0); PG8_SCHED; PG8_LDA(At, 0, 0); PG8_STAGE(PG8_SA(1, 1), a1 + hstep, voffA);
            PG8_WAIT_L(8); PG8_BAR; PG8_WAIT_L(0); PG8_MMA(0, 0, At, B0); PG8_BAR; PG8_SCHED;
            PG8_LDB(B1, 0, 1); PG8_STAGE(PG8_SB(0, 0), b2, voffB);
            PG8_BAR; PG8_WAIT_L(0); PG8_MMA(0, 1, At, B1); PG8_BAR;
            PG8_LDA(At, 0, 1); PG8_STAGE(PG8_SA(0, 0), a2, voffA);
            PG8_BAR; PG8_WAIT_L(0); PG8_MMA(1, 0, At, B0); PG8_BAR; PG8_SCHED;
            PG8_STAGE(PG8_SB(0, 1), b2 + hstep, voffB);
            PG8_WAIT_V(6); PG8_BAR; PG8_MMA(1, 1, At, B1); PG8_BAR;
            PG8_LDB(B0, 1, 0); PG8_SCHED; PG8_LDA(At, 1, 0); PG8_STAGE(PG8_SA(0, 1), a2 + hstep, voffA);
            PG8_WAIT_L(8); PG8_BAR; PG8_WAIT_L(0); PG8_MMA(0, 0, At, B0); PG8_BAR; PG8_SCHED;
            PG8_LDB(B1, 1, 1); PG8_STAGE(PG8_SB(1, 0), b3, voffB);
            PG8_BAR; PG8_WAIT_L(0); PG8_MMA(0, 1, At, B1); PG8_BAR;
            PG8_LDA(At, 1, 1); PG8_STAGE(PG8_SA(1, 0), a3, voffA);
            PG8_BAR; PG8_WAIT_L(0); PG8_MMA(1, 0, At, B0); PG8_BAR; PG8_SCHED;
            PG8_STAGE(PG8_SB(1, 1), b3 + hstep, voffB);
            PG8_WAIT_V(6); PG8_BAR; PG8_MMA(1, 1, At, B1); PG8_BAR;
            }
        }
        if constexpr (ALIGN_EPI) { if (wr == 0) PG8_BAR; }
        { int le_; asm volatile("v_mbcnt_lo_u32_b32 %0, -1, 0\n\tv_mbcnt_hi_u32_b32 %0, -1, %0" : "=v"(le_));
          const int fr_e = le_ & 15, fq_e = le_ >> 4;
          if (cur.last) E(acc, cur, wr, wc, fr_e, fq_e); else E.mid(acc, cur, wr, wc, fr_e, fq_e); }
        if (!has_next) break;
        if (cur.last) {
#pragma unroll
        for (int a = 0; a < 2; ++a)
#pragma unroll
            for (int b = 0; b < 2; ++b)
#pragma unroll
                for (int m = 0; m < 4; ++m)
#pragma unroll
                    for (int n = 0; n < 2; ++n) acc[a][b][m][n] = (f32x4){0.f, 0.f, 0.f, 0.f};
        }
        cur = nxt; cA = nA; cB = nB; ++ui;
        if constexpr (Sched::GATHER) gof(ui, gc);
        if constexpr (ALIGN_EPI) { if (wr == 1) PG8_BAR; }
    }
    PG8_WAIT_V(0);
    if constexpr (!ALIGN_EPI) { if (wr == 0) PG8_BAR; }
    PG8_BAR;
#undef PG8_SA
#undef PG8_SB
#undef PG8_STAGE
#undef PG8_LDA
#undef PG8_LDB
#undef PG8_MMA
#undef PG8_WAIT_V
#undef PG8_WAIT_L
#undef PG8_BAR
#undef PG8_SCHED
}
}


#define GAS __attribute__((address_space(1)))
#define LAS __attribute__((address_space(3)))
typedef unsigned short bf16;
typedef unsigned v4u __attribute__((ext_vector_type(4)));
typedef float f32x4 __attribute__((ext_vector_type(4)));
typedef short bf16x8 __attribute__((ext_vector_type(8)));
typedef GAS unsigned gu32;
typedef GAS unsigned long long gu64;
#define RLX_AGENT __ATOMIC_RELAXED, __HIP_MEMORY_SCOPE_AGENT
#define LDS_WAIT() asm volatile("s_waitcnt lgkmcnt(0)" ::: "memory")
#define VM_WAIT() asm volatile("s_waitcnt vmcnt(0)" ::: "memory")
__device__ __forceinline__ unsigned long long rt() { return __builtin_amdgcn_s_memrealtime(); }
__device__ __forceinline__ unsigned f2bf(float f) { unsigned u = __builtin_bit_cast(unsigned, f); return (u + 0x7fffu + ((u >> 16) & 1u)) >> 16; }
__device__ __forceinline__ unsigned pk2(float lo, float hi) { return f2bf(lo) | (f2bf(hi) << 16); }

#define XB_TMO      128
#define XB_XCNT(j)  (256  + 64 * (j))
#define XB_XSUB(j)  (1280 + 64 * (j))
#define XB_XGEN(j)  (2304 + 64 * (j))
#define XB_TOP      3328
#define XB_TOPGEN   3392
#define XCD_BAR_WORDS 3456
#define XB_SPIN_CAP (1u << 18)

__device__ __forceinline__ unsigned xb_ld(unsigned* p)              { return __hip_atomic_load(p, __ATOMIC_RELAXED, __HIP_MEMORY_SCOPE_AGENT); }
__device__ __forceinline__ unsigned xb_add(unsigned* p, unsigned v) { return __hip_atomic_fetch_add(p, v, __ATOMIC_RELAXED, __HIP_MEMORY_SCOPE_AGENT); }
__device__ __forceinline__ unsigned xb_xcc_id() { return (unsigned)__builtin_amdgcn_s_getreg((3 << 11) | 20) & 0xFu; }
#define XB_SPIN(cond, bar) do { unsigned _sp = 0; while (cond) { __builtin_amdgcn_s_sleep(1); \
    if ((++_sp & 255u) == 0u) { if (xb_ld(&(bar)[XB_TMO])) break; if (_sp > XB_SPIN_CAP) { atomicAdd(&(bar)[XB_TMO], 1u); break; } } } } while (0)

struct XcdBarrier {
    unsigned* bar; unsigned x;
    volatile LAS unsigned* st;
};

__device__ __forceinline__ XcdBarrier xcd_barrier_post(unsigned* bar, volatile LAS unsigned* st) {
    XcdBarrier b; b.bar = bar; b.x = xb_xcc_id(); b.st = st;
    if (threadIdx.x == 0) (void)xb_add(&bar[XB_XCNT(b.x)], 1u);
    return b;
}
__device__ __forceinline__ void xcd_barrier_complete(unsigned* bar, unsigned x, unsigned& nloc, unsigned& nx) {
    const unsigned G = gridDim.x * gridDim.y * gridDim.z;
    unsigned sum, cnt, mine, sp = 0u;
    for (;;) {
        sum = 0u; cnt = 0u; mine = 0u;
#pragma unroll
        for (unsigned j = 0; j < 16; ++j) { const unsigned c = xb_ld(&bar[XB_XCNT(j)]); sum += c; cnt += (c > 0u) ? 1u : 0u; mine = (j == x) ? c : mine; }
        if (sum == G) break;
        __builtin_amdgcn_s_sleep(1);
        if ((++sp & 255u) == 0u) { if (xb_ld(&bar[XB_TMO])) break; if (sp > XB_SPIN_CAP) { atomicAdd(&bar[XB_TMO], 1u); break; } }
    }
    nloc = mine > 0u ? mine : 1u; nx = cnt > 0u ? cnt : 1u;
}

__device__ __forceinline__ void xcd_barrier(const XcdBarrier& b) {
    asm volatile("s_waitcnt vmcnt(0)" ::: "memory");
    __syncthreads();
    if (threadIdx.x == 0) {
        unsigned* bar = b.bar;
        __builtin_amdgcn_s_waitcnt(0);
        unsigned nloc = b.st[0], nx = b.st[1];
        if (nloc == 0u) { xcd_barrier_complete(bar, b.x, nloc, nx); b.st[0] = nloc; b.st[1] = nx; }
        const unsigned old = xb_add(&bar[XB_XSUB(b.x)], 1u);
        const unsigned gen = old / nloc;
        if (old + 1u == (gen + 1u) * nloc) {
            __builtin_amdgcn_fence(__ATOMIC_RELEASE, "agent");
            asm volatile("s_waitcnt vmcnt(0)" ::: "memory");
            const unsigned og = xb_add(&bar[XB_TOP], 1u);
            const unsigned tg = og / nx;
            if (og + 1u == (tg + 1u) * nx) xb_add(&bar[XB_TOPGEN], 1u);
            else XB_SPIN(xb_ld(&bar[XB_TOPGEN]) == tg, bar);
            __builtin_amdgcn_fence(__ATOMIC_ACQUIRE, "agent");
            xb_add(&bar[XB_XGEN(b.x)], 1u);
            asm volatile("s_waitcnt vmcnt(0)" ::: "memory");
        } else {
            XB_SPIN(xb_ld(&bar[XB_XGEN(b.x)]) == gen, bar);
            __builtin_amdgcn_fence(__ATOMIC_ACQUIRE, "agent");
            asm volatile("s_waitcnt vmcnt(0)" ::: "memory");
        }
    }
    __syncthreads();
}


#include <hip/hip_bf16.h>
#include <cmath>
#include <hip/hip_bf16.h>
#include <cmath>
namespace attn_body {
using bf16=__hip_bfloat16;
using bf16x8=__attribute__((ext_vector_type(8)))short;
using s16x4=__attribute__((ext_vector_type(4)))short;
using f32x16=__attribute__((ext_vector_type(16)))float;
using u32x4=__attribute__((ext_vector_type(4)))unsigned;
using f32x4_t=__attribute__((ext_vector_type(4)))float;
constexpr int BATCH=16,NHEAD=8,SEQ=2048,D=64,DM=5888,OP=512;
constexpr int NW=8,QBLK=32,QB=QBLK*NW,KVBLK=64,NQB=SEQ/QB;
constexpr int ATTN_PITCH=DM, ATTN_UNIT_ROWS=QB;
__device__ __forceinline__ int crow(int r,int hi){return (r&3)+8*(r>>2)+4*hi;}
#define SBAR() __builtin_amdgcn_sched_barrier(0)
__device__ __forceinline__ void cmask(f32x16&p0,f32x16&p1,int jb,int qrel,int hi){
  const float NEG=-INFINITY; int kb=64*jb+4*hi;
  #pragma unroll
  for(int r=0;r<16;++r){int kv=kb+(r&3)+8*(r>>2); if(kv>qrel)p0[r]=NEG; if(kv+32>qrel)p1[r]=NEG;}
}

constexpr int NSLOT=3, SLOTB=8192;
constexpr int LDS_K=0, LDS_V=NSLOT*SLOTB, LDS_WS=2*NSLOT*SLOTB, LDS_OST=LDS_WS+NW*64*4, LDS_CB=LDS_OST+NW*4096, LDS_BYTES=LDS_CB+SEQ*4;
constexpr float C2=0.125f*1.4426950408889634f;
__device__ __forceinline__ void glds16(const void*gsrc,unsigned lds_dst){unsigned keep;
  asm volatile("s_mov_b32 %0, m0\n\ts_mov_b32 m0, %2\n\ts_nop 0\n\tglobal_load_lds_dwordx4 %1, off\n\ts_mov_b32 m0, %0":"=&s"(keep):"v"(gsrc),"s"(lds_dst):"memory");}
__device__ __forceinline__ float max3f(float a,float b,float c){float r;asm("v_max3_f32 %0, %1, %2, %3":"=v"(r):"v"(a),"v"(b),"v"(c));return r;}
__device__ __forceinline__ float max2f(float a,float b){float r;asm("v_max_f32_e32 %0, %1, %2":"=v"(r):"v"(a),"v"(b));return r;}
__device__ __forceinline__ float fadd_s(float a,float b){float r;asm("v_add_f32_e32 %0, %1, %2":"=v"(r):"v"(a),"v"(b));return r;}
__device__ __forceinline__ float fsub_s(float a,float b){float r;asm("v_sub_f32_e32 %0, %1, %2":"=v"(r):"v"(a),"v"(b));return r;}
typedef float f32x2_t __attribute__((ext_vector_type(2))); typedef __bf16 bf16x2_t __attribute__((ext_vector_type(2)));
__device__ __forceinline__ unsigned cvtpk_s(float lo,float hi){f32x2_t v={lo,hi};bf16x2_t b=__builtin_convertvector(v,bf16x2_t);return __builtin_bit_cast(unsigned,b);}
#define WAIT_BAR(N) asm volatile("s_waitcnt vmcnt(" #N ") lgkmcnt(0)\n\ts_barrier":::"memory")

__device__ __forceinline__ void qkt(f32x16&p0,f32x16&p1,const char*Kslot,const bf16x8*qr,int r32,int hi){
  const char*kb=Kslot+hi*1024+r32*16;
  #pragma unroll
  for(int d0=0;d0<4;++d0){
    const bf16x8 b0=*reinterpret_cast<const bf16x8*>(kb+d0*2048);
    const bf16x8 b1=*reinterpret_cast<const bf16x8*>(kb+d0*2048+512);
    if(d0==0){p0=__builtin_amdgcn_mfma_f32_32x32x16_bf16(b0,qr[0],p0,0,0,0);p1=__builtin_amdgcn_mfma_f32_32x32x16_bf16(b1,qr[0],p1,0,0,0);}
    else{p0=__builtin_amdgcn_mfma_f32_32x32x16_bf16(b0,qr[d0],p0,0,0,0);p1=__builtin_amdgcn_mfma_f32_32x32x16_bf16(b1,qr[d0],p1,0,0,0);}}
}
typedef __attribute__((address_space(3))) const char* lds_cptr;
typedef short v4i16_t __attribute__((ext_vector_type(4)));
__device__ __forceinline__ void kload8(bf16x8*kf,lds_cptr kp){
  kf[0]=*(const __attribute__((address_space(3))) bf16x8*)(kp);      kf[1]=*(const __attribute__((address_space(3))) bf16x8*)(kp+512);
  kf[2]=*(const __attribute__((address_space(3))) bf16x8*)(kp+2048); kf[3]=*(const __attribute__((address_space(3))) bf16x8*)(kp+2560);
  kf[4]=*(const __attribute__((address_space(3))) bf16x8*)(kp+4096); kf[5]=*(const __attribute__((address_space(3))) bf16x8*)(kp+4608);
  kf[6]=*(const __attribute__((address_space(3))) bf16x8*)(kp+6144); kf[7]=*(const __attribute__((address_space(3))) bf16x8*)(kp+6656);
}
__device__ __forceinline__ void kload2(bf16x8*kf,lds_cptr kp,int j){ kf[2*j]=*(const __attribute__((address_space(3))) bf16x8*)(kp+j*2048); kf[2*j+1]=*(const __attribute__((address_space(3))) bf16x8*)(kp+j*2048+512); }
__device__ __forceinline__ s16x4 vtr(lds_cptr p){ return __builtin_bit_cast(s16x4,__builtin_amdgcn_ds_read_tr16_b64_v4i16((__attribute__((address_space(3))) v4i16_t*)p)); }
__device__ __forceinline__ float rowmax(const f32x16&p0,const f32x16&p1){
  float a=max3f(p0[0],p0[1],p1[0]),b=max3f(p0[2],p0[3],p1[1]);a=max3f(a,p1[2],p1[3]);
  #pragma unroll
  for(int r=4;r<16;r+=4){a=max3f(a,p0[r],p0[r+1]);b=max3f(b,p0[r+2],p0[r+3]);a=max3f(a,p1[r],p1[r+1]);b=max3f(b,p1[r+2],p1[r+3]);}
  const float m=max2f(a,b);
  auto rr=__builtin_amdgcn_permlane32_swap(__float_as_uint(m),__float_as_uint(m),false,false);
  return max2f(__uint_as_float(rr[0]),__uint_as_float(rr[1]));
}
__device__ __forceinline__ void pv(f32x16*o,int vb,bf16x8 pa0,bf16x8 pa1,bf16x8 pa2,bf16x8 pa3){
  #pragma unroll
  for(int d0=0;d0<2;++d0){s16x4 lo[4],hi[4];
    #pragma unroll
    for(int ks=0;ks<4;++ks){
      asm volatile("ds_read_b64_tr_b16 %0,%1 offset:%c2":"=&v"(lo[ks]):"v"(vb),"i"(d0*4096+ks*1024):"memory");
      asm volatile("ds_read_b64_tr_b16 %0,%1 offset:%c2":"=&v"(hi[ks]):"v"(vb),"i"(d0*4096+ks*1024+512):"memory");}
    asm volatile("s_waitcnt lgkmcnt(0)":::"memory");SBAR();
    #define PK(k) (bf16x8){lo[k][0],lo[k][1],lo[k][2],lo[k][3],hi[k][0],hi[k][1],hi[k][2],hi[k][3]}
    o[d0]=__builtin_amdgcn_mfma_f32_32x32x16_bf16(pa0,PK(0),o[d0],0,0,0);
    o[d0]=__builtin_amdgcn_mfma_f32_32x32x16_bf16(pa1,PK(1),o[d0],0,0,0);
    o[d0]=__builtin_amdgcn_mfma_f32_32x32x16_bf16(pa2,PK(2),o[d0],0,0,0);
    o[d0]=__builtin_amdgcn_mfma_f32_32x32x16_bf16(pa3,PK(3),o[d0],0,0,0);
    #undef PK
  }
}

#ifndef ATTN_STORE16
#define ATTN_STORE16(p,v) (*(u32x4*)(p)=(v))
#endif
template<int THRL> __device__ __forceinline__ void attn_unit(int b,int h,int qb,const bf16*Q,const bf16*__restrict__ K,const bf16*__restrict__ V,bf16*O,const float*__restrict__ ck,char*shm,const int wave0){
  int sw_=wave0; asm volatile("":"+s"(sw_)); int ln_; asm volatile("v_mbcnt_lo_u32_b32 %0, -1, 0\n\tv_mbcnt_hi_u32_b32 %0, -1, %0":"=v"(ln_)); const int tid=sw_*64+ln_,lane=tid&63,r32=lane&31,hi=lane>>5; const int wid=__builtin_amdgcn_readfirstlane(tid>>6);
  const long rowbase=(long)b*SEQ; const int q0=qb*QB;
  const bf16*Qw=Q+(rowbase+q0+wid*QBLK)*DM+h*D;
  const bf16*Kh=K+rowbase*DM+h*D,*Vh=V+rowbase*DM+h*D;
  const unsigned lds0=(unsigned)(uintptr_t)shm;
  float*wsf=(float*)(shm+LDS_WS)+wid*64;
  const bf16*ksrc=Kh+(long)lane*DM+wid*8;
  const bf16*vsrc=Vh+(long)(16*(wid&3)+(lane>>2))*DM+(wid>>2)*32+(lane&3)*8;
  const unsigned kdst=lds0+LDS_K+wid*1024, vdst=lds0+LDS_V+wid*1024;
  #define DMA_K(t,slot) glds16(ksrc+(long)(t)*KVBLK*DM,(unsigned)__builtin_amdgcn_readfirstlane(kdst+(slot)))
  #define DMA_V(t,slot) glds16(vsrc+(long)(t)*KVBLK*DM,(unsigned)__builtin_amdgcn_readfirstlane(vdst+(slot)))
  const int vb0=(int)(lds0+LDS_V)+((lane>>4)&1)*32+(lane&3)*8+(4*hi+((lane&15)>>2))*64;
  const char*Kbase=shm+LDS_K; bf16x8 kf[8];
  const lds_cptr shm3=(lds_cptr)shm; const lds_cptr kp0=shm3+LDS_K+hi*1024+r32*16; const lds_cptr vp0=shm3+LDS_V+((lane>>4)&1)*32+(lane&3)*8+(4*hi+((lane&15)>>2))*64;
  const int NT=(q0+QB)/KVBLK;
  { __attribute__((address_space(3))) float*cbl=(__attribute__((address_space(3))) float*)((__attribute__((address_space(3))) char*)shm+LDS_CB); const float cref=ck[q0+QB-1]; for(int i=tid;i<q0+QB;i+=NW*64)cbl[i]=cref-ck[i]; }
  typedef __attribute__((address_space(3))) const f32x4_t* lds_f4p; const lds_f4p cbp=(lds_f4p)((lds_cptr)shm+LDS_CB)+hi;
  #define BIASLD(X0,X1,t) do{ const lds_f4p c_=cbp+16*(t); _Pragma("unroll") for(int g_=0;g_<4;++g_){ const f32x4_t a_=c_[2*g_],b_=c_[8+2*g_]; X0[4*g_]=a_[0];X0[4*g_+1]=a_[1];X0[4*g_+2]=a_[2];X0[4*g_+3]=a_[3]; X1[4*g_]=b_[0];X1[4*g_+1]=b_[1];X1[4*g_+2]=b_[2];X1[4*g_+3]=b_[3]; } }while(0)
  DMA_K(0,0);DMA_V(0,0);DMA_K(1,SLOTB);
  bf16x8 qr[4];
  #pragma unroll
  for(int d0=0;d0<4;++d0)qr[d0]=*reinterpret_cast<const bf16x8*>(&Qw[(long)r32*DM+d0*16+hi*8]);
  float mhat=0.f,l_reg=0.f;f32x16 o[2];o[0]=f32x16{};o[1]=f32x16{};
  const int qrel=wid*QBLK+r32;
  #define CMASK(P0,P1,t) do{int jb_=(t)-(NT-4); if(jb_>=0)cmask(P0,P1,jb_,qrel,hi);}while(0)
  bool resc=false;
  #define START(P0,P1) do{ const float rm=rowmax(P0,P1); resc=false; \
    { const float dl=rm; mhat=fadd_s(mhat,dl); \
      _Pragma("unroll") for(int r=0;r<16;++r){P0[r]=fsub_s(P0[r],dl);P1[r]=fsub_s(P1[r],dl);} } \
    _Pragma("unroll") for(int r=0;r<16;++r)P0[r]=__builtin_amdgcn_exp2f(P0[r]); }while(0)
  #define RESC() do{ if(resc){ asm volatile("s_waitcnt lgkmcnt(0)":::"memory"); \
      _Pragma("unroll") for(int d_=0;d_<2;++d_) _Pragma("unroll") for(int r=0;r<16;++r)o[d_][r]*=wsf[crow(r,hi)]; } }while(0)
  f32x16 pA0,pA1,pB0,pB1;
  int sl_prev=0,sl_cur=0,sl_next=SLOTB;
  #define ROT() do{sl_prev=sl_cur;sl_cur=sl_next;sl_next=(sl_next==(NSLOT-1)*SLOTB)?0:sl_next+SLOTB;}while(0)
  DMA_K(2,2*SLOTB);
  WAIT_BAR(3);
  BIASLD(pA0,pA1,0);
  qkt(pA0,pA1,Kbase,qr,r32,hi);asm volatile("s_nop 15\n\ts_nop 7":"+v"(pA0),"+v"(pA1));CMASK(pA0,pA1,0);
  START(pA0,pA1);
  _Pragma("unroll") for(int r=0;r<16;++r)pA1[r]=__builtin_amdgcn_exp2f(pA1[r]);
  WAIT_BAR(0);
  DMA_K(3,0);DMA_V(1,SLOTB);
  ROT();
  kload8(kf,kp0+sl_cur);
  BIASLD(pB0,pB1,1);
  WAIT_BAR(2);
  s16x4 vlo[8],vhi[8]; u32x4 pw0,pw1,pw2,pw3;
  #define PKW(P,B) cvtpk_s(P[B],P[B+1])
  #define PAF(k) __builtin_bit_cast(bf16x8,pw##k)
  #define VFR(i) (bf16x8){vlo[i][0],vlo[i][1],vlo[i][2],vlo[i][3],vhi[i][0],vhi[i][1],vhi[i][2],vhi[i][3]}
  #define PIN(x) asm volatile("":"+v"(x))
  #define MX3(a,b,c) __builtin_fmaxf(__builtin_fmaxf((a),(b)),(c))
  #define GAPA(MF,A0,A1,A2,A3,W0,W1,PW) do{ MF; sacc+=A0; sacc+=A1; sacc+=A2; sacc+=A3; PIN(sacc); W0; W1; PIN(PW); SBAR(); }while(0)
  #define EX(v) __builtin_amdgcn_exp2f(v)
  #define GAPB(MF,X,B) do{ MF; X[B]=EX(X[B]); X[B+1]=EX(X[B+1]); X[B+2]=EX(X[B+2]); X[B+3]=EX(X[B+3]); PIN(X); SBAR(); }while(0)
  #define VRD(i) do{ vlo[i]=vtr(vp_+(((i)>>2)*4096+((i)&3)*1024)); vhi[i]=vtr(vp_+(((i)>>2)*4096+((i)&3)*1024+512)); }while(0)
  #define KRD(G,j) do{ if(G){ kload2(kf,kp0+sl_next,j); SBAR(); } }while(0)
  #define STEP(C0,C1,P0,P1,t,GK,GV,GL) do{ SBAR(); \
    _Pragma("unroll") for(int r=0;r<16;++r){C0[r]-=mhat;C1[r]-=mhat;} \
    const lds_cptr vp_=vp0+sl_prev; \
    VRD(0); SBAR(); float sacc=(P0[0]+P0[1]); \
    GAPA(C0=__builtin_amdgcn_mfma_f32_32x32x16_bf16(kf[0],qr[0],C0,0,0,0), P0[2],P0[3],P0[4],P0[5],     pw0[0]=PKW(P0,0), pw0[1]=PKW(P0,2), pw0); \
    VRD(4); SBAR(); GAPA(C1=__builtin_amdgcn_mfma_f32_32x32x16_bf16(kf[1],qr[0],C1,0,0,0), P0[6],P0[7],P0[8],P0[9],     pw0[2]=PKW(P0,4), pw0[3]=PKW(P0,6), pw0); \
    VRD(1); SBAR(); GAPA(C0=__builtin_amdgcn_mfma_f32_32x32x16_bf16(kf[2],qr[1],C0,0,0,0),   P0[10],P0[11],P0[12],P0[13], pw1[0]=PKW(P0,8), pw1[1]=PKW(P0,10), pw1); \
    VRD(5); SBAR(); GAPA(C1=__builtin_amdgcn_mfma_f32_32x32x16_bf16(kf[3],qr[1],C1,0,0,0),   P0[14],P0[15],P1[0],P1[1],   pw1[2]=PKW(P0,12),pw1[3]=PKW(P0,14), pw1); \
    VRD(2); SBAR(); GAPA(C0=__builtin_amdgcn_mfma_f32_32x32x16_bf16(kf[4],qr[2],C0,0,0,0),   P1[2],P1[3],P1[4],P1[5],     pw2[0]=PKW(P1,0), pw2[1]=PKW(P1,2), pw2); \
    VRD(6); SBAR(); GAPA(C1=__builtin_amdgcn_mfma_f32_32x32x16_bf16(kf[5],qr[2],C1,0,0,0),   P1[6],P1[7],P1[8],P1[9],     pw2[2]=PKW(P1,4), pw2[3]=PKW(P1,6), pw2); \
    VRD(3); SBAR(); GAPA(C0=__builtin_amdgcn_mfma_f32_32x32x16_bf16(kf[6],qr[3],C0,0,0,0),   P1[10],P1[11],P1[12],P1[13], pw3[0]=PKW(P1,8), pw3[1]=PKW(P1,10), pw3); \
    VRD(7); SBAR(); GAPA(C1=__builtin_amdgcn_mfma_f32_32x32x16_bf16(kf[7],qr[3],C1,0,0,0),   P1[14],P1[15],0.f,0.f,       pw3[2]=PKW(P1,12),pw3[3]=PKW(P1,14), pw3); \
    l_reg+=sacc; \
    if(GK){DMA_K((t)+3,sl_cur);} if(GV){DMA_V((t)+1,sl_next);} \
    CMASK(C0,C1,t); \
    { float a=MX3(C0[0],C0[1],C1[0]),b=MX3(C0[2],C0[3],C1[1]); a=MX3(a,C1[2],C1[3]); \
      _Pragma("unroll") for(int r=4;r<16;r+=4){a=MX3(a,C0[r],C0[r+1]);b=MX3(b,C0[r+2],C0[r+3]);a=MX3(a,C1[r],C1[r+1]);b=MX3(b,C1[r+2],C1[r+3]);} \
      float rm=__builtin_fmaxf(a,b); { auto rr=__builtin_amdgcn_permlane32_swap(__float_as_uint(rm),__float_as_uint(rm),false,false); rm=__builtin_fmaxf(__uint_as_float(rr[0]),__uint_as_float(rr[1])); } \
      resc=false; \
      if(__builtin_expect(__any(rm>(float)THRL),0)){ const float dl=__builtin_fmaxf(rm,0.f); mhat+=dl; \
        _Pragma("unroll") for(int r=0;r<16;++r){C0[r]-=dl;C1[r]-=dl;} \
        const float f=__builtin_amdgcn_exp2f(-dl); l_reg*=f; if(hi==0)wsf[r32]=f; resc=true; } } \
    SBAR(); \
    GAPB(o[0]=__builtin_amdgcn_mfma_f32_32x32x16_bf16(PAF(0),VFR(0),o[0],0,0,0), C0,0); \
    GAPB(o[1]=__builtin_amdgcn_mfma_f32_32x32x16_bf16(PAF(0),VFR(4),o[1],0,0,0), C0,4); \
    KRD(GL,0); GAPB(o[0]=__builtin_amdgcn_mfma_f32_32x32x16_bf16(PAF(1),VFR(1),o[0],0,0,0), C0,8); \
    KRD(GL,1); GAPB(o[1]=__builtin_amdgcn_mfma_f32_32x32x16_bf16(PAF(1),VFR(5),o[1],0,0,0), C0,12); \
    KRD(GL,2); GAPB(o[0]=__builtin_amdgcn_mfma_f32_32x32x16_bf16(PAF(2),VFR(2),o[0],0,0,0), C1,0); \
    KRD(GL,3); GAPB(o[1]=__builtin_amdgcn_mfma_f32_32x32x16_bf16(PAF(2),VFR(6),o[1],0,0,0), C1,4); \
    GAPB(o[0]=__builtin_amdgcn_mfma_f32_32x32x16_bf16(PAF(3),VFR(3),o[0],0,0,0), C1,8); \
    GAPB(o[1]=__builtin_amdgcn_mfma_f32_32x32x16_bf16(PAF(3),VFR(7),o[1],0,0,0), C1,12); \
    if((t)+1<NT){ BIASLD(P0,P1,(t)+1); } \
    }while(0)
  int t=1;
  #undef CMASK
  #define CMASK(P0,P1,t) do{}while(0)
  for(;t+5<NT;t+=2){
    STEP(pB0,pB1,pA0,pA1,t,true,true,true);     WAIT_BAR(2); RESC(); ROT();
    STEP(pA0,pA1,pB0,pB1,t+1,true,true,true);   WAIT_BAR(2); RESC(); ROT();
  }
  #undef CMASK
  #define CMASK(P0,P1,t) do{int jb_=(t)-(NT-4); if(jb_>=0)cmask(P0,P1,jb_,qrel,hi);}while(0)
  #define ENDW(tt) do{ if((tt)+3<NT){WAIT_BAR(2);} else if((tt)+2<NT){WAIT_BAR(1);} else {WAIT_BAR(0);} }while(0)
  for(;t+1<NT;t+=2){
    STEP(pB0,pB1,pA0,pA1,t,(t+3<NT),(t+1<NT),(t+1<NT));       ENDW(t);   RESC(); ROT();
    STEP(pA0,pA1,pB0,pB1,t+1,(t+4<NT),(t+2<NT),(t+2<NT));     ENDW(t+1); RESC(); ROT();
  }
  STEP(pB0,pB1,pA0,pA1,NT-1,false,false,false); RESC();
  { float sacc=pB0[0]+pB0[1]; _Pragma("unroll") for(int r=2;r<16;++r)sacc+=pB0[r]; _Pragma("unroll") for(int r=0;r<16;++r)sacc+=pB1[r]; l_reg+=sacc;
    pw0=(u32x4){PKW(pB0,0),PKW(pB0,2),PKW(pB0,4),PKW(pB0,6)};pw1=(u32x4){PKW(pB0,8),PKW(pB0,10),PKW(pB0,12),PKW(pB0,14)};pw2=(u32x4){PKW(pB1,0),PKW(pB1,2),PKW(pB1,4),PKW(pB1,6)};pw3=(u32x4){PKW(pB1,8),PKW(pB1,10),PKW(pB1,12),PKW(pB1,14)};
    SBAR(); pv(o,vb0+sl_cur,PAF(0),PAF(1),PAF(2),PAF(3)); }
  #undef PKW
  #undef PAF
  #undef VFR
  #undef PIN
  #undef MX3
  #undef GAPA
  #undef GAPB
  #undef EX
  #undef VRD
  #undef KRD
  #undef STEP
  #undef ENDW
  {auto rr=__builtin_amdgcn_permlane32_swap(__float_as_uint(l_reg),__float_as_uint(l_reg),false,false);l_reg=__uint_as_float(rr[0])+__uint_as_float(rr[1]);}
  if(hi==0)wsf[32+r32]=l_reg;asm volatile("s_waitcnt lgkmcnt(0)":::"memory");
  float rli[16];
  #pragma unroll
  for(int r=0;r<16;++r)rli[r]=__builtin_amdgcn_rcpf(wsf[32+crow(r,hi)]);
  bf16*Ow=O+(rowbase+q0+wid*QBLK)*OP+h*D;
  { bf16*stg=(bf16*)(shm+LDS_OST)+wid*2048;
    #pragma unroll
    for(int r=0;r<16;++r){const int orow=crow(r,hi);
      #pragma unroll
      for(int d0=0;d0<2;++d0)stg[orow*64+d0*32+r32]=__float2bfloat16(o[d0][r]*rli[r]);}
    asm volatile("s_waitcnt lgkmcnt(0)":::"memory");
    #pragma unroll
    for(int i=0;i<4;++i){const int row=i*8+(lane>>3),ch=lane&7; const u32x4 v=*(const u32x4*)(stg+row*64+ch*8); ATTN_STORE16(Ow+(long)row*OP+ch*8,v);} }
  asm volatile("s_waitcnt lgkmcnt(0)\n\ts_barrier":::"memory");
  #undef DMA_K
  #undef DMA_V
  #undef BIASLD
  #undef CMASK
  #undef START
  #undef RESC
  #undef ROT
}
constexpr int ATTN_LDS_BYTES=LDS_BYTES;
#undef SBAR
#undef WAIT_BAR
}


constexpr size_t MiB = 1u << 20;
constexpr size_t WS_CTL = 0, CTL_ZERO_BYTES = 1 * MiB;
constexpr size_t WS_WSMALL = 1 * MiB;
constexpr size_t WL_WIN = 0, WL_LORA = 18 * MiB, WL_BR = WL_LORA + 768 * 1024, WL_WOUT = WL_BR + 4 * MiB, WL_STRIDE = WL_WOUT + 2 * MiB;
constexpr size_t WS_WEXP = 100 * MiB;
constexpr size_t WS_PMIX = 196 * MiB;
constexpr size_t WS_MISC = 564 * MiB;
constexpr size_t WS_PGATE = 568 * MiB;
constexpr size_t WS_RA = 760 * MiB;
constexpr size_t WS_RB = 888 * MiB;
constexpr size_t WS_ROUTE = 1016 * MiB;
constexpr size_t WS_END = 1024 * MiB;
static_assert(WS_WSMALL + 4 * WL_STRIDE <= WS_WEXP, "small weights");
constexpr size_t WS_MERGED = WS_PMIX;
constexpr size_t WS_X1 = WS_RA;
constexpr size_t WS_LIN = WS_RA, WS_LOUT = WS_RA + 16 * MiB, WS_CK = WS_RA + 112 * MiB, WS_SSQ = WS_RA + 113 * MiB;
constexpr size_t WS_DTCS = WS_RA + 115 * MiB;
constexpr size_t WS_HALO = WS_ROUTE + 1 * MiB;
constexpr int CW_QUEUE = 12288;
constexpr size_t WS_OR = WS_RB, WS_OF = WS_RB + 32 * MiB, WS_OM0 = WS_RB + 64 * MiB, WS_OM1 = WS_RB + 96 * MiB, WS_XB = WS_RB;
constexpr size_t WS_GATEW = WS_ROUTE, WS_CNT = WS_ROUTE + 512 * 1024;
constexpr size_t WS_POS = WS_ROUTE + 256 * 1024;
constexpr size_t WS_ROWTOK = WS_ROUTE + 6 * MiB;
constexpr size_t WS_TAB = WS_ROUTE + 768 * 1024;
constexpr int MPAD = 73728;
constexpr size_t WS_XG = 196 * MiB, WS_H = 340 * MiB, WS_YS = 412 * MiB;
constexpr size_t WEXP_GU = 0, WEXP_D = 64 * MiB;
constexpr int CW_BAR = 1024;
constexpr int CW_CNT = 16384, CNT_STRIDE = 32;

constexpr int RING_OFF = 0, RING_BYTES = 131072;
constexpr int LDS_BYTES = 147456;
constexpr int LDSCTL_OFF = LDS_BYTES - 4096, MISC_OFF = LDSCTL_OFF;
constexpr int LTOK_OFF = RING_OFF + RING_BYTES, LTOK_UNITS = 11;
static_assert(LTOK_OFF + LTOK_UNITS * 1024 <= LDSCTL_OFF, "ltok");
constexpr int LTAB_OFF = LDSCTL_OFF + 256;
constexpr int ROUTER_LD = 1028;
static_assert(NEXP * ROUTER_LD * 4 <= LDSCTL_OFF, "router table");
constexpr int NWAVES = 8;

__device__ __forceinline__ void tr_item(const float* W, size_t ldw, int k0, int srccol, bf16* WT, size_t Kd, int drow0, int dk0, LAS float* scr, int lane, const float* kscale = nullptr) {
#pragma unroll 8
    for (int i = 0; i < 32; ++i) { const int kk = 2 * i + (lane >> 5); float wv = srccol >= 0 ? W[(size_t)(k0 + kk) * ldw + srccol] : 0.f; if (kscale) wv *= kscale[k0 + kk]; scr[kk * 33 + (lane & 31)] = wv; }
    LDS_WAIT(); asm volatile("" ::: "memory");
    const int c = lane & 7;
#pragma unroll
    for (int j = 0; j < 4; ++j) { const int n = (lane >> 3) + 8 * j; const LAS float* s = scr + (8 * c) * 33 + n;
        v4u o; o.x = pk2(s[0 * 33], s[1 * 33]); o.y = pk2(s[2 * 33], s[3 * 33]); o.z = pk2(s[4 * 33], s[5 * 33]); o.w = pk2(s[6 * 33], s[7 * 33]);
        *(GAS v4u*)(WT + (size_t)(drow0 + n) * Kd + dk0 + 8 * c) = o; }
    LDS_WAIT(); asm volatile("" ::: "memory");
}
__device__ __forceinline__ void tr4_load(f32x4 (&v)[8], const float* W, size_t ldw, int k0, int n0, int lane, const float* kscale) {
    const int rr = lane >> 3, c4 = (lane & 7) * 4;
#pragma unroll
    for (int i = 0; i < 8; ++i) v[i] = *(const GAS f32x4*)(W + (size_t)(k0 + 8 * i + rr) * ldw + n0 + c4);
    if (kscale) {
#pragma unroll
        for (int i = 0; i < 8; ++i) v[i] = v[i] * kscale[k0 + 8 * i + rr]; }
}
__device__ __forceinline__ void tr4_store(const f32x4 (&v)[8], bf16* WT, size_t Kd, int drow0, int dk0, LAS float* scr, int lane) {
    const int rr = lane >> 3, c4 = (lane & 7) * 4;
#pragma unroll
    for (int i = 0; i < 8; ++i) { LAS float* d = scr + (8 * i + rr) * 33 + c4; d[0] = v[i].x; d[1] = v[i].y; d[2] = v[i].z; d[3] = v[i].w; }
    LDS_WAIT(); asm volatile("" ::: "memory");
    const int c = lane & 7;
#pragma unroll
    for (int j = 0; j < 4; ++j) { const int n = (lane >> 3) + 8 * j; const LAS float* sp = scr + (8 * c) * 33 + n;
        v4u o; o.x = pk2(sp[0 * 33], sp[1 * 33]); o.y = pk2(sp[2 * 33], sp[3 * 33]); o.z = pk2(sp[4 * 33], sp[5 * 33]); o.w = pk2(sp[6 * 33], sp[7 * 33]);
        *(GAS v4u*)(WT + (size_t)(drow0 + n) * Kd + dk0 + 8 * c) = o; }
    LDS_WAIT(); asm volatile("" ::: "memory");
}
__device__ __forceinline__ void tr_item4(const float* W, size_t ldw, int k0, int n0, bf16* WT, size_t Kd, int drow0, int dk0, LAS float* scr, int lane, const float* kscale = nullptr) {
    f32x4 v[8]; tr4_load(v, W, ldw, k0, n0, lane, kscale); tr4_store(v, WT, Kd, drow0, dk0, scr, lane);
}
__device__ __forceinline__ int win_srccol(int r) { return r < 3328 ? r : r < 5888 ? r + 8 : r < 5896 ? r - 2560 : r < 5912 ? r : r < 6144 ? -1 : r - 232; }

__device__ __forceinline__ unsigned char* opaque_ptr(unsigned char* p) { GAS unsigned char* g = (GAS unsigned char*)p; asm volatile("" : "+s"(g)); return (unsigned char*)g; }
__device__ __forceinline__ int lane_id() { int x; asm volatile("v_mbcnt_lo_u32_b32 %0, -1, 0\n\tv_mbcnt_hi_u32_b32 %0, -1, %0" : "=v"(x)); return x; }
__device__ __forceinline__ float shfl_f(float v, int src) { return __int_as_float(__builtin_amdgcn_ds_bpermute(src << 2, __float_as_int(v))); }
__device__ __forceinline__ int shfl_i(int v, int src) { return __builtin_amdgcn_ds_bpermute(src << 2, v); }
__device__ __forceinline__ float shx(float v, int m, int lane) { return shfl_f(v, lane ^ m); }
template <int CTRL> __device__ __forceinline__ float dpp_f(float v) { return __builtin_bit_cast(float, __builtin_amdgcn_update_dpp(0, __builtin_bit_cast(int, v), CTRL, 0xF, 0xF, false)); }
__device__ __forceinline__ float sum8(float v) { v += dpp_f<0xB1>(v); v += dpp_f<0x4E>(v); v += dpp_f<0x141>(v); return v; }
__device__ __forceinline__ float sum16(float v) { v = sum8(v); v += dpp_f<0x140>(v); return v; }
template <int CTRL, int RMASK> __device__ __forceinline__ float dpp_fm(float v) { return __builtin_bit_cast(float, __builtin_amdgcn_update_dpp(0, __builtin_bit_cast(int, v), CTRL, RMASK, 0xF, true)); }
__device__ __forceinline__ float wave_scan(float v) {
    v += dpp_fm<0x111, 0xF>(v); v += dpp_fm<0x112, 0xF>(v); v += dpp_fm<0x114, 0xF>(v); v += dpp_fm<0x118, 0xF>(v);
    v += __builtin_bit_cast(float, __builtin_amdgcn_update_dpp(0, __builtin_bit_cast(int, v), 0x142, 0xA, 0xF, false));
    v += __builtin_bit_cast(float, __builtin_amdgcn_update_dpp(0, __builtin_bit_cast(int, v), 0x143, 0xC, 0xF, false));
    return v;
}
__device__ __forceinline__ float wsum(float v, int lane) {
    v = sum16(v); (void)lane;
    const float r0 = __builtin_bit_cast(float, __builtin_amdgcn_readlane(__builtin_bit_cast(int, v), 0)), r1 = __builtin_bit_cast(float, __builtin_amdgcn_readlane(__builtin_bit_cast(int, v), 16));
    const float r2 = __builtin_bit_cast(float, __builtin_amdgcn_readlane(__builtin_bit_cast(int, v), 32)), r3 = __builtin_bit_cast(float, __builtin_amdgcn_readlane(__builtin_bit_cast(int, v), 48));
    return (r0 + r1) + (r2 + r3);
}
#define LBAR() asm volatile("s_waitcnt lgkmcnt(0)\n\ts_barrier" ::: "memory")
#define PHASE_IDS const int wave = opaque_int(wave0), lane = lane_id(), tid = wave * 64 + lane; const int G = opaque_int((int)gridDim.x), bx = opaque_int((int)blockIdx.x); \
    const int vcu = (G % 8 == 0) ? (bx % 8) * (G / 8) + bx / 8 : bx; const int gw = vcu * NWAVES + wave, NGW = G * NWAVES; LAS float* scr = (LAS float*)(lds + RING_OFF + wave * 16384); (void)tid; (void)gw; (void)NGW; (void)scr; (void)lane
struct Args;
__device__ __forceinline__ int opaque_int(int i) { asm volatile("" : "+s"(i)); return i; }
struct Args { const float* in[N_IN]; float* out; unsigned char* ws; int prologue, l_lo, l_hi, ph_lo, ph_hi, pad; };
enum { PH_EXPW = 0, PH_INPROJ = 1, PH_PREP = 2, PH_LORA = 3, PH_MIX = 4, PH_FIN = 5, PH_MERGE = 6, PH_WOUT = 7, PH_LN1 = 8, PH_DISPATCH = 9, PH_GU = 10, PH_DOWN = 11, PH_LN2 = 12, PH_COUNT = 13 };

__global__ void __launch_bounds__(NWAVES * 64, 2) mk_fwd(Args a) {
    extern __shared__ __attribute__((aligned(16))) unsigned char lds_raw[];
    LAS unsigned char* lds = (LAS unsigned char*)lds_raw;
    const int wave0 = __builtin_amdgcn_readfirstlane((int)threadIdx.x >> 6);
    const int wave = wave0, lane = lane_id(), tid = wave * 64 + lane;
    const int G = gridDim.x; const int bx = blockIdx.x; const int vcu = (G % 8 == 0) ? (bx % 8) * (G / 8) + bx / 8 : bx;
    unsigned char* ws = a.ws;
    for (int u = tid; u < (LDS_BYTES - LDSCTL_OFF) / 4; u += NWAVES * 64) ((LAS unsigned*)(lds + LDSCTL_OFF))[u] = 0u;
    __syncthreads();
    const bool one_launch = a.prologue && (a.l_hi - a.l_lo) * (a.ph_hi - a.ph_lo) > 1;
    unsigned bar_x = 0u;
    if (one_launch) bar_x = xcd_barrier_post((unsigned*)(a.ws + WS_CTL) + CW_BAR, (volatile LAS unsigned*)(lds + MISC_OFF) + 8).x;
#define SEAM() do { if (a.prologue && (a.l_hi - a.l_lo) * (a.ph_hi - a.ph_lo) > 1) { XcdBarrier b2_; b2_.bar = (unsigned*)(opaque_ptr(a.ws) + WS_CTL) + CW_BAR; b2_.x = (unsigned)opaque_int((int)bar_x); b2_.st = (volatile LAS unsigned*)(lds + MISC_OFF) + 8; xcd_barrier(b2_); } } while (0)
    const int gw = vcu * NWAVES + wave, NGW = G * NWAVES;
    LAS float* scr = (LAS float*)(lds + RING_OFF + wave * 16384);

    if (a.prologue) {
        constexpr int I_WINI = 16 * 280, I_BRI = 8 * 32, I_WOI = 16 * 32, I_LAYER = I_WINI + 4 * I_BRI + I_WOI;
        auto dsc = [&](int it, const float*& W, size_t& ldw, int& k0, int& n0, bf16*& WT, size_t& Kd, int& drow0, int& dk0, const float*& ks) {
            const int l = it / I_LAYER; int r = it % I_LAYER; unsigned char* wl = ws + WS_WSMALL + (size_t)l * WL_STRIDE; ks = nullptr;
            if (r < I_WINI) { const int kb = r / 280, q = r % 280, nb = q < 184 ? q : q + 8;
                W = a.in[opaque_int(I_WIN)] + (size_t)l * D * IN_COLS; ldw = IN_COLS; k0 = 64 * kb; n0 = win_srccol(32 * nb); WT = (bf16*)(wl + WL_WIN); Kd = 1024; drow0 = 32 * nb; dk0 = 64 * kb; return; }
            r -= I_WINI;
            if (r < 4 * I_BRI) { const int sg = r / I_BRI, q = r % I_BRI, kb = q / 32, nb = q % 32;
                W = sg == 0 ? a.in[opaque_int(I_BRR)] + (size_t)l * 512 * D : sg == 1 ? a.in[opaque_int(I_BRF)] + (size_t)l * 512 * D : a.in[opaque_int(I_BRM)] + (size_t)l * 1024 * D + (size_t)(sg - 2) * 512 * D;
                ldw = D; k0 = 64 * kb; n0 = 32 * nb; WT = (bf16*)(wl + WL_BR + (size_t)sg * MiB); Kd = 512; drow0 = 32 * nb; dk0 = 64 * kb;
                if (sg >= 2) ks = a.in[I_NG] + (size_t)l * SSM_DIM + (size_t)(sg - 2) * 512; return; }
            r -= 4 * I_BRI;
            { const int kb = r / 32, nb = r % 32;
              W = a.in[opaque_int(I_WO)] + (size_t)l * D * D; ldw = D; k0 = 64 * kb; n0 = 32 * nb; WT = (bf16*)(wl + WL_WOUT); Kd = 1024; drow0 = 32 * nb; dk0 = 64 * kb; }
        };
        for (int it = gw; it < DEPTH * I_LAYER; it += 2 * NGW) {
            const float *W0, *W1, *ks0, *ks1; size_t ldw0, ldw1, Kd0, Kd1; int k00, k01, n00, n01, dr0, dr1, dk00, dk01; bf16 *WT0, *WT1;
            const bool two = it + NGW < DEPTH * I_LAYER;
            dsc(it, W0, ldw0, k00, n00, WT0, Kd0, dr0, dk00, ks0); dsc(two ? it + NGW : it, W1, ldw1, k01, n01, WT1, Kd1, dr1, dk01, ks1);
            f32x4 v0[8], v1[8];
            tr4_load(v0, W0, ldw0, k00, n00, lane, ks0); tr4_load(v1, W1, ldw1, k01, n01, lane, ks1);
            tr4_store(v0, WT0, Kd0, dr0, dk00, scr, lane);
            if (two) tr4_store(v1, WT1, Kd1, dr1, dk01, scr, lane);
        }
        for (int it = gw; it < DEPTH * 16 * 8; it += NGW) { const int l = it >> 7, kb = (it >> 3) & 15, nb = 184 + (it & 7);
            tr_item(a.in[opaque_int(I_WIN)] + (size_t)l * D * IN_COLS, IN_COLS, 64 * kb, win_srccol(32 * nb + (lane & 31)), (bf16*)(ws + WS_WSMALL + (size_t)l * WL_STRIDE + WL_WIN), 1024, 32 * nb, 64 * kb, scr, lane); }
        for (int it = gw; it < DEPTH * 64; it += NGW) {
            const int l = it >> 6, r = it & 63; bf16* LT = (bf16*)(ws + WS_WSMALL + (size_t)l * WL_STRIDE + WL_LORA);
            if (r < 16) tr_item4(a.in[I_WUP] + (size_t)l * 64 * 512, 512, 0, 32 * r, LT, 256, 32 * r, 0, scr, lane);
            else if (r < 32) tr_item4(a.in[I_AUP] + (size_t)l * 64 * 512, 512, 0, 32 * (r - 16), LT, 256, 512 + 32 * (r - 16), 64, scr, lane);
            else { const int q = r - 32, kb = q >> 4, nb = q & 15; tr_item4(a.in[I_GUP] + (size_t)l * 128 * 512, 512, 64 * kb, 32 * nb, LT, 256, 1024 + 32 * nb, 128 + 64 * kb, scr, lane); }
        }
        for (int idx = gw * 64 + lane; idx < DEPTH * 1536 * 32; idx += NGW * 64) {
            const int l = idx / (1536 * 32), r = idx % (1536 * 32), n = r >> 5, k8 = (r & 31) * 8;
            const bool nz = (n < 512) ? (k8 < 64) : (n < 1024) ? (k8 >= 64 && k8 < 128) : (k8 >= 128);
            if (!nz) *(GAS v4u*)((bf16*)(ws + WS_WSMALL + (size_t)l * WL_STRIDE + WL_LORA) + (size_t)n * 256 + k8) = (v4u){0u, 0u, 0u, 0u};
        }
        for (int m = gw; m < NTOK; m += 4 * NGW) {
            f32x4 v[4][4];
#pragma unroll
            for (int u = 0; u < 4; ++u) { const int mm = (m + u * NGW < NTOK) ? m + u * NGW : m; const GAS f32x4* xr = (const GAS f32x4*)(a.in[opaque_int(I_X)] + (size_t)mm * D) + lane;
#pragma unroll
                for (int j = 0; j < 4; ++j) v[u][j] = xr[64 * j]; }
#pragma unroll
            for (int u = 0; u < 4; ++u) { if (m + u * NGW >= NTOK) break; GAS unsigned long long* o8 = (GAS unsigned long long*)((bf16*)a.out + (size_t)(m + u * NGW) * D) + lane;
#pragma unroll
                for (int j = 0; j < 4; ++j) o8[64 * j] = (unsigned long long)pk2(v[u][j].x, v[u][j].y) | ((unsigned long long)pk2(v[u][j].z, v[u][j].w) << 32); }
        }
        SEAM();
    }
#define IN(k) (opaque_int(a.ph_lo) <= (k) && (k) < opaque_int(a.ph_hi))
    for (int l = a.l_lo; l < a.l_hi; ++l) {
        if (IN(PH_PREP)) { PHASE_IDS;
            unsigned char* ws = opaque_ptr(a.ws);
            constexpr int I_G = NEXP * 16 * 16, I_D = NEXP * 8 * 32;
            for (int it = gw; it < 2 * I_G + I_D; it += NGW) {
                if (it < 2 * I_G) { const int up = it >= I_G, r = it - up * I_G, e = r >> 8, q = r & 255, kb = q >> 4, nb = q & 15, n0 = 32 * nb;
                    const float* W = (up ? a.in[opaque_int(I_EU)] : a.in[opaque_int(I_EG)]) + ((size_t)l * NEXP + e) * D * DEXP;
                    tr_item4(W, DEXP, 64 * kb, n0, (bf16*)(ws + WS_WEXP + WEXP_GU) + (size_t)e * 1024 * 1024, 1024, 256 * (n0 >> 7) + (n0 & 127) + 128 * up, 64 * kb, scr, lane);
                } else { const int r = it - 2 * I_G, e = r >> 8, q = r & 255, kb = q >> 5, nb = q & 31;
                    const float* W = a.in[opaque_int(I_ED)] + ((size_t)l * NEXP + e) * DEXP * D;
                    tr_item4(W, D, 64 * kb, 32 * nb, (bf16*)(ws + WS_WEXP + WEXP_D) + (size_t)e * 1024 * 512, 512, 32 * nb, 64 * kb, scr, lane); }
            }
            __syncthreads();
        }
        if (IN(PH_INPROJ)) { PHASE_IDS;
            unsigned char* ws = opaque_ptr(a.ws); unsigned char* wl = ws + WS_WSMALL + (size_t)l * WL_STRIDE;
            pg8::DenseOrder S; S.init(a.out, wl + WL_WIN, NTOK, NPROJ, D, G, bx);
            pg8::EpiProj E{(bf16*)(ws + WS_PMIX), (bf16*)(ws + WS_PGATE), (float*)(ws + WS_MISC), a.in[opaque_int(I_GB)] + (size_t)l * 3 * D};
            pg8::gemm_phase<pg8::EpiProj, pg8::DenseOrder, true, true>(lds + RING_OFF, D, S, E, wave0);
        }
        if (IN(PH_INPROJ)) SEAM();
        if (IN(PH_PREP)) { PHASE_IDS;
            unsigned char* ws = opaque_ptr(a.ws);
            const bf16* pmix = (const bf16*)(ws + WS_PMIX);
            { const float* mu = a.in[I_MU] + (size_t)l * RWKV_COLS + 1536 + 4 * lane; const f32x4 m4 = *(const f32x4*)mu;
              bf16* lin = (bf16*)(ws + WS_LIN);
              for (int tokp = gw; tokp < NTOK; tokp += 4 * NGW) {
                  unsigned long long cw[4], pw[4];
#pragma unroll
                  for (int u = 0; u < 4; ++u) { const int tok = (tokp + u * NGW < NTOK) ? tokp + u * NGW : tokp;
                      cw[u] = *(const unsigned long long*)(pmix + (size_t)tok * PMIX_LD + C_RW + 1536 + 4 * lane);
                      pw[u] = 0ull; if (tok % SEQ) pw[u] = *(const unsigned long long*)(pmix + (size_t)(tok - 1) * PMIX_LD + C_RW + 1536 + 4 * lane); }
#pragma unroll
                  for (int u = 0; u < 4; ++u) { const int tok = tokp + u * NGW; if (tok >= NTOK) break;
                      float c[4], q[4];
                      c[0] = __uint_as_float((unsigned)cw[u] << 16); c[1] = __uint_as_float((unsigned)cw[u] & 0xffff0000u); c[2] = __uint_as_float((unsigned)(cw[u] >> 32) << 16); c[3] = __uint_as_float((unsigned)(cw[u] >> 32) & 0xffff0000u);
                      q[0] = __uint_as_float((unsigned)pw[u] << 16); q[1] = __uint_as_float((unsigned)pw[u] & 0xffff0000u); q[2] = __uint_as_float((unsigned)(pw[u] >> 32) << 16); q[3] = __uint_as_float((unsigned)(pw[u] >> 32) & 0xffff0000u);
#pragma unroll
                      for (int i = 0; i < 4; ++i) { float x = c[i] + m4[i] * (q[i] - c[i]); if (lane < 16) x = tanhf_(x); else if (lane >= 32) x = sigmoidf_(x); c[i] = x; }
                      *(unsigned long long*)(lin + (size_t)tok * 256 + 4 * lane) = (unsigned long long)pk2(c[0], c[1]) | ((unsigned long long)pk2(c[2], c[3]) << 32); }
              } }
            if (gw < BATCH * FOX_HEADS) {
                const int b = gw >> 3, h = gw & 7; const float fb = a.in[I_FB][l * FOX_HEADS + h];
                const float* misc = (const float*)(ws + WS_MISC); float* ck = (float*)(ws + WS_CK) + (size_t)gw * SEQ;
                float carry = 0.f;
#pragma unroll 4
                for (int s0 = 0; s0 < SEQ; s0 += 64) {
                    float v = -softplusf_(-(misc[((size_t)b * SEQ + s0 + lane) * 32 + h] + fb)) * 1.4426950408889634f;
                    v = wave_scan(v) + carry; ck[s0 + lane] = v; carry = __builtin_bit_cast(float, __builtin_amdgcn_readlane(__builtin_bit_cast(int, v), 63));
                }
            }
            for (int task = gw; task < BATCH * 16 * 16; task += NGW) {
                const int c = task & 15, h = (task >> 4) & 15, bb = task >> 8;
                const float A = -__expf(a.in[opaque_int(I_ALOG)][l * SSM_HEADS + h]), dtb = a.in[opaque_int(I_DTB)][l * SSM_HEADS + h];
                const float* misc = (const float*)(ws + WS_MISC); const size_t tok0 = (size_t)bb * SEQ + c * 128;
                const float d0 = softplusf_(misc[(tok0 + 2 * lane) * 32 + 8 + h] + dtb), d1 = softplusf_(misc[(tok0 + 2 * lane + 1) * 32 + 8 + h] + dtb);
                const float a0 = d0 * A, a1 = d1 * A; const float sc = wave_scan(a0 + a1);
                *(f32x4*)((float*)(ws + WS_DTCS) + (((size_t)(bb * 16 + h) * SEQ + c * 128 + 2 * lane) * 2)) = (f32x4){d0, sc - a1, d1, sc};
            }
            { int* rowtok = (int*)(ws + WS_ROWTOK); for (int idx = gw * 64 + lane; idx < MPAD; idx += NGW * 64) rowtok[idx] = 0; }
            for (int it = gw; it < BATCH * 32 * 3; it += NGW) {
                const int bb = it / 96, r = it % 96, c = r / 3, k = r % 3;
                if (c == 0) continue;
                const bf16* src = (const bf16*)(ws + WS_PMIX) + ((size_t)bb * SEQ + c * 64 - 3 + k) * PMIX_LD + C_SX;
                bf16* dst = (bf16*)(ws + WS_HALO) + (size_t)it * SSM_CONV_DIM;
#pragma unroll
                for (int j = 0; j < 3; ++j) *((v4u*)dst + lane + 64 * j) = *((const v4u*)src + lane + 64 * j);
            }
        }
        if (IN(PH_PREP)) SEAM();
        if (IN(PH_LORA)) { PHASE_IDS;
            unsigned char* ws = opaque_ptr(a.ws); unsigned char* wl = ws + WS_WSMALL + (size_t)l * WL_STRIDE;
            pg8::DenseOrder S; S.init(ws + WS_LIN, wl + WL_LORA, NTOK, 1536, 256, G, bx);
            pg8::EpiBf16<1536> E{(bf16*)(ws + WS_LOUT)};
            pg8::gemm_phase<pg8::EpiBf16<1536>, pg8::DenseOrder, true, true>(lds + RING_OFF, 256, S, E, wave0);
            {   const int lane = lane_id(), tid = wave * 64 + lane;
                const float* cwp = a.in[opaque_int(I_CW)] + (size_t)l * 4 * SSM_CONV_DIM; const float* cbp = a.in[opaque_int(I_CB)] + (size_t)l * SSM_CONV_DIM;
                for (int task = vcu * 384 + tid; tid < 384 && task < BATCH * 16 * 384; task += G * 384) {
                    const int oc = task % 192, r = task / 192, c = r & 31, bb = r >> 5;
                    float cw[4][8], cb[8];
#pragma unroll
                    for (int i = 0; i < 8; ++i) { cb[i] = cbp[8 * oc + i];
#pragma unroll
                        for (int w = 0; w < 4; ++w) cw[w][i] = cwp[w * SSM_CONV_DIM + 8 * oc + i]; }
                    bf16* rowp = (bf16*)(ws + WS_PMIX) + ((size_t)bb * SEQ + c * 64) * PMIX_LD + C_SX + 8 * oc;
                    float w1[8], w2[8], w3[8];
                    if (c == 0) {
#pragma unroll
                        for (int i = 0; i < 8; ++i) { w1[i] = 0.f; w2[i] = 0.f; w3[i] = 0.f; } }
                    else { const bf16* hp = (const bf16*)(ws + WS_HALO) + (size_t)((bb * 32 + c) * 3) * SSM_CONV_DIM + 8 * oc;
                        pg8::unpack8(*(const pg8::u32x4*)hp, w1); pg8::unpack8(*(const pg8::u32x4*)(hp + SSM_CONV_DIM), w2); pg8::unpack8(*(const pg8::u32x4*)(hp + 2 * SSM_CONV_DIM), w3); }
                    pg8::u32x4 raw[8], nxt[8];
#pragma unroll
                    for (int j = 0; j < 8; ++j) raw[j] = *(const pg8::u32x4*)(rowp + (size_t)j * PMIX_LD);
#pragma unroll 1
                    for (int t0 = 0; t0 < 64; t0 += 8) {
                        { const int tn = (t0 + 8 < 64) ? t0 + 8 : t0;
#pragma unroll
                          for (int j = 0; j < 8; ++j) nxt[j] = *(const pg8::u32x4*)(rowp + (size_t)(tn + j) * PMIX_LD); }
#pragma unroll
                        for (int j = 0; j < 8; ++j) {
                            float w0[8], o8[8];
#pragma unroll
                            for (int i = 0; i < 8; ++i) { w0[i] = w1[i]; w1[i] = w2[i]; w2[i] = w3[i]; }
                            pg8::unpack8(raw[j], w3);
#pragma unroll
                            for (int i = 0; i < 8; ++i) o8[i] = siluf_(cb[i] + cw[0][i] * w0[i] + cw[1][i] * w1[i] + cw[2][i] * w2[i] + cw[3][i] * w3[i]);
                            pg8::u32x4 pk; pk.x = pk2(o8[0], o8[1]); pk.y = pk2(o8[2], o8[3]); pk.z = pk2(o8[4], o8[5]); pk.w = pk2(o8[6], o8[7]);
                            *(pg8::u32x4*)(rowp + (size_t)(t0 + j) * PMIX_LD) = pk;
                        }
#pragma unroll
                        for (int j = 0; j < 8; ++j) raw[j] = nxt[j];
                    }
                }
            }
        }
        if (IN(PH_LORA)) SEAM();
        if (IN(PH_MIX)) { PHASE_IDS;
            unsigned char* ws = opaque_ptr(a.ws);
            unsigned* qhead = (unsigned*)(ws + WS_CTL) + CW_QUEUE + 64 * l;
            LAS int* qslot = (LAS int*)(lds + LDSCTL_OFF + 64);
            for (;;) {
                __syncthreads();
                if (tid == 0) qslot[0] = (int)atomicAdd(qhead, 1u);
                __syncthreads();
                const int unit = __builtin_amdgcn_readfirstlane(qslot[0]);
                if (unit >= 128 + 1024 + 256) break;
                if (unit < 128) {
                    constexpr int T = 32, BUF = 8 * T * 64;
                    const int wave = opaque_int(wave0), lane = lane_id();
                    const int b = unit >> 3, h = unit & 7;
                    LAS float* L0 = (LAS float*)lds;
                    const bf16* pmix = (const bf16*)(ws + WS_PMIX); const bf16* lout = (const bf16*)(ws + WS_LOUT); bf16* o_r = (bf16*)(ws + WS_OR);
                    __syncthreads();
                    if (wave >= 4) {
                        const int a4 = wave - 4, c4 = (lane & 15) * 4, ch = h * 64 + c4, tq = lane >> 4;
                        const f32x4 mu_r = *(const f32x4*)(a.in[opaque_int(I_MU)] + (size_t)l * RWKV_COLS + ch), mu_k = *(const f32x4*)(a.in[opaque_int(I_MU)] + (size_t)l * RWKV_COLS + 512 + ch), mu_v = *(const f32x4*)(a.in[opaque_int(I_MU)] + (size_t)l * RWKV_COLS + 1024 + ch);
                        const f32x4 w0 = *(const f32x4*)(a.in[opaque_int(I_W0)] + l * 512 + ch), a0 = *(const f32x4*)(a.in[opaque_int(I_A0)] + l * 512 + ch), kkw = *(const f32x4*)(a.in[opaque_int(I_KK)] + l * 512 + ch), kaw = *(const f32x4*)(a.in[opaque_int(I_KA)] + l * 512 + ch);
                        const f32x4 rk4 = *(const f32x4*)(a.in[opaque_int(I_RK)] + l * 512 + ch), gg4 = *(const f32x4*)(a.in[opaque_int(I_GNG)] + l * 512 + ch), gb4 = *(const f32x4*)(a.in[opaque_int(I_GNB)] + l * 512 + ch);
                        auto up4 = [](unsigned long long w, float* f) { f[0] = __uint_as_float((unsigned)w << 16); f[1] = __uint_as_float((unsigned)w & 0xffff0000u); f[2] = __uint_as_float((unsigned)(w >> 32) << 16); f[3] = __uint_as_float((unsigned)(w >> 32) & 0xffff0000u); };
                        unsigned long long R[2][9];
                        auto dload = [&](int c0) {
#pragma unroll
                            for (int u = 0; u < 2; ++u) { const int tt = 16 * u + 4 * a4 + tq; const size_t tok = (size_t)b * SEQ + c0 + tt; const bf16* pc = pmix + tok * PMIX_LD + C_RW + ch; const bf16* lo = lout + tok * 1536 + ch;
                                R[u][0] = *(const unsigned long long*)pc; R[u][1] = *(const unsigned long long*)(pc + 512); R[u][2] = *(const unsigned long long*)(pc + 1024);
                                if (c0 + tt > 0) { R[u][3] = *(const unsigned long long*)(pc - PMIX_LD); R[u][4] = *(const unsigned long long*)(pc - PMIX_LD + 512); R[u][5] = *(const unsigned long long*)(pc - PMIX_LD + 1024); } else { R[u][3] = 0ull; R[u][4] = 0ull; R[u][5] = 0ull; }
                                R[u][6] = *(const unsigned long long*)lo; R[u][7] = *(const unsigned long long*)(lo + 512); R[u][8] = *(const unsigned long long*)(lo + 1024); }
                        };
                        auto dcomp = [&](LAS float* Lb_) {
                            LAS float* Lr = Lb_; LAS float* Lw = Lr + T * 64; LAS float* Lk = Lw + T * 64; LAS float* Lv = Lk + T * 64; LAS float* La = Lv + T * 64; LAS float* Lbb = La + T * 64; LAS float* Lg = Lbb + T * 64;
#pragma unroll
                            for (int u = 0; u < 2; ++u) { const int tt = 16 * u + 4 * a4 + tq;
                                float cr[4], ck_[4], cv[4], pr[4], pk[4], pv[4], lw[4], la[4], lg[4];
                                up4(R[u][0], cr); up4(R[u][1], ck_); up4(R[u][2], cv); up4(R[u][3], pr); up4(R[u][4], pk); up4(R[u][5], pv); up4(R[u][6], lw); up4(R[u][7], la); up4(R[u][8], lg);
                                float kk[4], av[4], ss = 0.f;
#pragma unroll
                                for (int i = 0; i < 4; ++i) {
                                    cr[i] += mu_r[i] * (pr[i] - cr[i]); ck_[i] += mu_k[i] * (pk[i] - ck_[i]); cv[i] += mu_v[i] * (pv[i] - cv[i]);
                                    lw[i] = __expf(-0.6065306597126334f * sigmoidf_(w0[i] + lw[i]));
                                    av[i] = sigmoidf_(a0[i] + la[i]);
                                    kk[i] = ck_[i] * kkw[i]; ss += kk[i] * kk[i];
                                }
                                ss = sum16(ss);
                                const float inv = 1.f / fmaxf(sqrtf(ss), 1e-12f);
                                f32x4 o_r4, o_w4, o_k4, o_v4, o_a4, o_b4, o_g4;
#pragma unroll
                                for (int i = 0; i < 4; ++i) { const float kkn = kk[i] * inv; o_r4[i] = cr[i]; o_w4[i] = lw[i]; o_k4[i] = ck_[i] * (1.f + (av[i] - 1.f) * kaw[i]); o_v4[i] = cv[i]; o_a4[i] = -kkn; o_b4[i] = kkn * av[i]; o_g4[i] = lg[i]; }
                                *(LAS f32x4*)(Lr + tt * 64 + c4) = o_r4; *(LAS f32x4*)(Lw + tt * 64 + c4) = o_w4; *(LAS f32x4*)(Lk + tt * 64 + c4) = o_k4; *(LAS f32x4*)(Lv + tt * 64 + c4) = o_v4;
                                *(LAS f32x4*)(La + tt * 64 + c4) = o_a4; *(LAS f32x4*)(Lbb + tt * 64 + c4) = o_b4; *(LAS f32x4*)(Lg + tt * 64 + c4) = o_g4; }
                        };
                        auto post = [&](int c0, LAS float* Lb_) {
                            LAS float* Lr = Lb_; LAS float* Lk = Lr + 2 * T * 64; LAS float* Lv = Lk + T * 64; LAS float* Lg = Lr + 6 * T * 64; LAS float* Ly = Lg + T * 64;
#pragma unroll
                            for (int u = 0; u < 2; ++u) { const int tt = 16 * u + 4 * a4 + tq; const size_t tok = (size_t)b * SEQ + c0 + tt;
                                const f32x4 y4 = *(const LAS f32x4*)(Ly + tt * 64 + c4), r4 = *(const LAS f32x4*)(Lr + tt * 64 + c4), k4 = *(const LAS f32x4*)(Lk + tt * 64 + c4), v4 = *(const LAS f32x4*)(Lv + tt * 64 + c4), g4 = *(const LAS f32x4*)(Lg + tt * 64 + c4);
                                const float mean = sum16((y4[0] + y4[1]) + (y4[2] + y4[3])) * (1.f / 64.f);
                                float d[4], q = 0.f, pb = 0.f;
#pragma unroll
                                for (int i = 0; i < 4; ++i) { d[i] = y4[i] - mean; q += d[i] * d[i]; pb += r4[i] * k4[i] * rk4[i]; }
                                const float rs = rsqrtf(sum16(q) * (1.f / 64.f) + RWKV_GN_EPS);
                                const float bonus = sum16(pb);
                                float o[4];
#pragma unroll
                                for (int i = 0; i < 4; ++i) o[i] = (d[i] * rs * gg4[i] + gb4[i] + bonus * v4[i]) * g4[i];
                                *(unsigned long long*)(o_r + tok * 512 + ch) = (unsigned long long)pk2(o[0], o[1]) | ((unsigned long long)pk2(o[2], o[3]) << 32);
                            }
                        };
                        dload(0); dcomp(L0);
                        LBAR();
                        for (int c = 0; c < SEQ / T; ++c) {
                            if (c + 1 < SEQ / T) dload((c + 1) * T);
                            if (c > 0) post((c - 1) * T, L0 + ((c - 1) & 1) * BUF);
                            if (c + 1 < SEQ / T) dcomp(L0 + ((c + 1) & 1) * BUF);
                            LBAR();
                        }
                        post(SEQ - T, L0 + ((SEQ / T - 1) & 1) * BUF);
                    } else {
                        const int rg = lane >> 3, seg = lane & 7, row0 = 16 * wave + 2 * rg;
                        typedef float f32x2 __attribute__((ext_vector_type(2)));
                        f32x2 S0[4], S1[4];
#pragma unroll
                        for (int j = 0; j < 4; ++j) { S0[j] = (f32x2){0.f, 0.f}; S1[j] = (f32x2){0.f, 0.f}; }
                        LBAR();
                        __builtin_amdgcn_s_setprio(3);
                        for (int c = 0; c < SEQ / T; ++c) {
                            LAS float* Lr = L0 + (c & 1) * BUF; LAS float* Lw = Lr + T * 64; LAS float* Lk = Lw + T * 64; LAS float* Lv = Lk + T * 64; LAS float* La = Lv + T * 64; LAS float* Lbb = La + T * 64; LAS float* Ly = Lr + 7 * T * 64;
#define RW_LOAD(P, t) do { \
                                { const f32x4 x0 = *(const LAS f32x4*)(Lw + (t) * 64 + seg * 8), x1 = *(const LAS f32x4*)(Lw + (t) * 64 + seg * 8 + 4); P##w[0] = (f32x2){x0[0], x0[1]}; P##w[1] = (f32x2){x0[2], x0[3]}; P##w[2] = (f32x2){x1[0], x1[1]}; P##w[3] = (f32x2){x1[2], x1[3]}; } \
                                { const f32x4 x0 = *(const LAS f32x4*)(La + (t) * 64 + seg * 8), x1 = *(const LAS f32x4*)(La + (t) * 64 + seg * 8 + 4); P##a[0] = (f32x2){x0[0], x0[1]}; P##a[1] = (f32x2){x0[2], x0[3]}; P##a[2] = (f32x2){x1[0], x1[1]}; P##a[3] = (f32x2){x1[2], x1[3]}; } \
                                { const f32x4 x0 = *(const LAS f32x4*)(Lbb + (t) * 64 + seg * 8), x1 = *(const LAS f32x4*)(Lbb + (t) * 64 + seg * 8 + 4); P##b[0] = (f32x2){x0[0], x0[1]}; P##b[1] = (f32x2){x0[2], x0[3]}; P##b[2] = (f32x2){x1[0], x1[1]}; P##b[3] = (f32x2){x1[2], x1[3]}; } \
                                { const f32x4 x0 = *(const LAS f32x4*)(Lk + (t) * 64 + seg * 8), x1 = *(const LAS f32x4*)(Lk + (t) * 64 + seg * 8 + 4); P##k[0] = (f32x2){x0[0], x0[1]}; P##k[1] = (f32x2){x0[2], x0[3]}; P##k[2] = (f32x2){x1[0], x1[1]}; P##k[3] = (f32x2){x1[2], x1[3]}; } \
                                { const f32x4 x0 = *(const LAS f32x4*)(Lr + (t) * 64 + seg * 8), x1 = *(const LAS f32x4*)(Lr + (t) * 64 + seg * 8 + 4); P##r[0] = (f32x2){x0[0], x0[1]}; P##r[1] = (f32x2){x0[2], x0[3]}; P##r[2] = (f32x2){x1[0], x1[1]}; P##r[3] = (f32x2){x1[2], x1[3]}; } \
                                P##v0 = Lv[(t) * 64 + row0]; P##v1 = Lv[(t) * 64 + row0 + 1]; } while (0)
#define RW_STEP(P, t) do { \
                                f32x2 d0 = S0[0] * P##a[0], d1 = S1[0] * P##a[0]; \
                                _Pragma("unroll") for (int j = 1; j < 4; ++j) { d0 = S0[j] * P##a[j] + d0; d1 = S1[j] * P##a[j] + d1; } \
                                const float sa0 = sum8(d0.x + d0.y), sa1 = sum8(d1.x + d1.y); \
                                const f32x2 sa0v = (f32x2){sa0, sa0}, sa1v = (f32x2){sa1, sa1}, v0v = (f32x2){P##v0, P##v0}, v1v = (f32x2){P##v1, P##v1}; \
                                f32x2 y0 = (f32x2){0.f, 0.f}, y1 = (f32x2){0.f, 0.f}; \
                                _Pragma("unroll") for (int j = 0; j < 4; ++j) { \
                                    S0[j] = S0[j] * P##w[j] + (sa0v * P##b[j] + v0v * P##k[j]); \
                                    S1[j] = S1[j] * P##w[j] + (sa1v * P##b[j] + v1v * P##k[j]); \
                                    y0 = S0[j] * P##r[j] + y0; y1 = S1[j] * P##r[j] + y1; } \
                                float yy0 = sum8(y0.x + y0.y), yy1 = sum8(y1.x + y1.y); asm("" : "+v"(yy0), "+v"(yy1));     \
                                if (seg == 0) { Ly[(t) * 64 + row0] = yy0; Ly[(t) * 64 + row0 + 1] = yy1; } } while (0)
                            f32x2 Aw[4], Aa[4], Ab[4], Ak[4], Ar[4], Bw[4], Ba[4], Bb[4], Bk[4], Br[4]; float Av0, Av1, Bv0, Bv1;
                            RW_LOAD(A, 0);
                            for (int t = 0; t < T; t += 2) {
                                RW_LOAD(B, t + 1);
                                RW_STEP(A, t);
                                if (t + 2 < T) RW_LOAD(A, t + 2);
                                RW_STEP(B, t + 1);
                            }
#undef RW_LOAD
#undef RW_STEP
                            LBAR();
                        }
                        __builtin_amdgcn_s_setprio(0);
                    }
                } else if (unit >= 128 + 256) {
                    const int u2 = unit - 384, qb = 7 - (u2 >> 7), bh = u2 & 127;
                    attn_body::attn_unit<8>(bh >> 3, bh & 7, qb, (const attn_body::bf16*)(ws + WS_PMIX) + C_FQ, (const attn_body::bf16*)(ws + WS_PMIX) + C_FK, (const attn_body::bf16*)(ws + WS_PMIX) + C_FV,
                                            (attn_body::bf16*)(ws + WS_OF), (const float*)(ws + WS_CK) + (size_t)bh * SEQ, (char*)lds_raw, wave0);
                } else {
                    constexpr int LD = 136, XLD = 72;
                    typedef short bf16x8 __attribute__((ext_vector_type(8))); typedef short s16x4 __attribute__((ext_vector_type(4))); typedef float f32x2_t __attribute__((ext_vector_type(2)));
                    const int wave = opaque_int(wave0), lane = lane_id(), tid = wave * 64 + lane;
                    const int u3 = unit - 128, b = u3 >> 4, h = u3 & 15, g = h >> 3;
                    LAS bf16* Cm = (LAS bf16*)lds; LAS bf16* Bm = Cm + 128 * LD; LAS bf16* Xm = Bm + 128 * LD; LAS bf16* Xw = Xm + 128 * XLD; LAS bf16* St = Xw + 128 * XLD;
                    LAS float* Fd = (LAS float*)(St + 64 * LD); LAS float* Fc = Fd + 128;
                    const bf16* pmix = (const bf16*)(ws + WS_PMIX);
                    bf16* om = (bf16*)(ws + (g ? WS_OM1 : WS_OM0)); float* ssq = (float*)(ws + WS_SSQ);
                    const float* dtcs = (const float*)(ws + WS_DTCS) + (size_t)(b * 16 + h) * SEQ * 2;
                    const float Dh = a.in[opaque_int(I_DSK)][l * SSM_HEADS + h];
                    f32x4 accS[4];
#pragma unroll
                    for (int nt = 0; nt < 4; ++nt) accS[nt] = (f32x4){0.f, 0.f, 0.f, 0.f};
                    __syncthreads();
                    for (int i = tid; i < 64 * LD / 2; i += NWAVES * 64) ((LAS unsigned*)St)[i] = 0u;
                    pg8::u32x4 tb[8], tx[2]; f32x2_t tdc = (f32x2_t){0.f, 0.f};
                    auto request = [&](int c0) { const size_t tok0 = (size_t)b * SEQ + c0; const int o_bc = tid & 31;
#pragma unroll
                        for (int j = 0; j < 8; ++j) { const int ll = (tid >> 5) + 16 * j; tb[j] = *(const pg8::u32x4*)(pmix + (tok0 + ll) * PMIX_LD + C_SX + ((o_bc < 16) ? (1024 + g * 128 + 8 * o_bc) : (1280 + g * 128 + 8 * (o_bc - 16)))); }
#pragma unroll
                        for (int j = 0; j < 2; ++j) { const int ll = (tid >> 3) + 64 * j; tx[j] = *(const pg8::u32x4*)(pmix + (tok0 + ll) * PMIX_LD + C_SX + h * 64 + 8 * (tid & 7)); }
                        if (tid < 128) tdc = *(const f32x2_t*)(dtcs + (size_t)(c0 + tid) * 2); };
                    request(0);
                    for (int c0 = 0; c0 < SEQ; c0 += 128) {
                        LBAR();
                        const int lane = lane_id(), tid = wave * 64 + lane, fr = lane & 15, fq = lane >> 4;
                        const size_t tok0 = (size_t)b * SEQ + c0;
                        { const int o_bc = tid & 31;
#pragma unroll
                          for (int j = 0; j < 8; ++j) { const int ll = (tid >> 5) + 16 * j; *(LAS pg8::u32x4*)((o_bc < 16 ? Bm : Cm) + ll * LD + 8 * (o_bc & 15)) = tb[j]; }
#pragma unroll
                          for (int j = 0; j < 2; ++j) { const int ll = (tid >> 3) + 64 * j; *(LAS pg8::u32x4*)(Xm + ll * XLD + 8 * (tid & 7)) = tx[j]; }
                          if (tid < 128) { Fd[tid] = tdc.x; Fc[tid] = tdc.y; } }
                        if (c0 + 128 < SEQ) request(c0 + 128);
                        unsigned long long zr[4];
#pragma unroll
                        for (int nt = 0; nt < 4; ++nt) zr[nt] = *(const unsigned long long*)(pmix + (tok0 + 16 * wave + fr) * PMIX_LD + C_SZ + h * 64 + 16 * nt + 4 * fq);
                        LBAR();
                        const float cs_last = Fc[127];
#pragma unroll
                        for (int jj = 0; jj < 2; ++jj) {
                            const int idx = tid + NWAVES * 64 * jj, ll = idx >> 3, ox = idx & 7; const float wgt = __expf(cs_last - Fc[ll]) * Fd[ll];
                            float x8[8]; pg8::unpack8(*(const LAS pg8::u32x4*)(Xm + ll * XLD + 8 * ox), x8);
                            pg8::u32x4 pk; pk.x = pk2(x8[0] * wgt, x8[1] * wgt); pk.y = pk2(x8[2] * wgt, x8[3] * wgt); pk.z = pk2(x8[4] * wgt, x8[5] * wgt); pk.w = pk2(x8[6] * wgt, x8[7] * wgt);
                            *(LAS pg8::u32x4*)(Xw + ll * XLD + 8 * ox) = pk;
                        }
                        const int sbp = (int)((0x31322010u >> (4 * wave)) & 3u), lq = (int)((0x8Bu >> wave) & 1u), d0 = 2 * sbp - 4 * lq;
                        const int m1 = 32 * sbp, n1 = 64 * lq, m4 = 16 * wave;
                        f32x4 acc1[2][4];
#pragma unroll
                        for (int mt = 0; mt < 2; ++mt)
#pragma unroll
                            for (int nt = 0; nt < 4; ++nt) acc1[mt][nt] = (f32x4){0.f, 0.f, 0.f, 0.f};
                        if (d0 <= 3) {
#pragma unroll
                        for (int k0 = 0; k0 < 128; k0 += 32) {
                            bf16x8 af[2], bfv[4];
#pragma unroll
                            for (int mt = 0; mt < 2; ++mt) af[mt] = *(const LAS bf16x8*)(Bm + (m1 + 16 * mt + fr) * LD + k0 + 8 * fq);
#pragma unroll
                            for (int nt = 0; nt < 4; ++nt) bfv[nt] = *(const LAS bf16x8*)(Cm + (n1 + 16 * nt + fr) * LD + k0 + 8 * fq);
#pragma unroll
                            for (int mt = 0; mt < 2; ++mt)
#pragma unroll
                                for (int nt = 0; nt < 4; ++nt) if (nt >= d0 + mt) acc1[mt][nt] = __builtin_amdgcn_mfma_f32_16x16x32_bf16(af[mt], bfv[nt], acc1[mt][nt], 0, 0, 0);
                        }
                        }
                        f32x4 acc2[4];
#pragma unroll
                        for (int nt = 0; nt < 4; ++nt) acc2[nt] = (f32x4){0.f, 0.f, 0.f, 0.f};
#pragma unroll
                        for (int k0 = 0; k0 < 128; k0 += 32) {
                            const bf16x8 af = *(const LAS bf16x8*)(Cm + (m4 + fr) * LD + k0 + 8 * fq);
#pragma unroll
                            for (int nt = 0; nt < 4; ++nt) { const bf16x8 bfv = *(const LAS bf16x8*)(St + (16 * nt + fr) * LD + k0 + 8 * fq); acc2[nt] = __builtin_amdgcn_mfma_f32_16x16x32_bf16(bfv, af, acc2[nt], 0, 0, 0); }
                        }
                        LBAR();
                        if (d0 <= 4) {   float csl[4]; f32x4 css[2], dts[2];
#pragma unroll
                            for (int nt = 0; nt < 4; ++nt) csl[nt] = Fc[n1 + 16 * nt + fr];
#pragma unroll
                            for (int mt = 0; mt < 2; ++mt) { css[mt] = *(const LAS f32x4*)(Fc + m1 + 16 * mt + 4 * fq); dts[mt] = *(const LAS f32x4*)(Fd + m1 + 16 * mt + 4 * fq); }
#pragma unroll
                            for (int mt = 0; mt < 2; ++mt)
#pragma unroll
                                for (int nt = 0; nt < 4; ++nt) { const int ll = n1 + 16 * nt + fr, s0 = m1 + 16 * mt + 4 * fq;
                                    if (nt > d0 + mt) {
                                        float v[4];
#pragma unroll
                                        for (int r = 0; r < 4; ++r) v[r] = acc1[mt][nt][r] * __expf(csl[nt] - css[mt][r]) * dts[mt][r];
                                        *(LAS unsigned long long*)(Cm + ll * LD + s0) = (unsigned long long)pk2(v[0], v[1]) | ((unsigned long long)pk2(v[2], v[3]) << 32);
                                    } else if (nt == d0 + mt) {
                                        float v[4];
#pragma unroll
                                        for (int r = 0; r < 4; ++r) v[r] = (s0 + r <= ll) ? acc1[mt][nt][r] * __expf(csl[nt] - css[mt][r]) * dts[mt][r] + ((s0 + r == ll) ? Dh : 0.f) : 0.f;
                                        *(LAS unsigned long long*)(Cm + ll * LD + s0) = (unsigned long long)pk2(v[0], v[1]) | ((unsigned long long)pk2(v[2], v[3]) << 32);
                                    } else if (nt + 1 == d0 + mt) {
                                        *(LAS unsigned long long*)(Cm + ll * LD + s0) = 0ull;
                                    } }
                        }
                        LBAR();
                        const int q4 = (lane & 15) >> 2, p4 = lane & 3;
                        f32x4 acc3[4];
#pragma unroll
                        for (int nt = 0; nt < 4; ++nt) acc3[nt] = (f32x4){0.f, 0.f, 0.f, 0.f};
                        for (int k0 = 0; k0 < m4 + 16; k0 += 32) {
                            const bf16x8 af = *(const LAS bf16x8*)(Cm + (m4 + fr) * LD + k0 + 8 * fq);
#pragma unroll
                            for (int nt = 0; nt < 4; ++nt) {
                                const s16x4 lo = __builtin_bit_cast(s16x4, __builtin_amdgcn_ds_read_tr16_b64_v4i16((LAS s16x4*)(Xm + (k0 + 8 * fq + q4) * XLD + 16 * nt + 4 * p4)));
                                const s16x4 hi = __builtin_bit_cast(s16x4, __builtin_amdgcn_ds_read_tr16_b64_v4i16((LAS s16x4*)(Xm + (k0 + 8 * fq + 4 + q4) * XLD + 16 * nt + 4 * p4)));
                                const bf16x8 bfv = (bf16x8){lo[0], lo[1], lo[2], lo[3], hi[0], hi[1], hi[2], hi[3]};
                                acc3[nt] = __builtin_amdgcn_mfma_f32_16x16x32_bf16(bfv, af, acc3[nt], 0, 0, 0);
                            }
                        }
                        { const float dec = __expf(cs_last);
#pragma unroll
                          for (int nt = 0; nt < 4; ++nt) accS[nt] = accS[nt] * dec; }
#pragma unroll
                        for (int k0 = 0; k0 < 128; k0 += 32) {
                            const s16x4 alo = __builtin_bit_cast(s16x4, __builtin_amdgcn_ds_read_tr16_b64_v4i16((LAS s16x4*)(Bm + (k0 + 8 * fq + q4) * LD + m4 + 4 * p4)));
                            const s16x4 ahi = __builtin_bit_cast(s16x4, __builtin_amdgcn_ds_read_tr16_b64_v4i16((LAS s16x4*)(Bm + (k0 + 8 * fq + 4 + q4) * LD + m4 + 4 * p4)));
                            const bf16x8 af = (bf16x8){alo[0], alo[1], alo[2], alo[3], ahi[0], ahi[1], ahi[2], ahi[3]};
#pragma unroll
                            for (int nt = 0; nt < 4; ++nt) {
                                const s16x4 lo = __builtin_bit_cast(s16x4, __builtin_amdgcn_ds_read_tr16_b64_v4i16((LAS s16x4*)(Xw + (k0 + 8 * fq + q4) * XLD + 16 * nt + 4 * p4)));
                                const s16x4 hi = __builtin_bit_cast(s16x4, __builtin_amdgcn_ds_read_tr16_b64_v4i16((LAS s16x4*)(Xw + (k0 + 8 * fq + 4 + q4) * XLD + 16 * nt + 4 * p4)));
                                const bf16x8 bfv = (bf16x8){lo[0], lo[1], lo[2], lo[3], hi[0], hi[1], hi[2], hi[3]};
                                accS[nt] = __builtin_amdgcn_mfma_f32_16x16x32_bf16(af, bfv, accS[nt], 0, 0, 0);
                            }
                        }
                        {   const int ll = m4 + fr; const size_t tok = tok0 + ll; const float ecs = __expf(Fc[ll]);
                            float s2 = 0.f;
#pragma unroll
                            for (int nt = 0; nt < 4; ++nt) {
                                const float z4[4] = {__uint_as_float((unsigned)zr[nt] << 16), __uint_as_float((unsigned)zr[nt] & 0xffff0000u), __uint_as_float((unsigned)(zr[nt] >> 32) << 16), __uint_as_float((unsigned)(zr[nt] >> 32) & 0xffff0000u)};
                                float v[4];
#pragma unroll
                                for (int r = 0; r < 4; ++r) { const float y = acc3[nt][r] + ecs * acc2[nt][r]; v[r] = y * siluf_(z4[r]); s2 += v[r] * v[r]; }
                                *(unsigned long long*)(om + tok * 512 + (h & 7) * 64 + 16 * nt + 4 * fq) = (unsigned long long)pk2(v[0], v[1]) | ((unsigned long long)pk2(v[2], v[3]) << 32);
                            }
                            s2 += shx(s2, 16, lane); s2 += shx(s2, 32, lane);
                            if (fq == 0) ssq[tok * 16 + h] = s2;
                        }
#pragma unroll
                        for (int nt = 0; nt < 4; ++nt) *(LAS unsigned long long*)(St + (16 * nt + fr) * LD + m4 + 4 * fq) = (unsigned long long)pk2(accS[nt][0], accS[nt][1]) | ((unsigned long long)pk2(accS[nt][2], accS[nt][3]) << 32);
                    }
                }
            }
        }
        if (IN(PH_MIX)) SEAM();
        if (IN(PH_MERGE)) { PHASE_IDS;
            unsigned char* ws = opaque_ptr(a.ws); unsigned char* wl = ws + WS_WSMALL + (size_t)l * WL_STRIDE;
            pg8::MergeOrder S; S.tm.init(NTOK, D, G, bx); S.tstep = (size_t)256 * 512 * 2; S.segA = 32 * MiB; S.segB = MiB;
            S.A = (const char*)(ws + WS_OR); S.Bt = (const char*)(wl + WL_BR);
            pg8::EpiMerge E{(const bf16*)(ws + WS_PGATE), (bf16*)(ws + WS_MERGED), (const float*)(ws + WS_SSQ)};
            pg8::gemm_phase<pg8::EpiMerge, pg8::MergeOrder, true, true>(lds + RING_OFF, 512, S, E, wave0);
        }
        if (IN(PH_MERGE)) SEAM();
        if (IN(PH_WOUT)) { PHASE_IDS;
            unsigned char* ws = opaque_ptr(a.ws); unsigned char* wl = ws + WS_WSMALL + (size_t)l * WL_STRIDE;
            pg8::DenseOrder S; S.init(ws + WS_MERGED, wl + WL_WOUT, NTOK, D, D, G, bx);
            pg8::EpiRes E{(const bf16*)a.out, (bf16*)(ws + WS_X1), ALPHA};
            pg8::gemm_phase<pg8::EpiRes, pg8::DenseOrder, true, true>(lds + RING_OFF, D, S, E, wave0);
        }
        if (IN(PH_WOUT)) SEAM();
        if (IN(PH_LN1)) { PHASE_IDS;
            unsigned char* ws = opaque_ptr(a.ws);
            LAS float* WT = (LAS float*)lds;
            { const float* rw = a.in[opaque_int(I_RW)];
              f32x4 rv[16];
#pragma unroll
              for (int i = 0; i < 16; ++i) rv[i] = *(const f32x4*)(rw + 4 * (tid + 512 * i));
#pragma unroll
              for (int i = 0; i < 16; ++i) { const int q = tid + 512 * i, d = q >> 3, e0 = (q & 7) * 4; LAS float* wp = WT + e0 * ROUTER_LD + d;
                  wp[0] = rv[i].x; wp[ROUTER_LD] = rv[i].y; wp[2 * ROUTER_LD] = rv[i].z; wp[3 * ROUTER_LD] = rv[i].w; } }
            __syncthreads();
            const bf16* X1 = (const bf16*)(ws + WS_X1); bf16* XBp = (bf16*)(ws + WS_XB);
            float* gatew = (float*)(ws + WS_GATEW); int* pos = (int*)(ws + WS_POS);
            unsigned* cnt = (unsigned*)(ws + WS_CTL) + CW_CNT + 1024 * l;
            const float* lg = a.in[opaque_int(I_L1G)] + (size_t)l * D; const float* lb = a.in[opaque_int(I_L1B)] + (size_t)l * D; const float* rbias = a.in[opaque_int(I_RB)];
            int me0 = 0, me1 = 0, kt = 0, tokb = gw; float mw0 = 1.f, mw1 = 1.f;
#define LN1_FLUSH() do { if (lane < kt) { const int tk_ = tokb + lane * NGW; const float inv_ = 1.f / (mw0 + mw1); \
                gatew[(size_t)tk_ * 2] = mw0 * inv_; gatew[(size_t)tk_ * 2 + 1] = mw1 * inv_; \
                const unsigned s0_ = atomicAdd(&cnt[me0 * CNT_STRIDE], 1u), s1_ = atomicAdd(&cnt[me1 * CNT_STRIDE], 1u); \
                pos[(size_t)tk_ * 2] = (int)(((unsigned)me0 << 16) | s0_); pos[(size_t)tk_ * 2 + 1] = (int)(((unsigned)me1 << 16) | s1_); } } while (0)
            for (int tokp = gw; tokp < NTOK; tokp += 2 * NGW, kt += 2) {
                if (kt == 64) { LN1_FLUSH(); kt = 0; tokb = tokp; }
                const bool two = tokp + NGW < NTOK;
                f32x4 v[2][4]; float sm[2];
#pragma unroll
                for (int u = 0; u < 2; ++u) { const int tok = (u && two) ? tokp + NGW : tokp; const bf16* row = X1 + (size_t)tok * D; sm[u] = 0.f;
#pragma unroll
                    for (int j = 0; j < 4; ++j) { const unsigned long long xw = *(const unsigned long long*)(row + 4 * lane + 256 * j);
                        v[u][j] = (f32x4){__uint_as_float((unsigned)xw << 16), __uint_as_float((unsigned)xw & 0xffff0000u), __uint_as_float((unsigned)(xw >> 32) << 16), __uint_as_float((unsigned)(xw >> 32) & 0xffff0000u)}; sm[u] += (v[u][j].x + v[u][j].y) + (v[u][j].z + v[u][j].w); } }
                float mean[2], s2[2], rstd[2];
#pragma unroll
                for (int u = 0; u < 2; ++u) mean[u] = wsum(sm[u], lane) * (1.f / D);
#pragma unroll
                for (int u = 0; u < 2; ++u) { s2[u] = 0.f;
#pragma unroll
                    for (int j = 0; j < 4; ++j) { v[u][j] = v[u][j] - mean[u]; s2[u] += (v[u][j].x * v[u][j].x + v[u][j].y * v[u][j].y) + (v[u][j].z * v[u][j].z + v[u][j].w * v[u][j].w); } }
#pragma unroll
                for (int u = 0; u < 2; ++u) rstd[u] = rsqrtf(wsum(s2[u], lane) * (1.f / D) + LN_EPS);
#pragma unroll
                for (int j = 0; j < 4; ++j) { const f32x4 g = *(const f32x4*)(lg + 4 * lane + 256 * j), b = *(const f32x4*)(lb + 4 * lane + 256 * j);
#pragma unroll
                    for (int u = 0; u < 2; ++u) v[u][j] = v[u][j] * rstd[u] * g + b; }
#pragma unroll
                for (int u = 0; u < 2; ++u) { if (u && !two) break; const int tok = tokp + u * NGW;
#pragma unroll
                    for (int j = 0; j < 4; ++j) {
                        *(unsigned long long*)(XBp + (size_t)tok * D + 4 * lane + 256 * j) = (unsigned long long)pk2(v[u][j].x, v[u][j].y) | ((unsigned long long)pk2(v[u][j].z, v[u][j].w) << 32); } }
                float p[2][32];
                typedef float f32x2r __attribute__((ext_vector_type(2)));
                f32x2r vv[4][4];
#pragma unroll
                for (int j = 0; j < 4; ++j) { vv[j][0] = (f32x2r){v[0][j].x, v[1][j].x}; vv[j][1] = (f32x2r){v[0][j].y, v[1][j].y}; vv[j][2] = (f32x2r){v[0][j].z, v[1][j].z}; vv[j][3] = (f32x2r){v[0][j].w, v[1][j].w}; }
#pragma unroll
                for (int e = 0; e < 32; ++e) { const LAS f32x4* w = (const LAS f32x4*)(WT + e * ROUTER_LD) + lane; f32x2r a01 = (f32x2r){0.f, 0.f}, b01 = (f32x2r){0.f, 0.f};
#pragma unroll
                    for (int j = 0; j < 4; ++j) { const f32x4 ww = w[64 * j];
                        a01 = vv[j][0] * (f32x2r){ww.x, ww.x} + a01; b01 = vv[j][1] * (f32x2r){ww.y, ww.y} + b01; a01 = vv[j][2] * (f32x2r){ww.z, ww.z} + a01; b01 = vv[j][3] * (f32x2r){ww.w, ww.w} + b01; }
                    a01 = a01 + b01; p[0][e] = a01.x; p[1][e] = a01.y; if ((e & 3) == 3) asm volatile("" ::: "memory"); }
#define RSTEP(N, B) _Pragma("unroll") for (int k = 0; k < (N) / 2; ++k) { _Pragma("unroll") for (int u = 0; u < 2; ++u) { const float send = (lane & (B)) ? p[u][k] : p[u][k + (N) / 2]; const float keep = (lane & (B)) ? p[u][k + (N) / 2] : p[u][k]; p[u][k] = keep + shx(send, (B), lane); } }
                RSTEP(32, 32) RSTEP(16, 16) RSTEP(8, 8) RSTEP(4, 4) RSTEP(2, 2)
#undef RSTEP
                const int e = lane & 31; const float rb_e = rbias[e]; const int gbase = lane & ~7;
#pragma unroll
                for (int u = 0; u < 2; ++u) {
                    p[u][0] += shx(p[u][0], 1, lane);
                    const float logit = shfl_f(p[u][0], 2 * (lane & 31));
                    const float aff = sigmoidf_(logit);
                    const float sel = aff + rb_e;
                    float t1 = -INFINITY, t2 = -INFINITY; int i1 = -1, i2 = -1;
#pragma unroll
                    for (int k = 0; k < 8; ++k) {
                        const float uu = shfl_f(sel, gbase + k); const int ui = (gbase + k) & 31;
                        if (uu > t1) { t2 = t1; i2 = i1; t1 = uu; i1 = ui; } else if (uu > t2) { t2 = uu; i2 = ui; }
                    }
                    const float gs = t1 + t2;
                    float best = -INFINITY; int bg = 0;
#pragma unroll
                    for (int g = 0; g < 4; ++g) { const float uu = shfl_f(gs, g * 8); if (uu > best) { best = uu; bg = g; } }
                    const int e0 = shfl_i(i1, bg * 8), e1 = shfl_i(i2, bg * 8);
                    const float w0 = shfl_f(aff, e0), w1 = shfl_f(aff, e1);
                    if (lane == kt + u && (u == 0 || two)) { me0 = e0; me1 = e1; mw0 = w0; mw1 = w1; }
                }
                if (!two) --kt;
            }
            LN1_FLUSH();
#undef LN1_FLUSH
        }
        if (IN(PH_LN1)) SEAM();
        if (IN(PH_DISPATCH)) { PHASE_IDS;
            unsigned char* ws = opaque_ptr(a.ws);
            LAS int* ltab = (LAS int*)(lds + LTAB_OFF);
            const unsigned* cnt = (const unsigned*)(ws + WS_CTL) + CW_CNT + 1024 * l;
            if (wave == 0) {
                const int c = (lane < 32) ? (int)__hip_atomic_load(cnt + (lane & 31) * CNT_STRIDE, __ATOMIC_RELAXED, __HIP_MEMORY_SCOPE_AGENT) : 0;
                const int nb = (c + 255) >> 8; int inc = nb;
#pragma unroll
                for (int o = 1; o < 64; o <<= 1) { const int u = shfl_i(inc, lane - o); if (lane >= o) inc += u; }
                const int exc = inc - nb;
                if (lane < 32) ltab[lane] = exc * 256;
                if (bx == 0) { int* tab = (int*)(ws + WS_TAB); if (lane == 31) tab[0] = inc; if (lane < 32) for (int b = 0; b < nb; ++b) tab[1 + exc + b] = lane; }
            }
            __syncthreads();
            int* pos = (int*)(ws + WS_POS); int* rowtok = (int*)(ws + WS_ROWTOK);
            for (int tok = gw * 64 + lane; tok < NTOK; tok += NGW * 64) {
                const int p0 = pos[(size_t)tok * 2], p1 = pos[(size_t)tok * 2 + 1];
                const int r0 = ltab[(p0 >> 16) & 31] + (p0 & 0xffff), r1 = ltab[(p1 >> 16) & 31] + (p1 & 0xffff);
                rowtok[r0] = tok; rowtok[r1] = tok; pos[(size_t)tok * 2] = r0; pos[(size_t)tok * 2 + 1] = r1;
            }
        }
        if (IN(PH_DISPATCH)) SEAM();
        if (IN(PH_GU) || IN(PH_DOWN)) { PHASE_IDS;
            unsigned char* ws = opaque_ptr(a.ws);
            LAS int* ltab = (LAS int*)(lds + LTAB_OFF);
            const int* tab = (const int*)(ws + WS_TAB);
            for (int i = tid; i < 1 + MPAD / 256; i += NWAVES * 64) ltab[i] = tab[i];
            __syncthreads();
            if (IN(PH_GU)) { PHASE_IDS;
                LAS int* ltok = (LAS int*)(lds + LTOK_OFF);
                pg8::GroupGatherOrder S; S.tab = ltab; S.ltok = ltok; S.A = (const char*)(ws + WS_XB); S.Bt = (const char*)(ws + WS_WEXP + WEXP_GU); S.tstepA = (size_t)256 * 1024 * 2; S.tstepB = (size_t)256 * 1024 * 2; S.estride = (size_t)1024 * 1024 * 2; S.nN = 4; S.G = G; S.c = bx;
                { const int* rowtok = (const int*)(ws + WS_ROWTOK);
                  const int nbk = __builtin_amdgcn_readfirstlane(ltab[0]);
#pragma unroll 1
                  for (int i = 0; i < LTOK_UNITS; ++i) { const int rb = ((G & 31) == 0) ? i * (G >> 2) + (bx & 7) * (G >> 5) + (bx >> 5) : (i * G + bx) >> 2;
                      if (rb >= nbk) break; if (tid < 256) ltok[256 * i + tid] = rowtok[256 * rb + tid]; }
                  __syncthreads(); }
                pg8::EpiSwiGLU E{(bf16*)(ws + WS_H)};
                pg8::gemm_phase<pg8::EpiSwiGLU, pg8::GroupGatherOrder, true, true>(lds + RING_OFF, D, S, E, wave0);
            }
        }
        if (IN(PH_GU)) SEAM();
        if (IN(PH_DOWN)) { PHASE_IDS;
            unsigned char* ws = opaque_ptr(a.ws);
            LAS int* ltab = (LAS int*)(lds + LTAB_OFF);
            pg8::GroupOrder S; S.tab = ltab; S.A = (const char*)(ws + WS_H); S.Bt = (const char*)(ws + WS_WEXP + WEXP_D); S.tstepA = (size_t)256 * 512 * 2; S.tstepB = (size_t)256 * 512 * 2; S.estride = (size_t)1024 * 512 * 2; S.nN = 4; S.G = G; S.c = bx;
            pg8::EpiBf16<1024> E{(bf16*)(ws + WS_YS)};
            pg8::gemm_phase<pg8::EpiBf16<1024>, pg8::GroupOrder, true, true>(lds + RING_OFF, DEXP, S, E, wave0);
        }
        if (IN(PH_DOWN)) SEAM();
        if (IN(PH_LN2)) { PHASE_IDS;
            unsigned char* ws = opaque_ptr(a.ws);
            const bf16* X1b = (const bf16*)(ws + WS_XB); const bf16* YS = (const bf16*)(ws + WS_YS); bf16* XBXp = (bf16*)a.out; const bool lastl = (l == DEPTH - 1);
            const float* gatew = (const float*)(ws + WS_GATEW); const int* pos = (const int*)(ws + WS_POS);
            const float* lg = a.in[opaque_int(I_L2G)] + (size_t)l * D; const float* lb = a.in[opaque_int(I_L2B)] + (size_t)l * D;
            for (int tokp = gw; tokp < NTOK; tokp += 4 * NGW) {
                f32x4 v[4][4]; float sm[4];
#pragma unroll
                for (int u = 0; u < 4; ++u) {
                    const int tok = (tokp + u * NGW < NTOK) ? tokp + u * NGW : tokp;
                    const float g0 = gatew[(size_t)tok * 2], g1 = gatew[(size_t)tok * 2 + 1];
                    const int r0 = pos[(size_t)tok * 2], r1 = pos[(size_t)tok * 2 + 1];
                    sm[u] = 0.f;
#pragma unroll
                    for (int j = 0; j < 4; ++j) {
                        const int c = 4 * lane + 256 * j;
                        const unsigned long long xw = *(const unsigned long long*)(X1b + (size_t)tok * D + c);
                        const f32x4 xv = (f32x4){__uint_as_float((unsigned)xw << 16), __uint_as_float((unsigned)xw & 0xffff0000u), __uint_as_float((unsigned)(xw >> 32) << 16), __uint_as_float((unsigned)(xw >> 32) & 0xffff0000u)};
                        const unsigned long long ya = *(const unsigned long long*)(YS + (size_t)r0 * D + c), yb = *(const unsigned long long*)(YS + (size_t)r1 * D + c);
                        const f32x4 y0 = (f32x4){__uint_as_float((unsigned)ya << 16), __uint_as_float((unsigned)ya & 0xffff0000u), __uint_as_float((unsigned)(ya >> 32) << 16), __uint_as_float((unsigned)(ya >> 32) & 0xffff0000u)};
                        const f32x4 y1 = (f32x4){__uint_as_float((unsigned)yb << 16), __uint_as_float((unsigned)yb & 0xffff0000u), __uint_as_float((unsigned)(yb >> 32) << 16), __uint_as_float((unsigned)(yb >> 32) & 0xffff0000u)};
                        v[u][j] = xv * ALPHA + (y0 * g0 + y1 * g1);
                        sm[u] += (v[u][j].x + v[u][j].y) + (v[u][j].z + v[u][j].w);
                    }
                }
                float mean[4], s2[4], rstd[4];
#pragma unroll
                for (int u = 0; u < 4; ++u) mean[u] = wsum(sm[u], lane) * (1.f / D);
#pragma unroll
                for (int u = 0; u < 4; ++u) { s2[u] = 0.f;
#pragma unroll
                    for (int j = 0; j < 4; ++j) { v[u][j] = v[u][j] - mean[u]; s2[u] += (v[u][j].x * v[u][j].x + v[u][j].y * v[u][j].y) + (v[u][j].z * v[u][j].z + v[u][j].w * v[u][j].w); } }
#pragma unroll
                for (int u = 0; u < 4; ++u) rstd[u] = rsqrtf(wsum(s2[u], lane) * (1.f / D) + LN_EPS);
#pragma unroll
                for (int u = 0; u < 4; ++u) {
                    const int tok = tokp + u * NGW; if (tok >= NTOK) break;
#pragma unroll
                    for (int j = 0; j < 4; ++j) {
                        const int c = 4 * lane + 256 * j;
                        const f32x4 g = *(const f32x4*)(lg + c), b = *(const f32x4*)(lb + c);
                        const f32x4 o = v[u][j] * rstd[u] * g + b;
                        if (lastl) *(f32x4*)(a.out + (size_t)tok * D + c) = o;
                        else *(unsigned long long*)(XBXp + (size_t)tok * D + c) = (unsigned long long)pk2(o.x, o.y) | ((unsigned long long)pk2(o.z, o.w) << 32);
                    }
                }
            }
        }
        if (IN(PH_LN2)) SEAM();
    }
#undef IN
}

#ifndef MK_ONE_LAUNCH
#define MK_ONE_LAUNCH 1
#endif
static void launch_mk(const Args& base, int grid, hipStream_t stream, int prologue, int l_lo, int l_hi, int ph_lo, int ph_hi) {
    Args a = base; a.prologue = prologue; a.l_lo = l_lo; a.l_hi = l_hi; a.ph_lo = ph_lo; a.ph_hi = ph_hi; a.pad = 0;
    hipLaunchKernelGGL(mk_fwd, dim3(grid), dim3(NWAVES * 64), LDS_BYTES, stream, a);
}
extern "C" void kernel_launch(void* const* d_in, const int* in_sizes, int n_in, void* d_out, int out_size, void* d_ws, size_t ws_size, hipStream_t stream) {
    static int grid = 0;
    if (grid == 0) {
        if (n_in != N_IN || ws_size < WS_END || out_size != NTOK * D) { fprintf(stderr, "kernel_launch: unexpected n_in %d, out_size %d or ws_size %zu\n", n_in, out_size, ws_size); grid = -1; return; }
        int dev = 0, cus = 0;
        if (hipGetDevice(&dev) != hipSuccess || hipDeviceGetAttribute(&cus, hipDeviceAttributeMultiprocessorCount, dev) != hipSuccess) { grid = -1; return; }
        if (hipFuncSetAttribute((const void*)mk_fwd, hipFuncAttributeMaxDynamicSharedMemorySize, LDS_BYTES) != hipSuccess) { fprintf(stderr, "kernel_launch: hipFuncSetAttribute failed\n"); grid = -1; return; }
        int per_cu = 0;
        if (hipOccupancyMaxActiveBlocksPerMultiprocessor(&per_cu, (const void*)mk_fwd, NWAVES * 64, LDS_BYTES) != hipSuccess || per_cu < 1) fprintf(stderr, "kernel_launch: occupancy query reports %d blocks per CU\n", per_cu);
        (void)hipGetLastError();
        grid = cus;
    }
    if (grid < 0) return;
    (void)hipMemsetAsync((char*)d_ws + WS_CTL, 0, CTL_ZERO_BYTES, stream);
    Args base{};
    for (int i = 0; i < N_IN; ++i) base.in[i] = (const float*)d_in[i];
    base.out = (float*)d_out; base.ws = (unsigned char*)d_ws;
#if MK_ONE_LAUNCH
    launch_mk(base, grid, stream, 1, 0, DEPTH, 0, PH_COUNT);
#else
    launch_mk(base, grid, stream, 1, 0, 0, 0, 0);
    for (int l = 0; l < DEPTH; ++l)
        for (int ph = 1; ph < PH_COUNT; ++ph) launch_mk(base, grid, stream, 0, l, l + 1, ph, ph + 1);
#endif
}
```

```cpp
#include <hip/hip_runtime.h>
#include <cstdio>
#include <cstdint>

constexpr int D = 1024, BATCH = 16, SEQ = 2048, DEPTH = 4, NTOK = BATCH * SEQ;
constexpr int FOX_HEADS = 8;
constexpr int SSM_DIM = 1024, SSM_HEADS = 16, SSM_CONV_DIM = 1536;
constexpr int RWKV_COLS = 1792;
constexpr int IN_COLS = 8984;
constexpr int NEXP = 32, DEXP = 512;
constexpr float ALPHA = 1.681792830507429f;
constexpr float LN_EPS = 1e-5f, NORM_EPS = 1e-5f, RWKV_GN_EPS = 64e-5f;
constexpr int PMIX_LD = 5888, PGATE_LD = 3072, NPROJ = 9216;
constexpr int C_RW = 0, C_FQ = 1792, C_FK = 2304, C_FV = 2816, C_SZ = 3328, C_SX = 4352;
enum { I_X = 0, I_WIN, I_MU, I_W0, I_WUP, I_A0, I_AUP, I_GUP, I_KK, I_KA, I_RK, I_GNG, I_GNB, I_FB, I_CW, I_CB, I_DTB, I_ALOG, I_DSK, I_NG, I_GB, I_BRR, I_BRF, I_BRM, I_WO,
       I_L1G, I_L1B, I_RW, I_RB, I_EG, I_EU, I_ED, I_L2G, I_L2B, N_IN };

typedef float f32x4 __attribute__((ext_vector_type(4)));
typedef float f32x16 __attribute__((ext_vector_type(16)));
typedef unsigned short bf16;

__device__ __forceinline__ float sigmoidf_(float x) { return __builtin_amdgcn_rcpf(1.f + __expf(-x)); }
__device__ __forceinline__ float softplusf_(float x) { const float e = __expf(-fabsf(x)); return fmaxf(x, 0.f) + __logf(1.f + e); }
__device__ __forceinline__ float siluf_(float x) { return x * __builtin_amdgcn_rcpf(1.f + __expf(-x)); }
__device__ __forceinline__ float tanhf_(float x) { const float e = __expf(-2.f * fabsf(x)); const float t = (1.f - e) * __builtin_amdgcn_rcpf(1.f + e); return x < 0.f ? -t : t; }
__device__ __forceinline__ float wave_sum(float v) {
#pragma unroll
    for (int o = 1; o < 64; o <<= 1) v += __shfl_xor(v, o);
    return v;
}
__device__ __forceinline__ float bf2f(bf16 b) { return __uint_as_float((unsigned)b << 16); }

namespace pg8 {
#define PG8_LAS __attribute__((address_space(3)))
typedef unsigned short bf16_t;
typedef short bf16x8 __attribute__((ext_vector_type(8)));
typedef float f32x4 __attribute__((ext_vector_type(4)));
typedef unsigned u32x4 __attribute__((ext_vector_type(4)));
constexpr int BM = 256, BK = 64, HALF = 128, HTB = HALF * BK * 2  , STAGE_BYTES = 8 * HTB, NXCD = 8, WGM = 8;

__host__ __device__ __forceinline__ int lds_byte(int r, int c) { const int st = (r >> 4) * 2 + (c >> 5), rr = r & 15, cc = c & 31, ob = rr * 64 + cc * 2; return st * 1024 + (ob ^ (((ob >> 9) & 1) << 5)); }
__host__ __device__ __forceinline__ void stage_rc(int b, int& R, int& C) { const int st = b / 1024, sb = b % 1024, swz = sb ^ (((sb >> 9) & 1) << 5); R = (st >> 1) * 16 + swz / 64; C = (st & 1) * 32 + (swz % 64) / 2; }
__host__ __device__ __forceinline__ int perm32(int rho) { const int n = rho >> 4, i = rho & 15; return 8 * (i >> 2) + 4 * n + (i & 3); }

#define PG8_GAS __attribute__((address_space(1)))
struct Unit { int pm, pn, pb, seg, last; };

typedef float f32x2_t __attribute__((ext_vector_type(2))); typedef __bf16 bf16x2_t __attribute__((ext_vector_type(2)));
__device__ __forceinline__ unsigned cvt_pk_bf16(float lo, float hi) { f32x2_t v = {lo, hi}; bf16x2_t b = __builtin_convertvector(v, bf16x2_t); return __builtin_bit_cast(unsigned, b); }

struct TileMap {
    int nM, nN, nwg, G, c;
    __device__ void init(int M, int N, int G_, int c_) { nM = M / BM; nN = N / BM; nwg = nM * nN; G = G_; c = c_; }
    __device__ bool tile(int i, int& pm, int& pn) const {
        const long L = (long)i * G + c; if (L >= nwg) return false;
        int wgid = (int)L; { const int q = nwg / NXCD, r = nwg % NXCD, xcd = wgid % NXCD, off = wgid / NXCD; wgid = (xcd < r ? xcd * (q + 1) : r * (q + 1) + (xcd - r) * q) + off; }
        const int nig = WGM * nN, gid = wgid / nig, fm = gid * WGM, gsz = (nM - fm) < WGM ? (nM - fm) : WGM;
        pm = fm + ((wgid % nig) % gsz); pn = (wgid % nig) / gsz; return true;
    }
};
struct DenseOrder {
    static constexpr bool GATHER = false;
    TileMap tm; const char* A; const char* Bt; size_t tstep;
    __device__ void init(const void* A_, const void* Bt_, int M, int N, int K, int G, int c) { tm.init(M, N, G, c); A = (const char*)A_; Bt = (const char*)Bt_; tstep = (size_t)BM * K * 2; }
    __device__ bool next(int i, Unit& u) const { if (!tm.tile(i, u.pm, u.pn)) return false; u.pb = 0; u.seg = 0; u.last = 1; return true; }
    __device__ __forceinline__ void addr(const Unit& u, const char*& a, const char*& b) const { a = A + (size_t)u.pm * tstep; b = Bt + (size_t)u.pn * tstep; }
    __device__ __forceinline__ void a_ready(const Unit&) const {}
    __device__ __forceinline__ void done(const Unit&) const {}
};
struct MergeOrder {
    static constexpr bool GATHER = false;
    TileMap tm; const char *A, *Bt; size_t tstep, segA, segB;
    __device__ bool next(int i, Unit& u) const { if (!tm.tile(i >> 2, u.pm, u.pn)) return false; const int sg = i & 3; u.pb = 0; u.seg = sg; u.last = (sg == 3); return true; }
    __device__ __forceinline__ void addr(const Unit& u, const char*& a, const char*& b) const { a = A + (size_t)u.seg * segA + (size_t)u.pm * tstep; b = Bt + (size_t)u.seg * segB + (size_t)u.pn * tstep; }
    __device__ __forceinline__ void a_ready(const Unit&) const {}
    __device__ __forceinline__ void done(const Unit&) const {}
};

__device__ __forceinline__ void unpack8(const u32x4 w, float (&f)[8]) {
    f[0] = __uint_as_float(w.x << 16); f[1] = __uint_as_float(w.x & 0xffff0000u); f[2] = __uint_as_float(w.y << 16); f[3] = __uint_as_float(w.y & 0xffff0000u);
    f[4] = __uint_as_float(w.z << 16); f[5] = __uint_as_float(w.z & 0xffff0000u); f[6] = __uint_as_float(w.w << 16); f[7] = __uint_as_float(w.w & 0xffff0000u);
}
__device__ __forceinline__ u32x4 pack8(const f32x4 v0, const f32x4 v1) { u32x4 w; w.x = cvt_pk_bf16(v0[0], v0[1]); w.y = cvt_pk_bf16(v0[2], v0[3]); w.z = cvt_pk_bf16(v1[0], v1[1]); w.w = cvt_pk_bf16(v1[2], v1[3]); return w; }

template <int LDC> struct EpiBf16 {
    static constexpr bool PERM = true; static constexpr int ldc = LDC;
    bf16_t* O;
    __device__ __forceinline__ void mid(f32x4 (&)[2][2][4][2], const Unit&, int, int, int, int) const {}
    __device__ __forceinline__ void operator()(const f32x4 (&acc)[2][2][4][2], const Unit& u, int wr, int wc, int fr, int fq) const {
        const int row0 = u.pm * BM + wr * 64 + fr, col0 = u.pn * BM + wc * 32 + 8 * fq;
#pragma unroll
        for (int ai = 0; ai < 2; ++ai)
#pragma unroll
            for (int m = 0; m < 4; ++m) { bf16_t* rowp = O + (size_t)(row0 + ai * HALF + m * 16) * ldc + col0;
#pragma unroll
                for (int bj = 0; bj < 2; ++bj) *(PG8_GAS u32x4*)(rowp + bj * HALF) = pack8(acc[ai][bj][m][0], acc[ai][bj][m][1]); }
    }
};
struct EpiProj {
    static constexpr bool PERM = true;
    bf16_t* pmix; bf16_t* pgate; float* misc; const float* gbias;
    __device__ __forceinline__ void mid(f32x4 (&)[2][2][4][2], const Unit&, int, int, int, int) const {}
    __device__ __forceinline__ void operator()(const f32x4 (&acc)[2][2][4][2], const Unit& u, int wr, int wc, int fr, int fq) const {
        const int row0 = u.pm * BM + wr * 64 + fr, cl = wc * 32 + 8 * fq;
        if (u.pn < 23) {
            const float sc = (u.pn == 7 || u.pn == 8) ? 0.18033688011112042f : 1.f;
#pragma unroll
            for (int ai = 0; ai < 2; ++ai)
#pragma unroll
                for (int m = 0; m < 4; ++m) { bf16_t* rowp = pmix + (size_t)(row0 + ai * HALF + m * 16) * PMIX_LD + u.pn * BM + cl;
#pragma unroll
                    for (int bj = 0; bj < 2; ++bj) *(PG8_GAS u32x4*)(rowp + bj * HALF) = pack8(acc[ai][bj][m][0] * sc, acc[ai][bj][m][1] * sc); }
        } else if (u.pn == 23) {
            if (wc == 0 && fq < 3) {
#pragma unroll
                for (int ai = 0; ai < 2; ++ai)
#pragma unroll
                    for (int m = 0; m < 4; ++m) { float* rowp = misc + (size_t)(row0 + ai * HALF + m * 16) * 32 + 8 * fq;
                        *(PG8_GAS f32x4*)rowp = acc[ai][0][m][0]; *(PG8_GAS f32x4*)(rowp + 4) = acc[ai][0][m][1]; }
            }
        } else {
            const int gc = (u.pn - 24) * BM + cl;
            f32x4 bv[2][2];
#pragma unroll
            for (int bj = 0; bj < 2; ++bj)
#pragma unroll
                for (int n = 0; n < 2; ++n) bv[bj][n] = *(const PG8_GAS f32x4*)(gbias + gc + bj * HALF + 4 * n);
#pragma unroll
            for (int ai = 0; ai < 2; ++ai)
#pragma unroll
                for (int m = 0; m < 4; ++m) { bf16_t* rowp = pgate + (size_t)(row0 + ai * HALF + m * 16) * PGATE_LD + gc;
#pragma unroll
                    for (int bj = 0; bj < 2; ++bj) { f32x4 v0 = acc[ai][bj][m][0] + bv[bj][0], v1 = acc[ai][bj][m][1] + bv[bj][1];
#pragma unroll
                        for (int i = 0; i < 4; ++i) { v0[i] = __builtin_amdgcn_fmed3f(1.f + __expf(-v0[i]), 1.f, 1e30f); v1[i] = __builtin_amdgcn_fmed3f(1.f + __expf(-v1[i]), 1.f, 1e30f); }
                        *(PG8_GAS u32x4*)(rowp + bj * HALF) = pack8(v0, v1); } }
        }
    }
};
struct EpiMerge {
    static constexpr bool PERM = true;
    const bf16_t* pgate; bf16_t* O; const float* ssq;
    __device__ __forceinline__ float rs(size_t row, int g) const { const PG8_GAS f32x4* q = (const PG8_GAS f32x4*)(ssq + row * 16 + 8 * g); const f32x4 a = q[0], b = q[1];
        return __builtin_amdgcn_rsqf((((a[0] + a[1]) + (a[2] + a[3])) + ((b[0] + b[1]) + (b[2] + b[3]))) * (1.f / 512.f) + 1e-5f); }
    __device__ __forceinline__ void ld_ssq(size_t row, int g, f32x4& a, f32x4& b) const { const PG8_GAS f32x4* q = (const PG8_GAS f32x4*)(ssq + row * 16 + 8 * g); a = q[0]; b = q[1]; }
    static __device__ __forceinline__ float rs_of(const f32x4 a, const f32x4 b) { return __builtin_amdgcn_rsqf((((a[0] + a[1]) + (a[2] + a[3])) + ((b[0] + b[1]) + (b[2] + b[3]))) * (1.f / 512.f) + 1e-5f); }
    __device__ __forceinline__ void mid(f32x4 (&acc)[2][2][4][2], const Unit& u, int wr, int wc, int fr, int fq) const {
        const int row0 = u.pm * BM + wr * 64 + fr, col0 = u.pn * BM + wc * 32 + 8 * fq;
#pragma unroll
        for (int ai = 0; ai < 2; ++ai)
#pragma unroll
            for (int m0 = 0; m0 < 4; m0 += 2) {
                if (u.seg == 2) {
#pragma unroll
                    for (int mm = 0; mm < 2; ++mm) { const int m = m0 + mm; const size_t r = (size_t)(row0 + ai * HALF + m * 16); const float f = rs(r, 0) * __builtin_amdgcn_rcpf(rs(r, 1));
#pragma unroll
                        for (int bj = 0; bj < 2; ++bj) { acc[ai][bj][m][0] = acc[ai][bj][m][0] * f; acc[ai][bj][m][1] = acc[ai][bj][m][1] * f; } }
                } else {
                    u32x4 GA[2][2], GB[2][2]; float f[2];
#pragma unroll
                    for (int mm = 0; mm < 2; ++mm) { const size_t r = (size_t)(row0 + ai * HALF + (m0 + mm) * 16); const bf16_t* gp = pgate + r * PGATE_LD + u.seg * 1024 + col0;
#pragma unroll
                        for (int bj = 0; bj < 2; ++bj) { GA[mm][bj] = *(const PG8_GAS u32x4*)(gp + bj * HALF); GB[mm][bj] = *(const PG8_GAS u32x4*)(gp + 1024 + bj * HALF); }
                        f[mm] = (u.seg == 1) ? __builtin_amdgcn_rcpf(rs(r, 0)) : 1.f; }
#pragma unroll
                    for (int mm = 0; mm < 2; ++mm) { const int m = m0 + mm;
#pragma unroll
                        for (int bj = 0; bj < 2; ++bj) { float ga[8], gb[8]; unpack8(GA[mm][bj], ga); unpack8(GB[mm][bj], gb);
#pragma unroll
                            for (int i = 0; i < 4; ++i) { acc[ai][bj][m][0][i] *= f[mm] * gb[i] * __builtin_amdgcn_rcpf(ga[i]); acc[ai][bj][m][1][i] *= f[mm] * gb[4 + i] * __builtin_amdgcn_rcpf(ga[4 + i]); } } }
                }
#pragma unroll
                for (int mm = 0; mm < 2; ++mm) asm volatile("" : "+v"(acc[ai][0][m0 + mm][0]), "+v"(acc[ai][0][m0 + mm][1]), "+v"(acc[ai][1][m0 + mm][0]), "+v"(acc[ai][1][m0 + mm][1]) :: "memory");
            }
    }
    __device__ __forceinline__ void operator()(const f32x4 (&acc)[2][2][4][2], const Unit& u, int wr, int wc, int fr, int fq) const {
        const int row0 = u.pm * BM + wr * 64 + fr, col0 = u.pn * BM + wc * 32 + 8 * fq;
#pragma unroll
        for (int ai = 0; ai < 2; ++ai)
#pragma unroll
            for (int m0 = 0; m0 < 4; m0 += 2) {
                u32x4 G2[2][2]; f32x4 sa[2], sb[2];
#pragma unroll
                for (int mm = 0; mm < 2; ++mm) { const size_t r = (size_t)(row0 + ai * HALF + (m0 + mm) * 16); ld_ssq(r, 1, sa[mm], sb[mm]);
#pragma unroll
                    for (int bj = 0; bj < 2; ++bj) G2[mm][bj] = *(const PG8_GAS u32x4*)(pgate + r * PGATE_LD + 2048 + col0 + bj * HALF); }
#pragma unroll
                for (int mm = 0; mm < 2; ++mm) { const int m = m0 + mm; const size_t r = (size_t)(row0 + ai * HALF + m * 16); const float f = rs_of(sa[mm], sb[mm]);
#pragma unroll
                    for (int bj = 0; bj < 2; ++bj) { float g[8]; unpack8(G2[mm][bj], g);
                        f32x4 v0 = acc[ai][bj][m][0], v1 = acc[ai][bj][m][1];
#pragma unroll
                        for (int i = 0; i < 4; ++i) { v0[i] *= f * __builtin_amdgcn_rcpf(g[i]); v1[i] *= f * __builtin_amdgcn_rcpf(g[4 + i]); }
                        *(PG8_GAS u32x4*)(O + r * 1024 + col0 + bj * HALF) = pack8(v0, v1); } }
                asm volatile("" ::: "memory");
            }
    }
};
struct EpiRes {
    static constexpr bool PERM = false;
    const bf16_t* base; bf16_t* out; float alpha;
    __device__ __forceinline__ void mid(f32x4 (&)[2][2][4][2], const Unit&, int, int, int, int) const {}
    __device__ __forceinline__ void operator()(const f32x4 (&acc)[2][2][4][2], const Unit& u, int wr, int wc, int fr, int fq) const {
        const int row0 = u.pm * BM + wr * 64 + fr, col0 = u.pn * BM + wc * 32 + 4 * fq;
#pragma unroll
        for (int ai = 0; ai < 2; ++ai)
#pragma unroll
            for (int m = 0; m < 4; ++m) { const size_t off = (size_t)(row0 + ai * HALF + m * 16) * 1024 + col0;
#pragma unroll
                for (int bj = 0; bj < 2; ++bj)
#pragma unroll
                    for (int n = 0; n < 2; ++n) { const unsigned long long bw = *(const PG8_GAS unsigned long long*)(base + off + bj * HALF + n * 16);
                        const f32x4 b = (f32x4){__uint_as_float((unsigned)bw << 16), __uint_as_float((unsigned)bw & 0xffff0000u), __uint_as_float((unsigned)(bw >> 32) << 16), __uint_as_float((unsigned)(bw >> 32) & 0xffff0000u)};
                        const f32x4 o = b * alpha + acc[ai][bj][m][n];
                        *(PG8_GAS unsigned long long*)(out + off + bj * HALF + n * 16) = (unsigned long long)cvt_pk_bf16(o[0], o[1]) | ((unsigned long long)cvt_pk_bf16(o[2], o[3]) << 32); } }
    }
};

template <bool GATHER_> struct GroupOrderT {
    static constexpr bool GATHER = GATHER_;
    const PG8_LAS int* ltok;
    __device__ __forceinline__ unsigned arow(int ui, int r) const { return (unsigned)ltok[256 * ui + r]; }
    const PG8_LAS int* tab; const char* A; const char* Bt; size_t tstepA, tstepB, estride; int nN, G, c;
    __device__ bool next(int i, Unit& u) const {
        const int nb = __builtin_amdgcn_readfirstlane(tab[0]);
        int rb, pn;
        if ((G & 31) == 0) { const int x = c & 7, j = c >> 3; rb = i * (G >> 2) + x * (G >> 5) + (j >> 2); pn = j & 3; }
        else { const int L = i * G + c; rb = L >> 2; pn = L & 3; }
        if (rb >= nb) return false;
        u.pm = rb; u.pn = pn; u.pb = __builtin_amdgcn_readfirstlane(tab[1 + rb]); u.seg = 0; u.last = 1; return true;
    }
    __device__ __forceinline__ void addr(const Unit& u, const char*& a, const char*& b) const { a = GATHER_ ? A : A + (size_t)u.pm * tstepA; b = Bt + (size_t)u.pb * estride + (size_t)u.pn * tstepB; }
    __device__ __forceinline__ void a_ready(const Unit&) const {}
    __device__ __forceinline__ void done(const Unit&) const {}
};
using GroupOrder = GroupOrderT<false>; using GroupGatherOrder = GroupOrderT<true>;
struct EpiSwiGLU {
    static constexpr bool PERM = true;
    bf16_t* H;
    __device__ __forceinline__ void mid(f32x4 (&)[2][2][4][2], const Unit&, int, int, int, int) const {}
    __device__ __forceinline__ void operator()(const f32x4 (&acc)[2][2][4][2], const Unit& u, int wr, int wc, int fr, int fq) const {
        const int row0 = u.pm * BM + wr * 64 + fr, col0 = u.pn * HALF + wc * 32 + 8 * fq;
#pragma unroll
        for (int ai = 0; ai < 2; ++ai)
#pragma unroll
            for (int m = 0; m < 4; ++m) { f32x4 h0, h1;
#pragma unroll
                for (int i = 0; i < 4; ++i) { const float g0 = acc[ai][0][m][0][i], g1 = acc[ai][0][m][1][i];
                    h0[i] = g0 * __builtin_amdgcn_rcpf(1.f + __expf(-g0)) * acc[ai][1][m][0][i]; h1[i] = g1 * __builtin_amdgcn_rcpf(1.f + __expf(-g1)) * acc[ai][1][m][1][i]; }
                *(PG8_GAS u32x4*)(H + (size_t)(row0 + ai * HALF + m * 16) * 512 + col0) = pack8(h0, h1); }
    }
};

template <class Epi, class Sched, bool ALIGN_EPI = false, bool SP2 = false>
__device__ __forceinline__ void gemm_phase(PG8_LAS unsigned char* lds, const int K, const Sched& S, const Epi& E, const int wave0) {
    int sw_ = wave0; asm volatile("" : "+s"(sw_)); int ln_; asm volatile("v_mbcnt_lo_u32_b32 %0, -1, 0\n\tv_mbcnt_hi_u32_b32 %0, -1, %0" : "=v"(ln_));
    const int tid_ = sw_ * 64 + ln_;
    const int tid = tid_, wid = __builtin_amdgcn_readfirstlane(tid >> 6), lane = tid & 63, wr = wid >> 2, wc = wid & 3, fr = lane & 15, fq = lane >> 4;
    const int nt = K / BK;
    unsigned voffA[2], voffB[2];
#pragma unroll
    for (int i = 0; i < 2; ++i) { int R, C; stage_rc(tid * 16 + i * 8192, R, C); const int Rb = Epi::PERM ? ((R & ~31) + perm32(R & 31)) : R;
        voffA[i] = (unsigned)(R * K + C) * 2u; voffB[i] = (unsigned)(Rb * K + C) * 2u; }
    unsigned gc[2][2] = {{0u, 0u}, {0u, 0u}};
    auto gof = [&](int ui_, unsigned (&g)[2][2]) {
        if constexpr (Sched::GATHER) {
#pragma unroll
        for (int i = 0; i < 2; ++i) { int R, C; stage_rc(tid * 16 + i * 8192, R, C);
#pragma unroll
            for (int h = 0; h < 2; ++h) g[h][i] = S.arow(ui_, h * HALF + R) * (unsigned)(K * 2) + (unsigned)(C * 2); } } };
    const size_t kstep = (size_t)(BK * 2);
    const size_t hstep = (size_t)HALF * K * 2;
    const unsigned ldsw = (unsigned)wid * 1024u;
    const int aoff = lds_byte(wr * 64 + fr, fq * 8), boff = lds_byte(wc * 32 + fr, fq * 8);
#define PG8_SA(b, h) (((b) * 2 + (h)) * HTB)
#define PG8_SB(b, h) ((4 + (b) * 2 + (h)) * HTB)
#define PG8_STAGE(bufoff, gbase, voff) do { _Pragma("unroll") for (int _i = 0; _i < 2; ++_i) \
        __builtin_amdgcn_global_load_lds((const unsigned*)((const char*)(gbase) + (voff)[_i]), (PG8_LAS unsigned*)(lds + (bufoff) + ldsw + _i * 8192), 16, 0, 0); } while (0)
#define PG8_LDA(dst, b, h) do { _Pragma("unroll") for (int m = 0; m < 4; ++m) _Pragma("unroll") for (int k = 0; k < 2; ++k) dst[m][k] = *(const PG8_LAS bf16x8*)(lds + PG8_SA(b, h) + aoff + m * 2048 + k * 1024); } while (0)
#define PG8_LDB(dst, b, h) do { _Pragma("unroll") for (int n = 0; n < 2; ++n) _Pragma("unroll") for (int k = 0; k < 2; ++k) dst[n][k] = *(const PG8_LAS bf16x8*)(lds + PG8_SB(b, h) + boff + n * 2048 + k * 1024); } while (0)
#define PG8_MMA(ai, bj, At, Bt) do { __builtin_amdgcn_s_setprio(1); _Pragma("unroll") for (int m = 0; m < 4; ++m) _Pragma("unroll") for (int n = 0; n < 2; ++n) _Pragma("unroll") for (int k = 0; k < 2; ++k) \
        acc[ai][bj][m][n] = __builtin_amdgcn_mfma_f32_16x16x32_bf16(Bt[n][k], At[m][k], acc[ai][bj][m][n], 0, 0, 0); __builtin_amdgcn_s_setprio(0); } while (0)
#define PG8_WAIT_V(n) asm volatile("s_waitcnt vmcnt(" #n ")" ::: "memory")
#define PG8_WAIT_L(n) asm volatile("s_waitcnt lgkmcnt(" #n ")" ::: "memory")
#define PG8_BAR __builtin_amdgcn_s_barrier()
#define PG8_SCHED __builtin_amdgcn_sched_barrier(0)
    Unit cur, nxt; int ui = 0;
    if (!S.next(0, cur)) return;
    f32x4 acc[2][2][4][2];
#pragma unroll
    for (int a = 0; a < 2; ++a)
#pragma unroll
        for (int b = 0; b < 2; ++b)
#pragma unroll
            for (int m = 0; m < 4; ++m)
#pragma unroll
                for (int n = 0; n < 2; ++n) acc[a][b][m][n] = (f32x4){0.f, 0.f, 0.f, 0.f};
    bf16x8 At[4][2], B0[2][2], B1[2][2];
    const char* cA; const char* cB; S.addr(cur, cA, cB);
    S.a_ready(cur);
    if constexpr (Sched::GATHER) {
        static_assert(SP2, "GATHER schedulers use the SP2 loop");
        gof(0, gc);
        PG8_STAGE(PG8_SB(0, 0), cB, voffB); PG8_STAGE(PG8_SB(0, 1), cB + hstep, voffB); PG8_STAGE(PG8_SA(0, 0), cA, gc[0]); PG8_STAGE(PG8_SA(0, 1), cA, gc[1]);
        if (wr == 1) PG8_BAR;
        PG8_WAIT_V(2); PG8_BAR;
        PG8_STAGE(PG8_SB(1, 0), cB + kstep, voffB); PG8_STAGE(PG8_SA(1, 0), cA + kstep, gc[0]); PG8_STAGE(PG8_SB(1, 1), cB + hstep + kstep, voffB);
        PG8_WAIT_V(6); PG8_BAR;
    } else if constexpr (SP2) {
        PG8_STAGE(PG8_SB(0, 0), cB, voffB); PG8_STAGE(PG8_SB(0, 1), cB + hstep, voffB); PG8_STAGE(PG8_SA(0, 0), cA, voffA); PG8_STAGE(PG8_SA(0, 1), cA + hstep, voffA);
        if (wr == 1) PG8_BAR;
        PG8_WAIT_V(2); PG8_BAR;
        PG8_STAGE(PG8_SB(1, 0), cB + kstep, voffB); PG8_STAGE(PG8_SA(1, 0), cA + kstep, voffA); PG8_STAGE(PG8_SB(1, 1), cB + hstep + kstep, voffB);
        PG8_WAIT_V(6); PG8_BAR;
    } else {
        PG8_STAGE(PG8_SB(0, 0), cB, voffB); PG8_STAGE(PG8_SA(0, 0), cA, voffA); PG8_STAGE(PG8_SB(0, 1), cB + hstep, voffB); PG8_STAGE(PG8_SA(0, 1), cA + hstep, voffA);
        if (wr == 1) PG8_BAR;
        PG8_WAIT_V(4); PG8_BAR;
        PG8_STAGE(PG8_SB(1, 0), cB + kstep, voffB); PG8_STAGE(PG8_SA(1, 0), cA + kstep, voffA); PG8_STAGE(PG8_SB(1, 1), cB + hstep + kstep, voffB);
        PG8_WAIT_V(6); PG8_BAR;
    }
    for (;;) {
        const bool has_next = S.next(ui + 1, nxt);
        const char* nA = cA; const char* nB = cB; if (has_next) S.addr(nxt, nA, nB);
        for (int t = 0; t < nt; t += 2) {
            const bool last = (t == nt - 2);
            const char* a1 = cA + (size_t)(t + 1) * kstep;
            const char* a2 = last ? nA : cA + (size_t)(t + 2) * kstep; const char* b2 = last ? nB : cB + (size_t)(t + 2) * kstep;
            const char* a3 = a2 + kstep; const char* b3 = b2 + kstep;
            if (last && has_next) S.a_ready(nxt);
            if constexpr (Sched::GATHER) {
            unsigned o2[2][2];
            o2[0][0] = gc[0][0]; o2[0][1] = gc[0][1]; o2[1][0] = gc[1][0]; o2[1][1] = gc[1][1];
            if (last && has_next) gof(ui + 1, o2);
            PG8_LDB(B0, 0, 0); PG8_LDB(B1, 0, 1); PG8_SCHED; PG8_LDA(At, 0, 0); PG8_STAGE(PG8_SA(1, 1), a1, gc[1]);
            PG8_WAIT_V(8); PG8_WAIT_L(0); PG8_BAR; PG8_MMA(0, 0, At, B0); PG8_MMA(0, 1, At, B1); PG8_BAR; PG8_SCHED;
            PG8_LDA(At, 0, 1); PG8_STAGE(PG8_SB(0, 0), b2, voffB); PG8_STAGE(PG8_SB(0, 1), b2 + hstep, voffB); PG8_STAGE(PG8_SA(0, 0), a2, o2[0]);
            PG8_WAIT_V(8); PG8_WAIT_L(0); PG8_BAR; PG8_MMA(1, 0, At, B0); PG8_MMA(1, 1, At, B1); PG8_BAR; PG8_SCHED;
            PG8_LDB(B0, 1, 0); PG8_LDB(B1, 1, 1); PG8_SCHED; PG8_LDA(At, 1, 0); PG8_STAGE(PG8_SA(0, 1), a2, o2[1]);
            PG8_WAIT_V(8); PG8_WAIT_L(0); PG8_BAR; PG8_MMA(0, 0, At, B0); PG8_MMA(0, 1, At, B1); PG8_BAR; PG8_SCHED;
            PG8_LDA(At, 1, 1); PG8_STAGE(PG8_SB(1, 0), b3, voffB); PG8_STAGE(PG8_SB(1, 1), b3 + hstep, voffB); PG8_STAGE(PG8_SA(1, 0), a3, o2[0]);
            PG8_WAIT_V(8); PG8_WAIT_L(0); PG8_BAR; PG8_MMA(1, 0, At, B0); PG8_MMA(1, 1, At, B1); PG8_BAR; PG8_SCHED;
            } else if constexpr (SP2) {
            PG8_LDB(B0, 0, 0); PG8_LDB(B1, 0, 1); PG8_SCHED; PG8_LDA(At, 0, 0); PG8_STAGE(PG8_SA(1, 1), a1 + hstep, voffA);
            PG8_WAIT_V(8); PG8_WAIT_L(0); PG8_BAR; PG8_MMA(0, 0, At, B0); PG8_MMA(0, 1, At, B1); PG8_BAR; PG8_SCHED;
            PG8_LDA(At, 0, 1); PG8_STAGE(PG8_SB(0, 0), b2, voffB); PG8_STAGE(PG8_SB(0, 1), b2 + hstep, voffB); PG8_STAGE(PG8_SA(0, 0), a2, voffA);
            PG8_WAIT_V(8); PG8_WAIT_L(0); PG8_BAR; PG8_MMA(1, 0, At, B0); PG8_MMA(1, 1, At, B1); PG8_BAR; PG8_SCHED;
            PG8_LDB(B0, 1, 0); PG8_LDB(B1, 1, 1); PG8_SCHED; PG8_LDA(At, 1, 0); PG8_STAGE(PG8_SA(0, 1), a2 + hstep, voffA);
            PG8_WAIT_V(8); PG8_WAIT_L(0); PG8_BAR; PG8_MMA(0, 0, At, B0); PG8_MMA(0, 1, At, B1); PG8_BAR; PG8_SCHED;
            PG8_LDA(At, 1, 1); PG8_STAGE(PG8_SB(1, 0), b3, voffB); PG8_STAGE(PG8_SB(1, 1), b3 + hstep, voffB); PG8_STAGE(PG8_SA(1, 0), a3, voffA);
            PG8_WAIT_V(8); PG8_WAIT_L(0); PG8_BAR; PG8_MMA(1, 0, At, B0); PG8_MMA(1, 1, At, B1); PG8_BAR; PG8_SCHED;
            } else {
            PG8_LDB(B0, 0, 0); PG8_SCHED; PG8_LDA(At, 0, 0); PG8_STAGE(PG8_SA(1, 1), a1 + hstep, voffA);
            PG8_WAIT_L(8); PG8_BAR; PG8_WAIT_L(0); PG8_MMA(0, 0, At, B0); PG8_BAR; PG8_SCHED;
            PG8_LDB(B1, 0, 1); PG8_STAGE(PG8_SB(0, 0), b2, voffB);
            PG8_BAR; PG8_WAIT_L(0); PG8_MMA(0, 1, At, B1); PG8_BAR;
            PG8_LDA(At, 0, 1); PG8_STAGE(PG8_SA(0, 0), a2, voffA);
            PG8_BAR; PG8_WAIT_L(0); PG8_MMA(1, 0, At, B0); PG8_BAR; PG8_SCHED;
            PG8_STAGE(PG8_SB(0, 1), b2 + hstep, voffB);
            PG8_WAIT_V(6); PG8_BAR; PG8_MMA(1, 1, At, B1); PG8_BAR;
            PG8_LDB(B0, 1, 0); PG8_SCHED; PG8_LDA(At, 1, 0); PG8_STAGE(PG8_SA(0, 1), a2 + hstep, voffA);
            PG8_WAIT_L(8); PG8_BAR; PG8_WAIT_L(0); PG8_MMA(0, 0, At, B0); PG8_BAR; PG8_SCHED;
            PG8_LDB(B1, 1, 1); PG8_STAGE(PG8_SB(1, 0), b3, voffB);
            PG8_BAR; PG8_WAIT_L(0); PG8_MMA(0, 1, At, B1); PG8_BAR;
            PG8_LDA(At, 1, 1); PG8_STAGE(PG8_SA(1, 0), a3, voffA);
            PG8_BAR; PG8_WAIT_L(0); PG8_MMA(1, 0, At, B0); PG8_BAR; PG8_SCHED;
            PG8_STAGE(PG8_SB(1, 1), b3 + hstep, voffB);
            PG8_WAIT_V(6); PG8_BAR; PG8_MMA(1, 1, At, B1); PG8_BAR;
            }
        }
        if constexpr (ALIGN_EPI) { if (wr == 0) PG8_BAR; }
        { int le_; asm volatile("v_mbcnt_lo_u32_b32 %0, -1, 0\n\tv_mbcnt_hi_u32_b32 %0, -1, %0" : "=v"(le_));
          const int fr_e = le_ & 15, fq_e = le_ >> 4;
          if (cur.last) E(acc, cur, wr, wc, fr_e, fq_e); else E.mid(acc, cur, wr, wc, fr_e, fq_e); }
        if (!has_next) break;
        if (cur.last) {
#pragma unroll
        for (int a = 0; a < 2; ++a)
#pragma unroll
            for (int b = 0; b < 2; ++b)
#pragma unroll
                for (int m = 0; m < 4; ++m)
#pragma unroll
                    for (int n = 0; n < 2; ++n) acc[a][b][m][n] = (f32x4){0.f, 0.f, 0.f, 0.f};
        }
        cur = nxt; cA = nA; cB = nB; ++ui;
        if constexpr (Sched::GATHER) gof(ui, gc);
        if constexpr (ALIGN_EPI) { if (wr == 1) PG8_BAR; }
    }
    PG8_WAIT_V(0);
    if constexpr (!ALIGN_EPI) { if (wr == 0) PG8_BAR; }
    PG8_BAR;
#undef PG8_SA
#undef PG8_SB
#undef PG8_STAGE
#undef PG8_LDA
#undef PG8_LDB
#undef PG8_MMA
#undef PG8_WAIT_V
#undef PG8_WAIT_L
#undef PG8_BAR
#undef PG8_SCHED
}
}


#define GAS __attribute__((address_space(1)))
#define LAS __attribute__((address_space(3)))
typedef unsigned short bf16;
typedef unsigned v4u __attribute__((ext_vector_type(4)));
typedef float f32x4 __attribute__((ext_vector_type(4)));
typedef short bf16x8 __attribute__((ext_vector_type(8)));
typedef GAS unsigned gu32;
typedef GAS unsigned long long gu64;
#define RLX_AGENT __ATOMIC_RELAXED, __HIP_MEMORY_SCOPE_AGENT
#define LDS_WAIT() asm volatile("s_waitcnt lgkmcnt(0)" ::: "memory")
#define VM_WAIT() asm volatile("s_waitcnt vmcnt(0)" ::: "memory")
__device__ __forceinline__ unsigned long long rt() { return __builtin_amdgcn_s_memrealtime(); }
__device__ __forceinline__ unsigned f2bf(float f) { unsigned u = __builtin_bit_cast(unsigned, f); return (u + 0x7fffu + ((u >> 16) & 1u)) >> 16; }
__device__ __forceinline__ unsigned pk2(float lo, float hi) { return f2bf(lo) | (f2bf(hi) << 16); }

#define XB_TMO      128
#define XB_XCNT(j)  (256  + 64 * (j))
#define XB_XSUB(j)  (1280 + 64 * (j))
#define XB_XGEN(j)  (2304 + 64 * (j))
#define XB_TOP      3328
#define XB_TOPGEN   3392
#define XCD_BAR_WORDS 3456
#define XB_SPIN_CAP (1u << 18)

__device__ __forceinline__ unsigned xb_ld(unsigned* p)              { return __hip_atomic_load(p, __ATOMIC_RELAXED, __HIP_MEMORY_SCOPE_AGENT); }
__device__ __forceinline__ unsigned xb_add(unsigned* p, unsigned v) { return __hip_atomic_fetch_add(p, v, __ATOMIC_RELAXED, __HIP_MEMORY_SCOPE_AGENT); }
__device__ __forceinline__ unsigned xb_xcc_id() { return (unsigned)__builtin_amdgcn_s_getreg((3 << 11) | 20) & 0xFu; }
#define XB_SPIN(cond, bar) do { unsigned _sp = 0; while (cond) { __builtin_amdgcn_s_sleep(1); \
    if ((++_sp & 255u) == 0u) { if (xb_ld(&(bar)[XB_TMO])) break; if (_sp > XB_SPIN_CAP) { atomicAdd(&(bar)[XB_TMO], 1u); break; } } } } while (0)

struct XcdBarrier {
    unsigned* bar; unsigned x;
    volatile LAS unsigned* st;
};

__device__ __forceinline__ XcdBarrier xcd_barrier_post(unsigned* bar, volatile LAS unsigned* st) {
    XcdBarrier b; b.bar = bar; b.x = xb_xcc_id(); b.st = st;
    if (threadIdx.x == 0) (void)xb_add(&bar[XB_XCNT(b.x)], 1u);
    return b;
}
__device__ __forceinline__ void xcd_barrier_complete(unsigned* bar, unsigned x, unsigned& nloc, unsigned& nx) {
    const unsigned G = gridDim.x * gridDim.y * gridDim.z;
    unsigned sum, cnt, mine, sp = 0u;
    for (;;) {
        sum = 0u; cnt = 0u; mine = 0u;
#pragma unroll
        for (unsigned j = 0; j < 16; ++j) { const unsigned c = xb_ld(&bar[XB_XCNT(j)]); sum += c; cnt += (c > 0u) ? 1u : 0u; mine = (j == x) ? c : mine; }
        if (sum == G) break;
        __builtin_amdgcn_s_sleep(1);
        if ((++sp & 255u) == 0u) { if (xb_ld(&bar[XB_TMO])) break; if (sp > XB_SPIN_CAP) { atomicAdd(&bar[XB_TMO], 1u); break; } }
    }
    nloc = mine > 0u ? mine : 1u; nx = cnt > 0u ? cnt : 1u;
}

__device__ __forceinline__ void xcd_barrier(const XcdBarrier& b) {
    asm volatile("s_waitcnt vmcnt(0)" ::: "memory");
    __syncthreads();
    if (threadIdx.x == 0) {
        unsigned* bar = b.bar;
        __builtin_amdgcn_s_waitcnt(0);
        unsigned nloc = b.st[0], nx = b.st[1];
        if (nloc == 0u) { xcd_barrier_complete(bar, b.x, nloc, nx); b.st[0] = nloc; b.st[1] = nx; }
        const unsigned old = xb_add(&bar[XB_XSUB(b.x)], 1u);
        const unsigned gen = old / nloc;
        if (old + 1u == (gen + 1u) * nloc) {
            __builtin_amdgcn_fence(__ATOMIC_RELEASE, "agent");
            asm volatile("s_waitcnt vmcnt(0)" ::: "memory");
            const unsigned og = xb_add(&bar[XB_TOP], 1u);
            const unsigned tg = og / nx;
            if (og + 1u == (tg + 1u) * nx) xb_add(&bar[XB_TOPGEN], 1u);
            else XB_SPIN(xb_ld(&bar[XB_TOPGEN]) == tg, bar);
            __builtin_amdgcn_fence(__ATOMIC_ACQUIRE, "agent");
            xb_add(&bar[XB_XGEN(b.x)], 1u);
            asm volatile("s_waitcnt vmcnt(0)" ::: "memory");
        } else {
            XB_SPIN(xb_ld(&bar[XB_XGEN(b.x)]) == gen, bar);
            __builtin_amdgcn_fence(__ATOMIC_ACQUIRE, "agent");
            asm volatile("s_waitcnt vmcnt(0)" ::: "memory");
        }
    }
    __syncthreads();
}


#include <hip/hip_bf16.h>
#include <cmath>
#include <hip/hip_bf16.h>
#include <cmath>
namespace attn_body {
using bf16=__hip_bfloat16;
using bf16x8=__attribute__((ext_vector_type(8)))short;
using s16x4=__attribute__((ext_vector_type(4)))short;
using f32x16=__attribute__((ext_vector_type(16)))float;
using u32x4=__attribute__((ext_vector_type(4)))unsigned;
using f32x4_t=__attribute__((ext_vector_type(4)))float;
constexpr int BATCH=16,NHEAD=8,SEQ=2048,D=64,DM=5888,OP=512;
constexpr int NW=8,QBLK=32,QB=QBLK*NW,KVBLK=64,NQB=SEQ/QB;
constexpr int ATTN_PITCH=DM, ATTN_UNIT_ROWS=QB;
__device__ __forceinline__ int crow(int r,int hi){return (r&3)+8*(r>>2)+4*hi;}
#define SBAR() __builtin_amdgcn_sched_barrier(0)
__device__ __forceinline__ void cmask(f32x16&p0,f32x16&p1,int jb,int qrel,int hi){
  const float NEG=-INFINITY; int kb=64*jb+4*hi;
  #pragma unroll
  for(int r=0;r<16;++r){int kv=kb+(r&3)+8*(r>>2); if(kv>qrel)p0[r]=NEG; if(kv+32>qrel)p1[r]=NEG;}
}

constexpr int NSLOT=3, SLOTB=8192;
constexpr int LDS_K=0, LDS_V=NSLOT*SLOTB, LDS_WS=2*NSLOT*SLOTB, LDS_OST=LDS_WS+NW*64*4, LDS_CB=LDS_OST+NW*4096, LDS_BYTES=LDS_CB+SEQ*4;
constexpr float C2=0.125f*1.4426950408889634f;
__device__ __forceinline__ void glds16(const void*gsrc,unsigned lds_dst){unsigned keep;
  asm volatile("s_mov_b32 %0, m0\n\ts_mov_b32 m0, %2\n\ts_nop 0\n\tglobal_load_lds_dwordx4 %1, off\n\ts_mov_b32 m0, %0":"=&s"(keep):"v"(gsrc),"s"(lds_dst):"memory");}
__device__ __forceinline__ float max3f(float a,float b,float c){float r;asm("v_max3_f32 %0, %1, %2, %3":"=v"(r):"v"(a),"v"(b),"v"(c));return r;}
__device__ __forceinline__ float max2f(float a,float b){float r;asm("v_max_f32_e32 %0, %1, %2":"=v"(r):"v"(a),"v"(b));return r;}
__device__ __forceinline__ float fadd_s(float a,float b){float r;asm("v_add_f32_e32 %0, %1, %2":"=v"(r):"v"(a),"v"(b));return r;}
__device__ __forceinline__ float fsub_s(float a,float b){float r;asm("v_sub_f32_e32 %0, %1, %2":"=v"(r):"v"(a),"v"(b));return r;}
typedef float f32x2_t __attribute__((ext_vector_type(2))); typedef __bf16 bf16x2_t __attribute__((ext_vector_type(2)));
__device__ __forceinline__ unsigned cvtpk_s(float lo,float hi){f32x2_t v={lo,hi};bf16x2_t b=__builtin_convertvector(v,bf16x2_t);return __builtin_bit_cast(unsigned,b);}
#define WAIT_BAR(N) asm volatile("s_waitcnt vmcnt(" #N ") lgkmcnt(0)\n\ts_barrier":::"memory")

__device__ __forceinline__ void qkt(f32x16&p0,f32x16&p1,const char*Kslot,const bf16x8*qr,int r32,int hi){
  const char*kb=Kslot+hi*1024+r32*16;
  #pragma unroll
  for(int d0=0;d0<4;++d0){
    const bf16x8 b0=*reinterpret_cast<const bf16x8*>(kb+d0*2048);
    const bf16x8 b1=*reinterpret_cast<const bf16x8*>(kb+d0*2048+512);
    if(d0==0){p0=__builtin_amdgcn_mfma_f32_32x32x16_bf16(b0,qr[0],p0,0,0,0);p1=__builtin_amdgcn_mfma_f32_32x32x16_bf16(b1,qr[0],p1,0,0,0);}
    else{p0=__builtin_amdgcn_mfma_f32_32x32x16_bf16(b0,qr[d0],p0,0,0,0);p1=__builtin_amdgcn_mfma_f32_32x32x16_bf16(b1,qr[d0],p1,0,0,0);}}
}
typedef __attribute__((address_space(3))) const char* lds_cptr;
typedef short v4i16_t __attribute__((ext_vector_type(4)));
__device__ __forceinline__ void kload8(bf16x8*kf,lds_cptr kp){
  kf[0]=*(const __attribute__((address_space(3))) bf16x8*)(kp);      kf[1]=*(const __attribute__((address_space(3))) bf16x8*)(kp+512);
  kf[2]=*(const __attribute__((address_space(3))) bf16x8*)(kp+2048); kf[3]=*(const __attribute__((address_space(3))) bf16x8*)(kp+2560);
  kf[4]=*(const __attribute__((address_space(3))) bf16x8*)(kp+4096); kf[5]=*(const __attribute__((address_space(3))) bf16x8*)(kp+4608);
  kf[6]=*(const __attribute__((address_space(3))) bf16x8*)(kp+6144); kf[7]=*(const __attribute__((address_space(3))) bf16x8*)(kp+6656);
}
__device__ __forceinline__ void kload2(bf16x8*kf,lds_cptr kp,int j){ kf[2*j]=*(const __attribute__((address_space(3))) bf16x8*)(kp+j*2048); kf[2*j+1]=*(const __attribute__((address_space(3))) bf16x8*)(kp+j*2048+512); }
__device__ __forceinline__ s16x4 vtr(lds_cptr p){ return __builtin_bit_cast(s16x4,__builtin_amdgcn_ds_read_tr16_b64_v4i16((__attribute__((address_space(3))) v4i16_t*)p)); }
__device__ __forceinline__ float rowmax(const f32x16&p0,const f32x16&p1){
  float a=max3f(p0[0],p0[1],p1[0]),b=max3f(p0[2],p0[3],p1[1]);a=max3f(a,p1[2],p1[3]);
  #pragma unroll
  for(int r=4;r<16;r+=4){a=max3f(a,p0[r],p0[r+1]);b=max3f(b,p0[r+2],p0[r+3]);a=max3f(a,p1[r],p1[r+1]);b=max3f(b,p1[r+2],p1[r+3]);}
  const float m=max2f(a,b);
  auto rr=__builtin_amdgcn_permlane32_swap(__float_as_uint(m),__float_as_uint(m),false,false);
  return max2f(__uint_as_float(rr[0]),__uint_as_float(rr[1]));
}
__device__ __forceinline__ void pv(f32x16*o,int vb,bf16x8 pa0,bf16x8 pa1,bf16x8 pa2,bf16x8 pa3){
  #pragma unroll
  for(int d0=0;d0<2;++d0){s16x4 lo[4],hi[4];
    #pragma unroll
    for(int ks=0;ks<4;++ks){
      asm volatile("ds_read_b64_tr_b16 %0,%1 offset:%c2":"=&v"(lo[ks]):"v"(vb),"i"(d0*4096+ks*1024):"memory");
      asm volatile("ds_read_b64_tr_b16 %0,%1 offset:%c2":"=&v"(hi[ks]):"v"(vb),"i"(d0*4096+ks*1024+512):"memory");}
    asm volatile("s_waitcnt lgkmcnt(0)":::"memory");SBAR();
    #define PK(k) (bf16x8){lo[k][0],lo[k][1],lo[k][2],lo[k][3],hi[k][0],hi[k][1],hi[k][2],hi[k][3]}
    o[d0]=__builtin_amdgcn_mfma_f32_32x32x16_bf16(pa0,PK(0),o[d0],0,0,0);
    o[d0]=__builtin_amdgcn_mfma_f32_32x32x16_bf16(pa1,PK(1),o[d0],0,0,0);
    o[d0]=__builtin_amdgcn_mfma_f32_32x32x16_bf16(pa2,PK(2),o[d0],0,0,0);
    o[d0]=__builtin_amdgcn_mfma_f32_32x32x16_bf16(pa3,PK(3),o[d0],0,0,0);
    #undef PK
  }
}

#ifndef ATTN_STORE16
#define ATTN_STORE16(p,v) (*(u32x4*)(p)=(v))
#endif
template<int THRL> __device__ __forceinline__ void attn_unit(int b,int h,int qb,const bf16*Q,const bf16*__restrict__ K,const bf16*__restrict__ V,bf16*O,const float*__restrict__ ck,char*shm,const int wave0){
  int sw_=wave0; asm volatile("":"+s"(sw_)); int ln_; asm volatile("v_mbcnt_lo_u32_b32 %0, -1, 0\n\tv_mbcnt_hi_u32_b32 %0, -1, %0":"=v"(ln_)); const int tid=sw_*64+ln_,lane=tid&63,r32=lane&31,hi=lane>>5; const int wid=__builtin_amdgcn_readfirstlane(tid>>6);
  const long rowbase=(long)b*SEQ; const int q0=qb*QB;
  const bf16*Qw=Q+(rowbase+q0+wid*QBLK)*DM+h*D;
  const bf16*Kh=K+rowbase*DM+h*D,*Vh=V+rowbase*DM+h*D;
  const unsigned lds0=(unsigned)(uintptr_t)shm;
  float*wsf=(float*)(shm+LDS_WS)+wid*64;
  const bf16*ksrc=Kh+(long)lane*DM+wid*8;
  const bf16*vsrc=Vh+(long)(16*(wid&3)+(lane>>2))*DM+(wid>>2)*32+(lane&3)*8;
  const unsigned kdst=lds0+LDS_K+wid*1024, vdst=lds0+LDS_V+wid*1024;
  #define DMA_K(t,slot) glds16(ksrc+(long)(t)*KVBLK*DM,(unsigned)__builtin_amdgcn_readfirstlane(kdst+(slot)))
  #define DMA_V(t,slot) glds16(vsrc+(long)(t)*KVBLK*DM,(unsigned)__builtin_amdgcn_readfirstlane(vdst+(slot)))
  const int vb0=(int)(lds0+LDS_V)+((lane>>4)&1)*32+(lane&3)*8+(4*hi+((lane&15)>>2))*64;
  const char*Kbase=shm+LDS_K; bf16x8 kf[8];
  const lds_cptr shm3=(lds_cptr)shm; const lds_cptr kp0=shm3+LDS_K+hi*1024+r32*16; const lds_cptr vp0=shm3+LDS_V+((lane>>4)&1)*32+(lane&3)*8+(4*hi+((lane&15)>>2))*64;
  const int NT=(q0+QB)/KVBLK;
  { __attribute__((address_space(3))) float*cbl=(__attribute__((address_space(3))) float*)((__attribute__((address_space(3))) char*)shm+LDS_CB); const float cref=ck[q0+QB-1]; for(int i=tid;i<q0+QB;i+=NW*64)cbl[i]=cref-ck[i]; }
  typedef __attribute__((address_space(3))) const f32x4_t* lds_f4p; const lds_f4p cbp=(lds_f4p)((lds_cptr)shm+LDS_CB)+hi;
  #define BIASLD(X0,X1,t) do{ const lds_f4p c_=cbp+16*(t); _Pragma("unroll") for(int g_=0;g_<4;++g_){ const f32x4_t a_=c_[2*g_],b_=c_[8+2*g_]; X0[4*g_]=a_[0];X0[4*g_+1]=a_[1];X0[4*g_+2]=a_[2];X0[4*g_+3]=a_[3]; X1[4*g_]=b_[0];X1[4*g_+1]=b_[1];X1[4*g_+2]=b_[2];X1[4*g_+3]=b_[3]; } }while(0)
  DMA_K(0,0);DMA_V(0,0);DMA_K(1,SLOTB);
  bf16x8 qr[4];
  #pragma unroll
  for(int d0=0;d0<4;++d0)qr[d0]=*reinterpret_cast<const bf16x8*>(&Qw[(long)r32*DM+d0*16+hi*8]);
  float mhat=0.f,l_reg=0.f;f32x16 o[2];o[0]=f32x16{};o[1]=f32x16{};
  const int qrel=wid*QBLK+r32;
  #define CMASK(P0,P1,t) do{int jb_=(t)-(NT-4); if(jb_>=0)cmask(P0,P1,jb_,qrel,hi);}while(0)
  bool resc=false;
  #define START(P0,P1) do{ const float rm=rowmax(P0,P1); resc=false; \
    { const float dl=rm; mhat=fadd_s(mhat,dl); \
      _Pragma("unroll") for(int r=0;r<16;++r){P0[r]=fsub_s(P0[r],dl);P1[r]=fsub_s(P1[r],dl);} } \
    _Pragma("unroll") for(int r=0;r<16;++r)P0[r]=__builtin_amdgcn_exp2f(P0[r]); }while(0)
  #define RESC() do{ if(resc){ asm volatile("s_waitcnt lgkmcnt(0)":::"memory"); \
      _Pragma("unroll") for(int d_=0;d_<2;++d_) _Pragma("unroll") for(int r=0;r<16;++r)o[d_][r]*=wsf[crow(r,hi)]; } }while(0)
  f32x16 pA0,pA1,pB0,pB1;
  int sl_prev=0,sl_cur=0,sl_next=SLOTB;
  #define ROT() do{sl_prev=sl_cur;sl_cur=sl_next;sl_next=(sl_next==(NSLOT-1)*SLOTB)?0:sl_next+SLOTB;}while(0)
  DMA_K(2,2*SLOTB);
  WAIT_BAR(3);
  BIASLD(pA0,pA1,0);
  qkt(pA0,pA1,Kbase,qr,r32,hi);asm volatile("s_nop 15\n\ts_nop 7":"+v"(pA0),"+v"(pA1));CMASK(pA0,pA1,0);
  START(pA0,pA1);
  _Pragma("unroll") for(int r=0;r<16;++r)pA1[r]=__builtin_amdgcn_exp2f(pA1[r]);
  WAIT_BAR(0);
  DMA_K(3,0);DMA_V(1,SLOTB);
  ROT();
  kload8(kf,kp0+sl_cur);
  BIASLD(pB0,pB1,1);
  WAIT_BAR(2);
  s16x4 vlo[8],vhi[8]; u32x4 pw0,pw1,pw2,pw3;
  #define PKW(P,B) cvtpk_s(P[B],P[B+1])
  #define PAF(k) __builtin_bit_cast(bf16x8,pw##k)
  #define VFR(i) (bf16x8){vlo[i][0],vlo[i][1],vlo[i][2],vlo[i][3],vhi[i][0],vhi[i][1],vhi[i][2],vhi[i][3]}
  #define PIN(x) asm volatile("":"+v"(x))
  #define MX3(a,b,c) __builtin_fmaxf(__builtin_fmaxf((a),(b)),(c))
  #define GAPA(MF,A0,A1,A2,A3,W0,W1,PW) do{ MF; sacc+=A0; sacc+=A1; sacc+=A2; sacc+=A3; PIN(sacc); W0; W1; PIN(PW); SBAR(); }while(0)
  #define EX(v) __builtin_amdgcn_exp2f(v)
  #define GAPB(MF,X,B) do{ MF; X[B]=EX(X[B]); X[B+1]=EX(X[B+1]); X[B+2]=EX(X[B+2]); X[B+3]=EX(X[B+3]); PIN(X); SBAR(); }while(0)
  #define VRD(i) do{ vlo[i]=vtr(vp_+(((i)>>2)*4096+((i)&3)*1024)); vhi[i]=vtr(vp_+(((i)>>2)*4096+((i)&3)*1024+512)); }while(0)
  #define KRD(G,j) do{ if(G){ kload2(kf,kp0+sl_next,j); SBAR(); } }while(0)
  #define STEP(C0,C1,P0,P1,t,GK,GV,GL) do{ SBAR(); \
    _Pragma("unroll") for(int r=0;r<16;++r){C0[r]-=mhat;C1[r]-=mhat;} \
    const lds_cptr vp_=vp0+sl_prev; \
    VRD(0); SBAR(); float sacc=(P0[0]+P0[1]); \
    GAPA(C0=__builtin_amdgcn_mfma_f32_32x32x16_bf16(kf[0],qr[0],C0,0,0,0), P0[2],P0[3],P0[4],P0[5],     pw0[0]=PKW(P0,0), pw0[1]=PKW(P0,2), pw0); \
    VRD(4); SBAR(); GAPA(C1=__builtin_amdgcn_mfma_f32_32x32x16_bf16(kf[1],qr[0],C1,0,0,0), P0[6],P0[7],P0[8],P0[9],     pw0[2]=PKW(P0,4), pw0[3]=PKW(P0,6), pw0); \
    VRD(1); SBAR(); GAPA(C0=__builtin_amdgcn_mfma_f32_32x32x16_bf16(kf[2],qr[1],C0,0,0,0),   P0[10],P0[11],P0[12],P0[13], pw1[0]=PKW(P0,8), pw1[1]=PKW(P0,10), pw1); \
    VRD(5); SBAR(); GAPA(C1=__builtin_amdgcn_mfma_f32_32x32x16_bf16(kf[3],qr[1],C1,0,0,0),   P0[14],P0[15],P1[0],P1[1],   pw1[2]=PKW(P0,12),pw1[3]=PKW(P0,14), pw1); \
    VRD(2); SBAR(); GAPA(C0=__builtin_amdgcn_mfma_f32_32x32x16_bf16(kf[4],qr[2],C0,0,0,0),   P1[2],P1[3],P1[4],P1[5],     pw2[0]=PKW(P1,0), pw2[1]=PKW(P1,2), pw2); \
    VRD(6); SBAR(); GAPA(C1=__builtin_amdgcn_mfma_f32_32x32x16_bf16(kf[5],qr[2],C1,0,0,0),   P1[6],P1[7],P1[8],P1[9],     pw2[2]=PKW(P1,4), pw2[3]=PKW(P1,6), pw2); \
    VRD(3); SBAR(); GAPA(C0=__builtin_amdgcn_mfma_f32_32x32x16_bf16(kf[6],qr[3],C0,0,0,0),   P1[10],P1[11],P1[12],P1[13], pw3[0]=PKW(P1,8), pw3[1]=PKW(P1,10), pw3); \
    VRD(7); SBAR(); GAPA(C1=__builtin_amdgcn_mfma_f32_32x32x16_bf16(kf[7],qr[3],C1,0,0,0),   P1[14],P1[15],0.f,0.f,       pw3[2]=PKW(P1,12),pw3[3]=PKW(P1,14), pw3); \
    l_reg+=sacc; \
    if(GK){DMA_K((t)+3,sl_cur);} if(GV){DMA_V((t)+1,sl_next);} \
    CMASK(C0,C1,t); \
    { float a=MX3(C0[0],C0[1],C1[0]),b=MX3(C0[2],C0[3],C1[1]); a=MX3(a,C1[2],C1[3]); \
      _Pragma("unroll") for(int r=4;r<16;r+=4){a=MX3(a,C0[r],C0[r+1]);b=MX3(b,C0[r+2],C0[r+3]);a=MX3(a,C1[r],C1[r+1]);b=MX3(b,C1[r+2],C1[r+3]);} \
      float rm=__builtin_fmaxf(a,b); { auto rr=__builtin_amdgcn_permlane32_swap(__float_as_uint(rm),__float_as_uint(rm),false,false); rm=__builtin_fmaxf(__uint_as_float(rr[0]),__uint_as_float(rr[1])); } \
      resc=false; \
      if(__builtin_expect(__any(rm>(float)THRL),0)){ const float dl=__builtin_fmaxf(rm,0.f); mhat+=dl; \
        _Pragma("unroll") for(int r=0;r<16;++r){C0[r]-=dl;C1[r]-=dl;} \
        const float f=__builtin_amdgcn_exp2f(-dl); l_reg*=f; if(hi==0)wsf[r32]=f; resc=true; } } \
    SBAR(); \
    GAPB(o[0]=__builtin_amdgcn_mfma_f32_32x32x16_bf16(PAF(0),VFR(0),o[0],0,0,0), C0,0); \
    GAPB(o[1]=__builtin_amdgcn_mfma_f32_32x32x16_bf16(PAF(0),VFR(4),o[1],0,0,0), C0,4); \
    KRD(GL,0); GAPB(o[0]=__builtin_amdgcn_mfma_f32_32x32x16_bf16(PAF(1),VFR(1),o[0],0,0,0), C0,8); \
    KRD(GL,1); GAPB(o[1]=__builtin_amdgcn_mfma_f32_32x32x16_bf16(PAF(1),VFR(5),o[1],0,0,0), C0,12); \
    KRD(GL,2); GAPB(o[0]=__builtin_amdgcn_mfma_f32_32x32x16_bf16(PAF(2),VFR(2),o[0],0,0,0), C1,0); \
    KRD(GL,3); GAPB(o[1]=__builtin_amdgcn_mfma_f32_32x32x16_bf16(PAF(2),VFR(6),o[1],0,0,0), C1,4); \
    GAPB(o[0]=__builtin_amdgcn_mfma_f32_32x32x16_bf16(PAF(3),VFR(3),o[0],0,0,0), C1,8); \
    GAPB(o[1]=__builtin_amdgcn_mfma_f32_32x32x16_bf16(PAF(3),VFR(7),o[1],0,0,0), C1,12); \
    if((t)+1<NT){ BIASLD(P0,P1,(t)+1); } \
    }while(0)
  int t=1;
  #undef CMASK
  #define CMASK(P0,P1,t) do{}while(0)
  for(;t+5<NT;t+=2){
    STEP(pB0,pB1,pA0,pA1,t,true,true,true);     WAIT_BAR(2); RESC(); ROT();
    STEP(pA0,pA1,pB0,pB1,t+1,true,true,true);   WAIT_BAR(2); RESC(); ROT();
  }
  #undef CMASK
  #define CMASK(P0,P1,t) do{int jb_=(t)-(NT-4); if(jb_>=0)cmask(P0,P1,jb_,qrel,hi);}while(0)
  #define ENDW(tt) do{ if((tt)+3<NT){WAIT_BAR(2);} else if((tt)+2<NT){WAIT_BAR(1);} else {WAIT_BAR(0);} }while(0)
  for(;t+1<NT;t+=2){
    STEP(pB0,pB1,pA0,pA1,t,(t+3<NT),(t+1<NT),(t+1<NT));       ENDW(t);   RESC(); ROT();
    STEP(pA0,pA1,pB0,pB1,t+1,(t+4<NT),(t+2<NT),(t+2<NT));     ENDW(t+1); RESC(); ROT();
  }
  STEP(pB0,pB1,pA0,pA1,NT-1,false,false,false); RESC();
  { float sacc=pB0[0]+pB0[1]; _Pragma("unroll") for(int r=2;r<16;++r)sacc+=pB0[r]; _Pragma("unroll") for(int r=0;r<16;++r)sacc+=pB1[r]; l_reg+=sacc;
    pw0=(u32x4){PKW(pB0,0),PKW(pB0,2),PKW(pB0,4),PKW(pB0,6)};pw1=(u32x4){PKW(pB0,8),PKW(pB0,10),PKW(pB0,12),PKW(pB0,14)};pw2=(u32x4){PKW(pB1,0),PKW(pB1,2),PKW(pB1,4),PKW(pB1,6)};pw3=(u32x4){PKW(pB1,8),PKW(pB1,10),PKW(pB1,12),PKW(pB1,14)};
    SBAR(); pv(o,vb0+sl_cur,PAF(0),PAF(1),PAF(2),PAF(3)); }
  #undef PKW
  #undef PAF
  #undef VFR
  #undef PIN
  #undef MX3
  #undef GAPA
  #undef GAPB
  #undef EX
  #undef VRD
  #undef KRD
  #undef STEP
  #undef ENDW
  {auto rr=__builtin_amdgcn_permlane32_swap(__float_as_uint(l_reg),__float_as_uint(l_reg),false,false);l_reg=__uint_as_float(rr[0])+__uint_as_float(rr[1]);}
  if(hi==0)wsf[32+r32]=l_reg;asm volatile("s_waitcnt lgkmcnt(0)":::"memory");
  float rli[16];
  #pragma unroll
  for(int r=0;r<16;++r)rli[r]=__builtin_amdgcn_rcpf(wsf[32+crow(r,hi)]);
  bf16*Ow=O+(rowbase+q0+wid*QBLK)*OP+h*D;
  { bf16*stg=(bf16*)(shm+LDS_OST)+wid*2048;
    #pragma unroll
    for(int r=0;r<16;++r){const int orow=crow(r,hi);
      #pragma unroll
      for(int d0=0;d0<2;++d0)stg[orow*64+d0*32+r32]=__float2bfloat16(o[d0][r]*rli[r]);}
    asm volatile("s_waitcnt lgkmcnt(0)":::"memory");
    #pragma unroll
    for(int i=0;i<4;++i){const int row=i*8+(lane>>3),ch=lane&7; const u32x4 v=*(const u32x4*)(stg+row*64+ch*8); ATTN_STORE16(Ow+(long)row*OP+ch*8,v);} }
  asm volatile("s_waitcnt lgkmcnt(0)\n\ts_barrier":::"memory");
  #undef DMA_K
  #undef DMA_V
  #undef BIASLD
  #undef CMASK
  #undef START
  #undef RESC
  #undef ROT
}
constexpr int ATTN_LDS_BYTES=LDS_BYTES;
#undef SBAR
#undef WAIT_BAR
}


constexpr size_t MiB = 1u << 20;
constexpr size_t WS_CTL = 0, CTL_ZERO_BYTES = 1 * MiB;
constexpr size_t WS_WSMALL = 1 * MiB;
constexpr size_t WL_WIN = 0, WL_LORA = 18 * MiB, WL_BR = WL_LORA + 768 * 1024, WL_WOUT = WL_BR + 4 * MiB, WL_STRIDE = WL_WOUT + 2 * MiB;
constexpr size_t WS_WEXP = 100 * MiB;
constexpr size_t WS_PMIX = 196 * MiB;
constexpr size_t WS_MISC = 564 * MiB;
constexpr size_t WS_PGATE = 568 * MiB;
constexpr size_t WS_RA = 760 * MiB;
constexpr size_t WS_RB = 888 * MiB;
constexpr size_t WS_ROUTE = 1016 * MiB;
constexpr size_t WS_END = 1024 * MiB;
static_assert(WS_WSMALL + 4 * WL_STRIDE <= WS_WEXP, "small weights");
constexpr size_t WS_MERGED = WS_PMIX;
constexpr size_t WS_X1 = WS_RA;
constexpr size_t WS_LIN = WS_RA, WS_LOUT = WS_RA + 16 * MiB, WS_CK = WS_RA + 112 * MiB, WS_SSQ = WS_RA + 113 * MiB;
constexpr size_t WS_DTCS = WS_RA + 115 * MiB;
constexpr size_t WS_HALO = WS_ROUTE + 1 * MiB;
constexpr int CW_QUEUE = 12288;
constexpr size_t WS_OR = WS_RB, WS_OF = WS_RB + 32 * MiB, WS_OM0 = WS_RB + 64 * MiB, WS_OM1 = WS_RB + 96 * MiB, WS_XB = WS_RB;
constexpr size_t WS_GATEW = WS_ROUTE, WS_CNT = WS_ROUTE + 512 * 1024;
constexpr size_t WS_POS = WS_ROUTE + 256 * 1024;
constexpr size_t WS_ROWTOK = WS_ROUTE + 6 * MiB;
constexpr size_t WS_TAB = WS_ROUTE + 768 * 1024;
constexpr int MPAD = 73728;
constexpr size_t WS_XG = 196 * MiB, WS_H = 340 * MiB, WS_YS = 412 * MiB;
constexpr size_t WEXP_GU = 0, WEXP_D = 64 * MiB;
constexpr int CW_BAR = 1024;
constexpr int CW_CNT = 16384, CNT_STRIDE = 32;

constexpr int RING_OFF = 0, RING_BYTES = 131072;
constexpr int LDS_BYTES = 147456;
constexpr int LDSCTL_OFF = LDS_BYTES - 4096, MISC_OFF = LDSCTL_OFF;
constexpr int LTOK_OFF = RING_OFF + RING_BYTES, LTOK_UNITS = 11;
static_assert(LTOK_OFF + LTOK_UNITS * 1024 <= LDSCTL_OFF, "ltok");
constexpr int LTAB_OFF = LDSCTL_OFF + 256;
constexpr int ROUTER_LD = 1028;
static_assert(NEXP * ROUTER_LD * 4 <= LDSCTL_OFF, "router table");
constexpr int NWAVES = 8;

__device__ __forceinline__ void tr_item(const float* W, size_t ldw, int k0, int srccol, bf16* WT, size_t Kd, int drow0, int dk0, LAS float* scr, int lane, const float* kscale = nullptr) {
#pragma unroll 8
    for (int i = 0; i < 32; ++i) { const int kk = 2 * i + (lane >> 5); float wv = srccol >= 0 ? W[(size_t)(k0 + kk) * ldw + srccol] : 0.f; if (kscale) wv *= kscale[k0 + kk]; scr[kk * 33 + (lane & 31)] = wv; }
    LDS_WAIT(); asm volatile("" ::: "memory");
    const int c = lane & 7;
#pragma unroll
    for (int j = 0; j < 4; ++j) { const int n = (lane >> 3) + 8 * j; const LAS float* s = scr + (8 * c) * 33 + n;
        v4u o; o.x = pk2(s[0 * 33], s[1 * 33]); o.y = pk2(s[2 * 33], s[3 * 33]); o.z = pk2(s[4 * 33], s[5 * 33]); o.w = pk2(s[6 * 33], s[7 * 33]);
        *(GAS v4u*)(WT + (size_t)(drow0 + n) * Kd + dk0 + 8 * c) = o; }
    LDS_WAIT(); asm volatile("" ::: "memory");
}
__device__ __forceinline__ void tr4_load(f32x4 (&v)[8], const float* W, size_t ldw, int k0, int n0, int lane, const float* kscale) {
    const int rr = lane >> 3, c4 = (lane & 7) * 4;
#pragma unroll
    for (int i = 0; i < 8; ++i) v[i] = *(const GAS f32x4*)(W + (size_t)(k0 + 8 * i + rr) * ldw + n0 + c4);
    if (kscale) {
#pragma unroll
        for (int i = 0; i < 8; ++i) v[i] = v[i] * kscale[k0 + 8 * i + rr]; }
}
__device__ __forceinline__ void tr4_store(const f32x4 (&v)[8], bf16* WT, size_t Kd, int drow0, int dk0, LAS float* scr, int lane) {
    const int rr = lane >> 3, c4 = (lane & 7) * 4;
#pragma unroll
    for (int i = 0; i < 8; ++i) { LAS float* d = scr + (8 * i + rr) * 33 + c4; d[0] = v[i].x; d[1] = v[i].y; d[2] = v[i].z; d[3] = v[i].w; }
    LDS_WAIT(); asm volatile("" ::: "memory");
    const int c = lane & 7;
#pragma unroll
    for (int j = 0; j < 4; ++j) { const int n = (lane >> 3) + 8 * j; const LAS float* sp = scr + (8 * c) * 33 + n;
        v4u o; o.x = pk2(sp[0 * 33], sp[1 * 33]); o.y = pk2(sp[2 * 33], sp[3 * 33]); o.z = pk2(sp[4 * 33], sp[5 * 33]); o.w = pk2(sp[6 * 33], sp[7 * 33]);
        *(GAS v4u*)(WT + (size_t)(drow0 + n) * Kd + dk0 + 8 * c) = o; }
    LDS_WAIT(); asm volatile("" ::: "memory");
}
__device__ __forceinline__ void tr_item4(const float* W, size_t ldw, int k0, int n0, bf16* WT, size_t Kd, int drow0, int dk0, LAS float* scr, int lane, const float* kscale = nullptr) {
    f32x4 v[8]; tr4_load(v, W, ldw, k0, n0, lane, kscale); tr4_store(v, WT, Kd, drow0, dk0, scr, lane);
}
__device__ __forceinline__ int win_srccol(int r) { return r < 3328 ? r : r < 5888 ? r + 8 : r < 5896 ? r - 2560 : r < 5912 ? r : r < 6144 ? -1 : r - 232; }

__device__ __forceinline__ unsigned char* opaque_ptr(unsigned char* p) { GAS unsigned char* g = (GAS unsigned char*)p; asm volatile("" : "+s"(g)); return (unsigned char*)g; }
__device__ __forceinline__ int lane_id() { int x; asm volatile("v_mbcnt_lo_u32_b32 %0, -1, 0\n\tv_mbcnt_hi_u32_b32 %0, -1, %0" : "=v"(x)); return x; }
__device__ __forceinline__ float shfl_f(float v, int src) { return __int_as_float(__builtin_amdgcn_ds_bpermute(src << 2, __float_as_int(v))); }
__device__ __forceinline__ int shfl_i(int v, int src) { return __builtin_amdgcn_ds_bpermute(src << 2, v); }
__device__ __forceinline__ float shx(float v, int m, int lane) { return shfl_f(v, lane ^ m); }
template <int CTRL> __device__ __forceinline__ float dpp_f(float v) { return __builtin_bit_cast(float, __builtin_amdgcn_update_dpp(0, __builtin_bit_cast(int, v), CTRL, 0xF, 0xF, false)); }
__device__ __forceinline__ float sum8(float v) { v += dpp_f<0xB1>(v); v += dpp_f<0x4E>(v); v += dpp_f<0x141>(v); return v; }
__device__ __forceinline__ float sum16(float v) { v = sum8(v); v += dpp_f<0x140>(v); return v; }
template <int CTRL, int RMASK> __device__ __forceinline__ float dpp_fm(float v) { return __builtin_bit_cast(float, __builtin_amdgcn_update_dpp(0, __builtin_bit_cast(int, v), CTRL, RMASK, 0xF, true)); }
__device__ __forceinline__ float wave_scan(float v) {
    v += dpp_fm<0x111, 0xF>(v); v += dpp_fm<0x112, 0xF>(v); v += dpp_fm<0x114, 0xF>(v); v += dpp_fm<0x118, 0xF>(v);
    v += __builtin_bit_cast(float, __builtin_amdgcn_update_dpp(0, __builtin_bit_cast(int, v), 0x142, 0xA, 0xF, false));
    v += __builtin_bit_cast(float, __builtin_amdgcn_update_dpp(0, __builtin_bit_cast(int, v), 0x143, 0xC, 0xF, false));
    return v;
}
__device__ __forceinline__ float wsum(float v, int lane) {
    v = sum16(v); (void)lane;
    const float r0 = __builtin_bit_cast(float, __builtin_amdgcn_readlane(__builtin_bit_cast(int, v), 0)), r1 = __builtin_bit_cast(float, __builtin_amdgcn_readlane(__builtin_bit_cast(int, v), 16));
    const float r2 = __builtin_bit_cast(float, __builtin_amdgcn_readlane(__builtin_bit_cast(int, v), 32)), r3 = __builtin_bit_cast(float, __builtin_amdgcn_readlane(__builtin_bit_cast(int, v), 48));
    return (r0 + r1) + (r2 + r3);
}
#define LBAR() asm volatile("s_waitcnt lgkmcnt(0)\n\ts_barrier" ::: "memory")
#define PHASE_IDS const int wave = opaque_int(wave0), lane = lane_id(), tid = wave * 64 + lane; const int G = opaque_int((int)gridDim.x), bx = opaque_int((int)blockIdx.x); \
    const int vcu = (G % 8 == 0) ? (bx % 8) * (G / 8) + bx / 8 : bx; const int gw = vcu * NWAVES + wave, NGW = G * NWAVES; LAS float* scr = (LAS float*)(lds + RING_OFF + wave * 16384); (void)tid; (void)gw; (void)NGW; (void)scr; (void)lane
struct Args;
__device__ __forceinline__ int opaque_int(int i) { asm volatile("" : "+s"(i)); return i; }
struct Args { const float* in[N_IN]; float* out; unsigned char* ws; int prologue, l_lo, l_hi, ph_lo, ph_hi, pad; };
enum { PH_EXPW = 0, PH_INPROJ = 1, PH_PREP = 2, PH_LORA = 3, PH_MIX = 4, PH_FIN = 5, PH_MERGE = 6, PH_WOUT = 7, PH_LN1 = 8, PH_DISPATCH = 9, PH_GU = 10, PH_DOWN = 11, PH_LN2 = 12, PH_COUNT = 13 };

__global__ void __launch_bounds__(NWAVES * 64, 2) mk_fwd(Args a) {
    extern __shared__ __attribute__((aligned(16))) unsigned char lds_raw[];
    LAS unsigned char* lds = (LAS unsigned char*)lds_raw;
    const int wave0 = __builtin_amdgcn_readfirstlane((int)threadIdx.x >> 6);
    const int wave = wave0, lane = lane_id(), tid = wave * 64 + lane;
    const int G = gridDim.x; const int bx = blockIdx.x; const int vcu = (G % 8 == 0) ? (bx % 8) * (G / 8) + bx / 8 : bx;
    unsigned char* ws = a.ws;
    for (int u = tid; u < (LDS_BYTES - LDSCTL_OFF) / 4; u += NWAVES * 64) ((LAS unsigned*)(lds + LDSCTL_OFF))[u] = 0u;
    __syncthreads();
    const bool one_launch = a.prologue && (a.l_hi - a.l_lo) * (a.ph_hi - a.ph_lo) > 1;
    unsigned bar_x = 0u;
    if (one_launch) bar_x = xcd_barrier_post((unsigned*)(a.ws + WS_CTL) + CW_BAR, (volatile LAS unsigned*)(lds + MISC_OFF) + 8).x;
#define SEAM() do { if (a.prologue && (a.l_hi - a.l_lo) * (a.ph_hi - a.ph_lo) > 1) { XcdBarrier b2_; b2_.bar = (unsigned*)(opaque_ptr(a.ws) + WS_CTL) + CW_BAR; b2_.x = (unsigned)opaque_int((int)bar_x); b2_.st = (volatile LAS unsigned*)(lds + MISC_OFF) + 8; xcd_barrier(b2_); } } while (0)
    const int gw = vcu * NWAVES + wave, NGW = G * NWAVES;
    LAS float* scr = (LAS float*)(lds + RING_OFF + wave * 16384);

    if (a.prologue) {
        constexpr int I_WINI = 16 * 280, I_BRI = 8 * 32, I_WOI = 16 * 32, I_LAYER = I_WINI + 4 * I_BRI + I_WOI;
        auto dsc = [&](int it, const float*& W, size_t& ldw, int& k0, int& n0, bf16*& WT, size_t& Kd, int& drow0, int& dk0, const float*& ks) {
            const int l = it / I_LAYER; int r = it % I_LAYER; unsigned char* wl = ws + WS_WSMALL + (size_t)l * WL_STRIDE; ks = nullptr;
            if (r < I_WINI) { const int kb = r / 280, q = r % 280, nb = q < 184 ? q : q + 8;
                W = a.in[opaque_int(I_WIN)] + (size_t)l * D * IN_COLS; ldw = IN_COLS; k0 = 64 * kb; n0 = win_srccol(32 * nb); WT = (bf16*)(wl + WL_WIN); Kd = 1024; drow0 = 32 * nb; dk0 = 64 * kb; return; }
            r -= I_WINI;
            if (r < 4 * I_BRI) { const int sg = r / I_BRI, q = r % I_BRI, kb = q / 32, nb = q % 32;
                W = sg == 0 ? a.in[opaque_int(I_BRR)] + (size_t)l * 512 * D : sg == 1 ? a.in[opaque_int(I_BRF)] + (size_t)l * 512 * D : a.in[opaque_int(I_BRM)] + (size_t)l * 1024 * D + (size_t)(sg - 2) * 512 * D;
                ldw = D; k0 = 64 * kb; n0 = 32 * nb; WT = (bf16*)(wl + WL_BR + (size_t)sg * MiB); Kd = 512; drow0 = 32 * nb; dk0 = 64 * kb;
                if (sg >= 2) ks = a.in[I_NG] + (size_t)l * SSM_DIM + (size_t)(sg - 2) * 512; return; }
            r -= 4 * I_BRI;
            { const int kb = r / 32, nb = r % 32;
              W = a.in[opaque_int(I_WO)] + (size_t)l * D * D; ldw = D; k0 = 64 * kb; n0 = 32 * nb; WT = (bf16*)(wl + WL_WOUT); Kd = 1024; drow0 = 32 * nb; dk0 = 64 * kb; }
        };
        for (int it = gw; it < DEPTH * I_LAYER; it += 2 * NGW) {
            const float *W0, *W1, *ks0, *ks1; size_t ldw0, ldw1, Kd0, Kd1; int k00, k01, n00, n01, dr0, dr1, dk00, dk01; bf16 *WT0, *WT1;
            const bool two = it + NGW < DEPTH * I_LAYER;
            dsc(it, W0, ldw0, k00, n00, WT0, Kd0, dr0, dk00, ks0); dsc(two ? it + NGW : it, W1, ldw1, k01, n01, WT1, Kd1, dr1, dk01, ks1);
            f32x4 v0[8], v1[8];
            tr4_load(v0, W0, ldw0, k00, n00, lane, ks0); tr4_load(v1, W1, ldw1, k01, n01, lane, ks1);
            tr4_store(v0, WT0, Kd0, dr0, dk00, scr, lane);
            if (two) tr4_store(v1, WT1, Kd1, dr1, dk01, scr, lane);
        }
        for (int it = gw; it < DEPTH * 16 * 8; it += NGW) { const int l = it >> 7, kb = (it >> 3) & 15, nb = 184 + (it & 7);
            tr_item(a.in[opaque_int(I_WIN)] + (size_t)l * D * IN_COLS, IN_COLS, 64 * kb, win_srccol(32 * nb + (lane & 31)), (bf16*)(ws + WS_WSMALL + (size_t)l * WL_STRIDE + WL_WIN), 1024, 32 * nb, 64 * kb, scr, lane); }
        for (int it = gw; it < DEPTH * 64; it += NGW) {
            const int l = it >> 6, r = it & 63; bf16* LT = (bf16*)(ws + WS_WSMALL + (size_t)l * WL_STRIDE + WL_LORA);
            if (r < 16) tr_item4(a.in[I_WUP] + (size_t)l * 64 * 512, 512, 0, 32 * r, LT, 256, 32 * r, 0, scr, lane);
            else if (r < 32) tr_item4(a.in[I_AUP] + (size_t)l * 64 * 512, 512, 0, 32 * (r - 16), LT, 256, 512 + 32 * (r - 16), 64, scr, lane);
            else { const int q = r - 32, kb = q >> 4, nb = q & 15; tr_item4(a.in[I_GUP] + (size_t)l * 128 * 512, 512, 64 * kb, 32 * nb, LT, 256, 1024 + 32 * nb, 128 + 64 * kb, scr, lane); }
        }
        for (int idx = gw * 64 + lane; idx < DEPTH * 1536 * 32; idx += NGW * 64) {
            const int l = idx / (1536 * 32), r = idx % (1536 * 32), n = r >> 5, k8 = (r & 31) * 8;
            const bool nz = (n < 512) ? (k8 < 64) : (n < 1024) ? (k8 >= 64 && k8 < 128) : (k8 >= 128);
            if (!nz) *(GAS v4u*)((bf16*)(ws + WS_WSMALL + (size_t)l * WL_STRIDE + WL_LORA) + (size_t)n * 256 + k8) = (v4u){0u, 0u, 0u, 0u};
        }
        for (int m = gw; m < NTOK; m += 4 * NGW) {
            f32x4 v[4][4];
#pragma unroll
            for (int u = 0; u < 4; ++u) { const int mm = (m + u * NGW < NTOK) ? m + u * NGW : m; const GAS f32x4* xr = (const GAS f32x4*)(a.in[opaque_int(I_X)] + (size_t)mm * D) + lane;
#pragma unroll
                for (int j = 0; j < 4; ++j) v[u][j] = xr[64 * j]; }
#pragma unroll
            for (int u = 0; u < 4; ++u) { if (m + u * NGW >= NTOK) break; GAS unsigned long long* o8 = (GAS unsigned long long*)((bf16*)a.out + (size_t)(m + u * NGW) * D) + lane;
#pragma unroll
                for (int j = 0; j < 4; ++j) o8[64 * j] = (unsigned long long)pk2(v[u][j].x, v[u][j].y) | ((unsigned long long)pk2(v[u][j].z, v[u][j].w) << 32); }
        }
        SEAM();
    }
#define IN(k) (opaque_int(a.ph_lo) <= (k) && (k) < opaque_int(a.ph_hi))
    for (int l = a.l_lo; l < a.l_hi; ++l) {
        if (IN(PH_PREP)) { PHASE_IDS;
            unsigned char* ws = opaque_ptr(a.ws);
            constexpr int I_G = NEXP * 16 * 16, I_D = NEXP * 8 * 32;
            for (int it = gw; it < 2 * I_G + I_D; it += NGW) {
                if (it < 2 * I_G) { const int up = it >= I_G, r = it - up * I_G, e = r >> 8, q = r & 255, kb = q >> 4, nb = q & 15, n0 = 32 * nb;
                    const float* W = (up ? a.in[opaque_int(I_EU)] : a.in[opaque_int(I_EG)]) + ((size_t)l * NEXP + e) * D * DEXP;
                    tr_item4(W, DEXP, 64 * kb, n0, (bf16*)(ws + WS_WEXP + WEXP_GU) + (size_t)e * 1024 * 1024, 1024, 256 * (n0 >> 7) + (n0 & 127) + 128 * up, 64 * kb, scr, lane);
                } else { const int r = it - 2 * I_G, e = r >> 8, q = r & 255, kb = q >> 5, nb = q & 31;
                    const float* W = a.in[opaque_int(I_ED)] + ((size_t)l * NEXP + e) * DEXP * D;
                    tr_item4(W, D, 64 * kb, 32 * nb, (bf16*)(ws + WS_WEXP + WEXP_D) + (size_t)e * 1024 * 512, 512, 32 * nb, 64 * kb, scr, lane); }
            }
            __syncthreads();
        }
        if (IN(PH_INPROJ)) { PHASE_IDS;
            unsigned char* ws = opaque_ptr(a.ws); unsigned char* wl = ws + WS_WSMALL + (size_t)l * WL_STRIDE;
            pg8::DenseOrder S; S.init(a.out, wl + WL_WIN, NTOK, NPROJ, D, G, bx);
            pg8::EpiProj E{(bf16*)(ws + WS_PMIX), (bf16*)(ws + WS_PGATE), (float*)(ws + WS_MISC), a.in[opaque_int(I_GB)] + (size_t)l * 3 * D};
            pg8::gemm_phase<pg8::EpiProj, pg8::DenseOrder, true, true>(lds + RING_OFF, D, S, E, wave0);
        }
        if (IN(PH_INPROJ)) SEAM();
        if (IN(PH_PREP)) { PHASE_IDS;
            unsigned char* ws = opaque_ptr(a.ws);
            const bf16* pmix = (const bf16*)(ws + WS_PMIX);
            { const float* mu = a.in[I_MU] + (size_t)l * RWKV_COLS + 1536 + 4 * lane; const f32x4 m4 = *(const f32x4*)mu;
              bf16* lin = (bf16*)(ws + WS_LIN);
              for (int tokp = gw; tokp < NTOK; tokp += 4 * NGW) {
                  unsigned long long cw[4], pw[4];
#pragma unroll
                  for (int u = 0; u < 4; ++u) { const int tok = (tokp + u * NGW < NTOK) ? tokp + u * NGW : tokp;
                      cw[u] = *(const unsigned long long*)(pmix + (size_t)tok * PMIX_LD + C_RW + 1536 + 4 * lane);
                      pw[u] = 0ull; if (tok % SEQ) pw[u] = *(const unsigned long long*)(pmix + (size_t)(tok - 1) * PMIX_LD + C_RW + 1536 + 4 * lane); }
#pragma unroll
                  for (int u = 0; u < 4; ++u) { const int tok = tokp + u * NGW; if (tok >= NTOK) break;
                      float c[4], q[4];
                      c[0] = __uint_as_float((unsigned)cw[u] << 16); c[1] = __uint_as_float((unsigned)cw[u] & 0xffff0000u); c[2] = __uint_as_float((unsigned)(cw[u] >> 32) << 16); c[3] = __uint_as_float((unsigned)(cw[u] >> 32) & 0xffff0000u);
                      q[0] = __uint_as_float((unsigned)pw[u] << 16); q[1] = __uint_as_float((unsigned)pw[u] & 0xffff0000u); q[2] = __uint_as_float((unsigned)(pw[u] >> 32) << 16); q[3] = __uint_as_float((unsigned)(pw[u] >> 32) & 0xffff0000u);
#pragma unroll
                      for (int i = 0; i < 4; ++i) { float x = c[i] + m4[i] * (q[i] - c[i]); if (lane < 16) x = tanhf_(x); else if (lane >= 32) x = sigmoidf_(x); c[i] = x; }
                      *(unsigned long long*)(lin + (size_t)tok * 256 + 4 * lane) = (unsigned long long)pk2(c[0], c[1]) | ((unsigned long long)pk2(c[2], c[3]) << 32); }
              } }
            if (gw < BATCH * FOX_HEADS) {
                const int b = gw >> 3, h = gw & 7; const float fb = a.in[I_FB][l * FOX_HEADS + h];
                const float* misc = (const float*)(ws + WS_MISC); float* ck = (float*)(ws + WS_CK) + (size_t)gw * SEQ;
                float carry = 0.f;
#pragma unroll 4
                for (int s0 = 0; s0 < SEQ; s0 += 64) {
                    float v = -softplusf_(-(misc[((size_t)b * SEQ + s0 + lane) * 32 + h] + fb)) * 1.4426950408889634f;
                    v = wave_scan(v) + carry; ck[s0 + lane] = v; carry = __builtin_bit_cast(float, __builtin_amdgcn_readlane(__builtin_bit_cast(int, v), 63));
                }
            }
            for (int task = gw; task < BATCH * 16 * 16; task += NGW) {
                const int c = task & 15, h = (task >> 4) & 15, bb = task >> 8;
                const float A = -__expf(a.in[opaque_int(I_ALOG)][l * SSM_HEADS + h]), dtb = a.in[opaque_int(I_DTB)][l * SSM_HEADS + h];
                const float* misc = (const float*)(ws + WS_MISC); const size_t tok0 = (size_t)bb * SEQ + c * 128;
                const float d0 = softplusf_(misc[(tok0 + 2 * lane) * 32 + 8 + h] + dtb), d1 = softplusf_(misc[(tok0 + 2 * lane + 1) * 32 + 8 + h] + dtb);
                const float a0 = d0 * A, a1 = d1 * A; const float sc = wave_scan(a0 + a1);
                *(f32x4*)((float*)(ws + WS_DTCS) + (((size_t)(bb * 16 + h) * SEQ + c * 128 + 2 * lane) * 2)) = (f32x4){d0, sc - a1, d1, sc};
            }
            { int* rowtok = (int*)(ws + WS_ROWTOK); for (int idx = gw * 64 + lane; idx < MPAD; idx += NGW * 64) rowtok[idx] = 0; }
            for (int it = gw; it < BATCH * 32 * 3; it += NGW) {
                const int bb = it / 96, r = it % 96, c = r / 3, k = r % 3;
                if (c == 0) continue;
                const bf16* src = (const bf16*)(ws + WS_PMIX) + ((size_t)bb * SEQ + c * 64 - 3 + k) * PMIX_LD + C_SX;
                bf16* dst = (bf16*)(ws + WS_HALO) + (size_t)it * SSM_CONV_DIM;
#pragma unroll
                for (int j = 0; j < 3; ++j) *((v4u*)dst + lane + 64 * j) = *((const v4u*)src + lane + 64 * j);
            }
        }
        if (IN(PH_PREP)) SEAM();
        if (IN(PH_LORA)) { PHASE_IDS;
            unsigned char* ws = opaque_ptr(a.ws); unsigned char* wl = ws + WS_WSMALL + (size_t)l * WL_STRIDE;
            pg8::DenseOrder S; S.init(ws + WS_LIN, wl + WL_LORA, NTOK, 1536, 256, G, bx);
            pg8::EpiBf16<1536> E{(bf16*)(ws + WS_LOUT)};
            pg8::gemm_phase<pg8::EpiBf16<1536>, pg8::DenseOrder, true, true>(lds + RING_OFF, 256, S, E, wave0);
            {   const int lane = lane_id(), tid = wave * 64 + lane;
                const float* cwp = a.in[opaque_int(I_CW)] + (size_t)l * 4 * SSM_CONV_DIM; const float* cbp = a.in[opaque_int(I_CB)] + (size_t)l * SSM_CONV_DIM;
                for (int task = vcu * 384 + tid; tid < 384 && task < BATCH * 16 * 384; task += G * 384) {
                    const int oc = task % 192, r = task / 192, c = r & 31, bb = r >> 5;
                    float cw[4][8], cb[8];
#pragma unroll
                    for (int i = 0; i < 8; ++i) { cb[i] = cbp[8 * oc + i];
#pragma unroll
                        for (int w = 0; w < 4; ++w) cw[w][i] = cwp[w * SSM_CONV_DIM + 8 * oc + i]; }
                    bf16* rowp = (bf16*)(ws + WS_PMIX) + ((size_t)bb * SEQ + c * 64) * PMIX_LD + C_SX + 8 * oc;
                    float w1[8], w2[8], w3[8];
                    if (c == 0) {
#pragma unroll
                        for (int i = 0; i < 8; ++i) { w1[i] = 0.f; w2[i] = 0.f; w3[i] = 0.f; } }
                    else { const bf16* hp = (const bf16*)(ws + WS_HALO) + (size_t)((bb * 32 + c) * 3) * SSM_CONV_DIM + 8 * oc;
                        pg8::unpack8(*(const pg8::u32x4*)hp, w1); pg8::unpack8(*(const pg8::u32x4*)(hp + SSM_CONV_DIM), w2); pg8::unpack8(*(const pg8::u32x4*)(hp + 2 * SSM_CONV_DIM), w3); }
                    pg8::u32x4 raw[8], nxt[8];
#pragma unroll
                    for (int j = 0; j < 8; ++j) raw[j] = *(const pg8::u32x4*)(rowp + (size_t)j * PMIX_LD);
#pragma unroll 1
                    for (int t0 = 0; t0 < 64; t0 += 8) {
                        { const int tn = (t0 + 8 < 64) ? t0 + 8 : t0;
#pragma unroll
                          for (int j = 0; j < 8; ++j) nxt[j] = *(const pg8::u32x4*)(rowp + (size_t)(tn + j) * PMIX_LD); }
#pragma unroll
                        for (int j = 0; j < 8; ++j) {
                            float w0[8], o8[8];
#pragma unroll
                            for (int i = 0; i < 8; ++i) { w0[i] = w1[i]; w1[i] = w2[i]; w2[i] = w3[i]; }
                            pg8::unpack8(raw[j], w3);
#pragma unroll
                            for (int i = 0; i < 8; ++i) o8[i] = siluf_(cb[i] + cw[0][i] * w0[i] + cw[1][i] * w1[i] + cw[2][i] * w2[i] + cw[3][i] * w3[i]);
                            pg8::u32x4 pk; pk.x = pk2(o8[0], o8[1]); pk.y = pk2(o8[2], o8[3]); pk.z = pk2(o8[4], o8[5]); pk.w = pk2(o8[6], o8[7]);
                            *(pg8::u32x4*)(rowp + (size_t)(t0 + j) * PMIX_LD) = pk;
                        }
#pragma unroll
                        for (int j = 0; j < 8; ++j) raw[j] = nxt[j];
                    }
                }
            }
        }
        if (IN(PH_LORA)) SEAM();
        if (IN(PH_MIX)) { PHASE_IDS;
            unsigned char* ws = opaque_ptr(a.ws);
            unsigned* qhead = (unsigned*)(ws + WS_CTL) + CW_QUEUE + 64 * l;
            LAS int* qslot = (LAS int*)(lds + LDSCTL_OFF + 64);
            for (;;) {
                __syncthreads();
                if (tid == 0) qslot[0] = (int)atomicAdd(qhead, 1u);
                __syncthreads();
                const int unit = __builtin_amdgcn_readfirstlane(qslot[0]);
                if (unit >= 128 + 1024 + 256) break;
                if (unit < 128) {
                    constexpr int T = 32, BUF = 8 * T * 64;
                    const int wave = opaque_int(wave0), lane = lane_id();
                    const int b = unit >> 3, h = unit & 7;
                    LAS float* L0 = (LAS float*)lds;
                    const bf16* pmix = (const bf16*)(ws + WS_PMIX); const bf16* lout = (const bf16*)(ws + WS_LOUT); bf16* o_r = (bf16*)(ws + WS_OR);
                    __syncthreads();
                    if (wave >= 4) {
                        const int a4 = wave - 4, c4 = (lane & 15) * 4, ch = h * 64 + c4, tq = lane >> 4;
                        const f32x4 mu_r = *(const f32x4*)(a.in[opaque_int(I_MU)] + (size_t)l * RWKV_COLS + ch), mu_k = *(const f32x4*)(a.in[opaque_int(I_MU)] + (size_t)l * RWKV_COLS + 512 + ch), mu_v = *(const f32x4*)(a.in[opaque_int(I_MU)] + (size_t)l * RWKV_COLS + 1024 + ch);
                        const f32x4 w0 = *(const f32x4*)(a.in[opaque_int(I_W0)] + l * 512 + ch), a0 = *(const f32x4*)(a.in[opaque_int(I_A0)] + l * 512 + ch), kkw = *(const f32x4*)(a.in[opaque_int(I_KK)] + l * 512 + ch), kaw = *(const f32x4*)(a.in[opaque_int(I_KA)] + l * 512 + ch);
                        const f32x4 rk4 = *(const f32x4*)(a.in[opaque_int(I_RK)] + l * 512 + ch), gg4 = *(const f32x4*)(a.in[opaque_int(I_GNG)] + l * 512 + ch), gb4 = *(const f32x4*)(a.in[opaque_int(I_GNB)] + l * 512 + ch);
                        auto up4 = [](unsigned long long w, float* f) { f[0] = __uint_as_float((unsigned)w << 16); f[1] = __uint_as_float((unsigned)w & 0xffff0000u); f[2] = __uint_as_float((unsigned)(w >> 32) << 16); f[3] = __uint_as_float((unsigned)(w >> 32) & 0xffff0000u); };
                        unsigned long long R[2][9];
                        auto dload = [&](int c0) {
#pragma unroll
                            for (int u = 0; u < 2; ++u) { const int tt = 16 * u + 4 * a4 + tq; const size_t tok = (size_t)b * SEQ + c0 + tt; const bf16* pc = pmix + tok * PMIX_LD + C_RW + ch; const bf16* lo = lout + tok * 1536 + ch;
                                R[u][0] = *(const unsigned long long*)pc; R[u][1] = *(const unsigned long long*)(pc + 512); R[u][2] = *(const unsigned long long*)(pc + 1024);
                                if (c0 + tt > 0) { R[u][3] = *(const unsigned long long*)(pc - PMIX_LD); R[u][4] = *(const unsigned long long*)(pc - PMIX_LD + 512); R[u][5] = *(const unsigned long long*)(pc - PMIX_LD + 1024); } else { R[u][3] = 0ull; R[u][4] = 0ull; R[u][5] = 0ull; }
                                R[u][6] = *(const unsigned long long*)lo; R[u][7] = *(const unsigned long long*)(lo + 512); R[u][8] = *(const unsigned long long*)(lo + 1024); }
                        };
                        auto dcomp = [&](LAS float* Lb_) {
                            LAS float* Lr = Lb_; LAS float* Lw = Lr + T * 64; LAS float* Lk = Lw + T * 64; LAS float* Lv = Lk + T * 64; LAS float* La = Lv + T * 64; LAS float* Lbb = La + T * 64; LAS float* Lg = Lbb + T * 64;
#pragma unroll
                            for (int u = 0; u < 2; ++u) { const int tt = 16 * u + 4 * a4 + tq;
                                float cr[4], ck_[4], cv[4], pr[4], pk[4], pv[4], lw[4], la[4], lg[4];
                                up4(R[u][0], cr); up4(R[u][1], ck_); up4(R[u][2], cv); up4(R[u][3], pr); up4(R[u][4], pk); up4(R[u][5], pv); up4(R[u][6], lw); up4(R[u][7], la); up4(R[u][8], lg);
                                float kk[4], av[4], ss = 0.f;
#pragma unroll
                                for (int i = 0; i < 4; ++i) {
                                    cr[i] += mu_r[i] * (pr[i] - cr[i]); ck_[i] += mu_k[i] * (pk[i] - ck_[i]); cv[i] += mu_v[i] * (pv[i] - cv[i]);
                                    lw[i] = __expf(-0.6065306597126334f * sigmoidf_(w0[i] + lw[i]));
                                    av[i] = sigmoidf_(a0[i] + la[i]);
                                    kk[i] = ck_[i] * kkw[i]; ss += kk[i] * kk[i];
                                }
                                ss = sum16(ss);
                                const float inv = 1.f / fmaxf(sqrtf(ss), 1e-12f);
                                f32x4 o_r4, o_w4, o_k4, o_v4, o_a4, o_b4, o_g4;
#pragma unroll
                                for (int i = 0; i < 4; ++i) { const float kkn = kk[i] * inv; o_r4[i] = cr[i]; o_w4[i] = lw[i]; o_k4[i] = ck_[i] * (1.f + (av[i] - 1.f) * kaw[i]); o_v4[i] = cv[i]; o_a4[i] = -kkn; o_b4[i] = kkn * av[i]; o_g4[i] = lg[i]; }
                                *(LAS f32x4*)(Lr + tt * 64 + c4) = o_r4; *(LAS f32x4*)(Lw + tt * 64 + c4) = o_w4; *(LAS f32x4*)(Lk + tt * 64 + c4) = o_k4; *(LAS f32x4*)(Lv + tt * 64 + c4) = o_v4;
                                *(LAS f32x4*)(La + tt * 64 + c4) = o_a4; *(LAS f32x4*)(Lbb + tt * 64 + c4) = o_b4; *(LAS f32x4*)(Lg + tt * 64 + c4) = o_g4; }
                        };
                        auto post = [&](int c0, LAS float* Lb_) {
                            LAS float* Lr = Lb_; LAS float* Lk = Lr + 2 * T * 64; LAS float* Lv = Lk + T * 64; LAS float* Lg = Lr + 6 * T * 64; LAS float* Ly = Lg + T * 64;
#pragma unroll
                            for (int u = 0; u < 2; ++u) { const int tt = 16 * u + 4 * a4 + tq; const size_t tok = (size_t)b * SEQ + c0 + tt;
                                const f32x4 y4 = *(const LAS f32x4*)(Ly + tt * 64 + c4), r4 = *(const LAS f32x4*)(Lr + tt * 64 + c4), k4 = *(const LAS f32x4*)(Lk + tt * 64 + c4), v4 = *(const LAS f32x4*)(Lv + tt * 64 + c4), g4 = *(const LAS f32x4*)(Lg + tt * 64 + c4);
                                const float mean = sum16((y4[0] + y4[1]) + (y4[2] + y4[3])) * (1.f / 64.f);
                                float d[4], q = 0.f, pb = 0.f;
#pragma unroll
                                for (int i = 0; i < 4; ++i) { d[i] = y4[i] - mean; q += d[i] * d[i]; pb += r4[i] * k4[i] * rk4[i]; }
                                const float rs = rsqrtf(sum16(q) * (1.f / 64.f) + RWKV_GN_EPS);
                                const float bonus = sum16(pb);
                                float o[4];
#pragma unroll
                                for (int i = 0; i < 4; ++i) o[i] = (d[i] * rs * gg4[i] + gb4[i] + bonus * v4[i]) * g4[i];
                                *(unsigned long long*)(o_r + tok * 512 + ch) = (unsigned long long)pk2(o[0], o[1]) | ((unsigned long long)pk2(o[2], o[3]) << 32);
                            }
                        };
                        dload(0); dcomp(L0);
                        LBAR();
                        for (int c = 0; c < SEQ / T; ++c) {
                            if (c + 1 < SEQ / T) dload((c + 1) * T);
                            if (c > 0) post((c - 1) * T, L0 + ((c - 1) & 1) * BUF);
                            if (c + 1 < SEQ / T) dcomp(L0 + ((c + 1) & 1) * BUF);
                            LBAR();
                        }
                        post(SEQ - T, L0 + ((SEQ / T - 1) & 1) * BUF);
                    } else {
                        const int rg = lane >> 3, seg = lane & 7, row0 = 16 * wave + 2 * rg;
                        typedef float f32x2 __attribute__((ext_vector_type(2)));
                        f32x2 S0[4], S1[4];
#pragma unroll
                        for (int j = 0; j < 4; ++j) { S0[j] = (f32x2){0.f, 0.f}; S1[j] = (f32x2){0.f, 0.f}; }
                        LBAR();
                        __builtin_amdgcn_s_setprio(3);
                        for (int c = 0; c < SEQ / T; ++c) {
                            LAS float* Lr = L0 + (c & 1) * BUF; LAS float* Lw = Lr + T * 64; LAS float* Lk = Lw + T * 64; LAS float* Lv = Lk + T * 64; LAS float* La = Lv + T * 64; LAS float* Lbb = La + T * 64; LAS float* Ly = Lr + 7 * T * 64;
#define RW_LOAD(P, t) do { \
                                { const f32x4 x0 = *(const LAS f32x4*)(Lw + (t) * 64 + seg * 8), x1 = *(const LAS f32x4*)(Lw + (t) * 64 + seg * 8 + 4); P##w[0] = (f32x2){x0[0], x0[1]}; P##w[1] = (f32x2){x0[2], x0[3]}; P##w[2] = (f32x2){x1[0], x1[1]}; P##w[3] = (f32x2){x1[2], x1[3]}; } \
                                { const f32x4 x0 = *(const LAS f32x4*)(La + (t) * 64 + seg * 8), x1 = *(const LAS f32x4*)(La + (t) * 64 + seg * 8 + 4); P##a[0] = (f32x2){x0[0], x0[1]}; P##a[1] = (f32x2){x0[2], x0[3]}; P##a[2] = (f32x2){x1[0], x1[1]}; P##a[3] = (f32x2){x1[2], x1[3]}; } \
                                { const f32x4 x0 = *(const LAS f32x4*)(Lbb + (t) * 64 + seg * 8), x1 = *(const LAS f32x4*)(Lbb + (t) * 64 + seg * 8 + 4); P##b[0] = (f32x2){x0[0], x0[1]}; P##b[1] = (f32x2){x0[2], x0[3]}; P##b[2] = (f32x2){x1[0], x1[1]}; P##b[3] = (f32x2){x1[2], x1[3]}; } \
                                { const f32x4 x0 = *(const LAS f32x4*)(Lk + (t) * 64 + seg * 8), x1 = *(const LAS f32x4*)(Lk + (t) * 64 + seg * 8 + 4); P##k[0] = (f32x2){x0[0], x0[1]}; P##k[1] = (f32x2){x0[2], x0[3]}; P##k[2] = (f32x2){x1[0], x1[1]}; P##k[3] = (f32x2){x1[2], x1[3]}; } \
                                { const f32x4 x0 = *(const LAS f32x4*)(Lr + (t) * 64 + seg * 8), x1 = *(const LAS f32x4*)(Lr + (t) * 64 + seg * 8 + 4); P##r[0] = (f32x2){x0[0], x0[1]}; P##r[1] = (f32x2){x0[2], x0[3]}; P##r[2] = (f32x2){x1[0], x1[1]}; P##r[3] = (f32x2){x1[2], x1[3]}; } \
                                P##v0 = Lv[(t) * 64 + row0]; P##v1 = Lv[(t) * 64 + row0 + 1]; } while (0)
#define RW_STEP(P, t) do { \
                                f32x2 d0 = S0[0] * P##a[0], d1 = S1[0] * P##a[0]; \
                                _Pragma("unroll") for (int j = 1; j < 4; ++j) { d0 = S0[j] * P##a[j] + d0; d1 = S1[j] * P##a[j] + d1; } \
                                const float sa0 = sum8(d0.x + d0.y), sa1 = sum8(d1.x + d1.y); \
                                const f32x2 sa0v = (f32x2){sa0, sa0}, sa1v = (f32x2){sa1, sa1}, v0v = (f32x2){P##v0, P##v0}, v1v = (f32x2){P##v1, P##v1}; \
                                f32x2 y0 = (f32x2){0.f, 0.f}, y1 = (f32x2){0.f, 0.f}; \
                                _Pragma("unroll") for (int j = 0; j < 4; ++j) { \
                                    S0[j] = S0[j] * P##w[j] + (sa0v * P##b[j] + v0v * P##k[j]); \
                                    S1[j] = S1[j] * P##w[j] + (sa1v * P##b[j] + v1v * P##k[j]); \
                                    y0 = S0[j] * P##r[j] + y0; y1 = S1[j] * P##r[j] + y1; } \
                                float yy0 = sum8(y0.x + y0.y), yy1 = sum8(y1.x + y1.y); asm("" : "+v"(yy0), "+v"(yy1));     \
                                if (seg == 0) { Ly[(t) * 64 + row0] = yy0; Ly[(t) * 64 + row0 + 1] = yy1; } } while (0)
                            f32x2 Aw[4], Aa[4], Ab[4], Ak[4], Ar[4], Bw[4], Ba[4], Bb[4], Bk[4], Br[4]; float Av0, Av1, Bv0, Bv1;
                            RW_LOAD(A, 0);
                            for (int t = 0; t < T; t += 2) {
                                RW_LOAD(B, t + 1);
                                RW_STEP(A, t);
                                if (t + 2 < T) RW_LOAD(A, t + 2);
                                RW_STEP(B, t + 1);
                            }
#undef RW_LOAD
#undef RW_STEP
                            LBAR();
                        }
                        __builtin_amdgcn_s_setprio(0);
                    }
                } else if (unit >= 128 + 256) {
                    const int u2 = unit - 384, qb = 7 - (u2 >> 7), bh = u2 & 127;
                    attn_body::attn_unit<8>(bh >> 3, bh & 7, qb, (const attn_body::bf16*)(ws + WS_PMIX) + C_FQ, (const attn_body::bf16*)(ws + WS_PMIX) + C_FK, (const attn_body::bf16*)(ws + WS_PMIX) + C_FV,
                                            (attn_body::bf16*)(ws + WS_OF), (const float*)(ws + WS_CK) + (size_t)bh * SEQ, (char*)lds_raw, wave0);
                } else {
                    constexpr int LD = 136, XLD = 72;
                    typedef short bf16x8 __attribute__((ext_vector_type(8))); typedef short s16x4 __attribute__((ext_vector_type(4))); typedef float f32x2_t __attribute__((ext_vector_type(2)));
                    const int wave = opaque_int(wave0), lane = lane_id(), tid = wave * 64 + lane;
                    const int u3 = unit - 128, b = u3 >> 4, h = u3 & 15, g = h >> 3;
                    LAS bf16* Cm = (LAS bf16*)lds; LAS bf16* Bm = Cm + 128 * LD; LAS bf16* Xm = Bm + 128 * LD; LAS bf16* Xw = Xm + 128 * XLD; LAS bf16* St = Xw + 128 * XLD;
                    LAS float* Fd = (LAS float*)(St + 64 * LD); LAS float* Fc = Fd + 128;
                    const bf16* pmix = (const bf16*)(ws + WS_PMIX);
                    bf16* om = (bf16*)(ws + (g ? WS_OM1 : WS_OM0)); float* ssq = (float*)(ws + WS_SSQ);
                    const float* dtcs = (const float*)(ws + WS_DTCS) + (size_t)(b * 16 + h) * SEQ * 2;
                    const float Dh = a.in[opaque_int(I_DSK)][l * SSM_HEADS + h];
                    f32x4 accS[4];
#pragma unroll
                    for (int nt = 0; nt < 4; ++nt) accS[nt] = (f32x4){0.f, 0.f, 0.f, 0.f};
                    __syncthreads();
                    for (int i = tid; i < 64 * LD / 2; i += NWAVES * 64) ((LAS unsigned*)St)[i] = 0u;
                    pg8::u32x4 tb[8], tx[2]; f32x2_t tdc = (f32x2_t){0.f, 0.f};
                    auto request = [&](int c0) { const size_t tok0 = (size_t)b * SEQ + c0; const int o_bc = tid & 31;
#pragma unroll
                        for (int j = 0; j < 8; ++j) { const int ll = (tid >> 5) + 16 * j; tb[j] = *(const pg8::u32x4*)(pmix + (tok0 + ll) * PMIX_LD + C_SX + ((o_bc < 16) ? (1024 + g * 128 + 8 * o_bc) : (1280 + g * 128 + 8 * (o_bc - 16)))); }
#pragma unroll
                        for (int j = 0; j < 2; ++j) { const int ll = (tid >> 3) + 64 * j; tx[j] = *(const pg8::u32x4*)(pmix + (tok0 + ll) * PMIX_LD + C_SX + h * 64 + 8 * (tid & 7)); }
                        if (tid < 128) tdc = *(const f32x2_t*)(dtcs + (size_t)(c0 + tid) * 2); };
                    request(0);
                    for (int c0 = 0; c0 < SEQ; c0 += 128) {
                        LBAR();
                        const int lane = lane_id(), tid = wave * 64 + lane, fr = lane & 15, fq = lane >> 4;
                        const size_t tok0 = (size_t)b * SEQ + c0;
                        { const int o_bc = tid & 31;
#pragma unroll
                          for (int j = 0; j < 8; ++j) { const int ll = (tid >> 5) + 16 * j; *(LAS pg8::u32x4*)((o_bc < 16 ? Bm : Cm) + ll * LD + 8 * (o_bc & 15)) = tb[j]; }
#pragma unroll
                          for (int j = 0; j < 2; ++j) { const int ll = (tid >> 3) + 64 * j; *(LAS pg8::u32x4*)(Xm + ll * XLD + 8 * (tid & 7)) = tx[j]; }
                          if (tid < 128) { Fd[tid] = tdc.x; Fc[tid] = tdc.y; } }
                        if (c0 + 128 < SEQ) request(c0 + 128);
                        unsigned long long zr[4];
#pragma unroll
                        for (int nt = 0; nt < 4; ++nt) zr[nt] = *(const unsigned long long*)(pmix + (tok0 + 16 * wave + fr) * PMIX_LD + C_SZ + h * 64 + 16 * nt + 4 * fq);
                        LBAR();
                        const float cs_last = Fc[127];
#pragma unroll
                        for (int jj = 0; jj < 2; ++jj) {
                            const int idx = tid + NWAVES * 64 * jj, ll = idx >> 3, ox = idx & 7; const float wgt = __expf(cs_last - Fc[ll]) * Fd[ll];
                            float x8[8]; pg8::unpack8(*(const LAS pg8::u32x4*)(Xm + ll * XLD + 8 * ox), x8);
                            pg8::u32x4 pk; pk.x = pk2(x8[0] * wgt, x8[1] * wgt); pk.y = pk2(x8[2] * wgt, x8[3] * wgt); pk.z = pk2(x8[4] * wgt, x8[5] * wgt); pk.w = pk2(x8[6] * wgt, x8[7] * wgt);
                            *(LAS pg8::u32x4*)(Xw + ll * XLD + 8 * ox) = pk;
                        }
                        const int sbp = (int)((0x31322010u >> (4 * wave)) & 3u), lq = (int)((0x8Bu >> wave) & 1u), d0 = 2 * sbp - 4 * lq;
                        const int m1 = 32 * sbp, n1 = 64 * lq, m4 = 16 * wave;
                        f32x4 acc1[2][4];
#pragma unroll
                        for (int mt = 0; mt < 2; ++mt)
#pragma unroll
                            for (int nt = 0; nt < 4; ++nt) acc1[mt][nt] = (f32x4){0.f, 0.f, 0.f, 0.f};
                        if (d0 <= 3) {
#pragma unroll
                        for (int k0 = 0; k0 < 128; k0 += 32) {
                            bf16x8 af[2], bfv[4];
#pragma unroll
                            for (int mt = 0; mt < 2; ++mt) af[mt] = *(const LAS bf16x8*)(Bm + (m1 + 16 * mt + fr) * LD + k0 + 8 * fq);
#pragma unroll
                            for (int nt = 0; nt < 4; ++nt) bfv[nt] = *(const LAS bf16x8*)(Cm + (n1 + 16 * nt + fr) * LD + k0 + 8 * fq);
#pragma unroll
                            for (int mt = 0; mt < 2; ++mt)
#pragma unroll
                                for (int nt = 0; nt < 4; ++nt) if (nt >= d0 + mt) acc1[mt][nt] = __builtin_amdgcn_mfma_f32_16x16x32_bf16(af[mt], bfv[nt], acc1[mt][nt], 0, 0, 0);
                        }
                        }
                        f32x4 acc2[4];
#pragma unroll
                        for (int nt = 0; nt < 4; ++nt) acc2[nt] = (f32x4){0.f, 0.f, 0.f, 0.f};
#pragma unroll
                        for (int k0 = 0; k0 < 128; k0 += 32) {
                            const bf16x8 af = *(const LAS bf16x8*)(Cm + (m4 + fr) * LD + k0 + 8 * fq);
#pragma unroll
                            for (int nt = 0; nt < 4; ++nt) { const bf16x8 bfv = *(const LAS bf16x8*)(St + (16 * nt + fr) * LD + k0 + 8 * fq); acc2[nt] = __builtin_amdgcn_mfma_f32_16x16x32_bf16(bfv, af, acc2[nt], 0, 0, 0); }
                        }
                        LBAR();
                        if (d0 <= 4) {   float csl[4]; f32x4 css[2], dts[2];
#pragma unroll
                            for (int nt = 0; nt < 4; ++nt) csl[nt] = Fc[n1 + 16 * nt + fr];
#pragma unroll
                            for (int mt = 0; mt < 2; ++mt) { css[mt] = *(const LAS f32x4*)(Fc + m1 + 16 * mt + 4 * fq); dts[mt] = *(const LAS f32x4*)(Fd + m1 + 16 * mt + 4 * fq); }
#pragma unroll
                            for (int mt = 0; mt < 2; ++mt)
#pragma unroll
                                for (int nt = 0; nt < 4; ++nt) { const int ll = n1 + 16 * nt + fr, s0 = m1 + 16 * mt + 4 * fq;
                                    if (nt > d0 + mt) {
                                        float v[4];
#pragma unroll
                                        for (int r = 0; r < 4; ++r) v[r] = acc1[mt][nt][r] * __expf(csl[nt] - css[mt][r]) * dts[mt][r];
                                        *(LAS unsigned long long*)(Cm + ll * LD + s0) = (unsigned long long)pk2(v[0], v[1]) | ((unsigned long long)pk2(v[2], v[3]) << 32);
                                    } else if (nt == d0 + mt) {
                                        float v[4];
#pragma unroll
                                        for (int r = 0; r < 4; ++r) v[r] = (s0 + r <= ll) ? acc1[mt][nt][r] * __expf(csl[nt] - css[mt][r]) * dts[mt][r] + ((s0 + r == ll) ? Dh : 0.f) : 0.f;
                                        *(LAS unsigned long long*)(Cm + ll * LD + s0) = (unsigned long long)pk2(v[0], v[1]) | ((unsigned long long)pk2(v[2], v[3]) << 32);
                                    } else if (nt + 1 == d0 + mt) {
                                        *(LAS unsigned long long*)(Cm + ll * LD + s0) = 0ull;
                                    } }
                        }
                        LBAR();
                        const int q4 = (lane & 15) >> 2, p4 = lane & 3;
                        f32x4 acc3[4];
#pragma unroll
                        for (int nt = 0; nt < 4; ++nt) acc3[nt] = (f32x4){0.f, 0.f, 0.f, 0.f};
                        for (int k0 = 0; k0 < m4 + 16; k0 += 32) {
                            const bf16x8 af = *(const LAS bf16x8*)(Cm + (m4 + fr) * LD + k0 + 8 * fq);
#pragma unroll
                            for (int nt = 0; nt < 4; ++nt) {
                                const s16x4 lo = __builtin_bit_cast(s16x4, __builtin_amdgcn_ds_read_tr16_b64_v4i16((LAS s16x4*)(Xm + (k0 + 8 * fq + q4) * XLD + 16 * nt + 4 * p4)));
                                const s16x4 hi = __builtin_bit_cast(s16x4, __builtin_amdgcn_ds_read_tr16_b64_v4i16((LAS s16x4*)(Xm + (k0 + 8 * fq + 4 + q4) * XLD + 16 * nt + 4 * p4)));
                                const bf16x8 bfv = (bf16x8){lo[0], lo[1], lo[2], lo[3], hi[0], hi[1], hi[2], hi[3]};
                                acc3[nt] = __builtin_amdgcn_mfma_f32_16x16x32_bf16(bfv, af, acc3[nt], 0, 0, 0);
                            }
                        }
                        { const float dec = __expf(cs_last);
#pragma unroll
                          for (int nt = 0; nt < 4; ++nt) accS[nt] = accS[nt] * dec; }
#pragma unroll
                        for (int k0 = 0; k0 < 128; k0 += 32) {
                            const s16x4 alo = __builtin_bit_cast(s16x4, __builtin_amdgcn_ds_read_tr16_b64_v4i16((LAS s16x4*)(Bm + (k0 + 8 * fq + q4) * LD + m4 + 4 * p4)));
                            const s16x4 ahi = __builtin_bit_cast(s16x4, __builtin_amdgcn_ds_read_tr16_b64_v4i16((LAS s16x4*)(Bm + (k0 + 8 * fq + 4 + q4) * LD + m4 + 4 * p4)));
                            const bf16x8 af = (bf16x8){alo[0], alo[1], alo[2], alo[3], ahi[0], ahi[1], ahi[2], ahi[3]};
#pragma unroll
                            for (int nt = 0; nt < 4; ++nt) {
                                const s16x4 lo = __builtin_bit_cast(s16x4, __builtin_amdgcn_ds_read_tr16_b64_v4i16((LAS s16x4*)(Xw + (k0 + 8 * fq + q4) * XLD + 16 * nt + 4 * p4)));
                                const s16x4 hi = __builtin_bit_cast(s16x4, __builtin_amdgcn_ds_read_tr16_b64_v4i16((LAS s16x4*)(Xw + (k0 + 8 * fq + 4 + q4) * XLD + 16 * nt + 4 * p4)));
                                const bf16x8 bfv = (bf16x8){lo[0], lo[1], lo[2], lo[3], hi[0], hi[1], hi[2], hi[3]};
                                accS[nt] = __builtin_amdgcn_mfma_f32_16x16x32_bf16(af, bfv, accS[nt], 0, 0, 0);
                            }
                        }
                        {   const int ll = m4 + fr; const size_t tok = tok0 + ll; const float ecs = __expf(Fc[ll]);
                            float s2 = 0.f;
#pragma unroll
                            for (int nt = 0; nt < 4; ++nt) {
                                const float z4[4] = {__uint_as_float((unsigned)zr[nt] << 16), __uint_as_float((unsigned)zr[nt] & 0xffff0000u), __uint_as_float((unsigned)(zr[nt] >> 32) << 16), __uint_as_float((unsigned)(zr[nt] >> 32) & 0xffff0000u)};
                                float v[4];
#pragma unroll
                                for (int r = 0; r < 4; ++r) { const float y = acc3[nt][r] + ecs * acc2[nt][r]; v[r] = y * siluf_(z4[r]); s2 += v[r] * v[r]; }
                                *(unsigned long long*)(om + tok * 512 + (h & 7) * 64 + 16 * nt + 4 * fq) = (unsigned long long)pk2(v[0], v[1]) | ((unsigned long long)pk2(v[2], v[3]) << 32);
                            }
                            s2 += shx(s2, 16, lane); s2 += shx(s2, 32, lane);
                            if (fq == 0) ssq[tok * 16 + h] = s2;
                        }
#pragma unroll
                        for (int nt = 0; nt < 4; ++nt) *(LAS unsigned long long*)(St + (16 * nt + fr) * LD + m4 + 4 * fq) = (unsigned long long)pk2(accS[nt][0], accS[nt][1]) | ((unsigned long long)pk2(accS[nt][2], accS[nt][3]) << 32);
                    }
                }
            }
        }
        if (IN(PH_MIX)) SEAM();
        if (IN(PH_MERGE)) { PHASE_IDS;
            unsigned char* ws = opaque_ptr(a.ws); unsigned char* wl = ws + WS_WSMALL + (size_t)l * WL_STRIDE;
            pg8::MergeOrder S; S.tm.init(NTOK, D, G, bx); S.tstep = (size_t)256 * 512 * 2; S.segA = 32 * MiB; S.segB = MiB;
            S.A = (const char*)(ws + WS_OR); S.Bt = (const char*)(wl + WL_BR);
            pg8::EpiMerge E{(const bf16*)(ws + WS_PGATE), (bf16*)(ws + WS_MERGED), (const float*)(ws + WS_SSQ)};
            pg8::gemm_phase<pg8::EpiMerge, pg8::MergeOrder, true, true>(lds + RING_OFF, 512, S, E, wave0);
        }
        if (IN(PH_MERGE)) SEAM();
        if (IN(PH_WOUT)) { PHASE_IDS;
            unsigned char* ws = opaque_ptr(a.ws); unsigned char* wl = ws + WS_WSMALL + (size_t)l * WL_STRIDE;
            pg8::DenseOrder S; S.init(ws + WS_MERGED, wl + WL_WOUT, NTOK, D, D, G, bx);
            pg8::EpiRes E{(const bf16*)a.out, (bf16*)(ws + WS_X1), ALPHA};
            pg8::gemm_phase<pg8::EpiRes, pg8::DenseOrder, true, true>(lds + RING_OFF, D, S, E, wave0);
        }
        if (IN(PH_WOUT)) SEAM();
        if (IN(PH_LN1)) { PHASE_IDS;
            unsigned char* ws = opaque_ptr(a.ws);
            LAS float* WT = (LAS float*)lds;
            { const float* rw = a.in[opaque_int(I_RW)];
              f32x4 rv[16];
#pragma unroll
              for (int i = 0; i < 16; ++i) rv[i] = *(const f32x4*)(rw + 4 * (tid + 512 * i));
#pragma unroll
              for (int i = 0; i < 16; ++i) { const int q = tid + 512 * i, d = q >> 3, e0 = (q & 7) * 4; LAS float* wp = WT + e0 * ROUTER_LD + d;
                  wp[0] = rv[i].x; wp[ROUTER_LD] = rv[i].y; wp[2 * ROUTER_LD] = rv[i].z; wp[3 * ROUTER_LD] = rv[i].w; } }
            __syncthreads();
            const bf16* X1 = (const bf16*)(ws + WS_X1); bf16* XBp = (bf16*)(ws + WS_XB);
            float* gatew = (float*)(ws + WS_GATEW); int* pos = (int*)(ws + WS_POS);
            unsigned* cnt = (unsigned*)(ws + WS_CTL) + CW_CNT + 1024 * l;
            const float* lg = a.in[opaque_int(I_L1G)] + (size_t)l * D; const float* lb = a.in[opaque_int(I_L1B)] + (size_t)l * D; const float* rbias = a.in[opaque_int(I_RB)];
            int me0 = 0, me1 = 0, kt = 0, tokb = gw; float mw0 = 1.f, mw1 = 1.f;
#define LN1_FLUSH() do { if (lane < kt) { const int tk_ = tokb + lane * NGW; const float inv_ = 1.f / (mw0 + mw1); \
                gatew[(size_t)tk_ * 2] = mw0 * inv_; gatew[(size_t)tk_ * 2 + 1] = mw1 * inv_; \
                const unsigned s0_ = atomicAdd(&cnt[me0 * CNT_STRIDE], 1u), s1_ = atomicAdd(&cnt[me1 * CNT_STRIDE], 1u); \
                pos[(size_t)tk_ * 2] = (int)(((unsigned)me0 << 16) | s0_); pos[(size_t)tk_ * 2 + 1] = (int)(((unsigned)me1 << 16) | s1_); } } while (0)
            for (int tokp = gw; tokp < NTOK; tokp += 2 * NGW, kt += 2) {
                if (kt == 64) { LN1_FLUSH(); kt = 0; tokb = tokp; }
                const bool two = tokp + NGW < NTOK;
                f32x4 v[2][4]; float sm[2];
#pragma unroll
                for (int u = 0; u < 2; ++u) { const int tok = (u && two) ? tokp + NGW : tokp; const bf16* row = X1 + (size_t)tok * D; sm[u] = 0.f;
#pragma unroll
                    for (int j = 0; j < 4; ++j) { const unsigned long long xw = *(const unsigned long long*)(row + 4 * lane + 256 * j);
                        v[u][j] = (f32x4){__uint_as_float((unsigned)xw << 16), __uint_as_float((unsigned)xw & 0xffff0000u), __uint_as_float((unsigned)(xw >> 32) << 16), __uint_as_float((unsigned)(xw >> 32) & 0xffff0000u)}; sm[u] += (v[u][j].x + v[u][j].y) + (v[u][j].z + v[u][j].w); } }
                float mean[2], s2[2], rstd[2];
#pragma unroll
                for (int u = 0; u < 2; ++u) mean[u] = wsum(sm[u], lane) * (1.f / D);
#pragma unroll
                for (int u = 0; u < 2; ++u) { s2[u] = 0.f;
#pragma unroll
                    for (int j = 0; j < 4; ++j) { v[u][j] = v[u][j] - mean[u]; s2[u] += (v[u][j].x * v[u][j].x + v[u][j].y * v[u][j].y) + (v[u][j].z * v[u][j].z + v[u][j].w * v[u][j].w); } }
#pragma unroll
                for (int u = 0; u < 2; ++u) rstd[u] = rsqrtf(wsum(s2[u], lane) * (1.f / D) + LN_EPS);
#pragma unroll
                for (int j = 0; j < 4; ++j) { const f32x4 g = *(const f32x4*)(lg + 4 * lane + 256 * j), b = *(const f32x4*)(lb + 4 * lane + 256 * j);
#pragma unroll
                    for (int u = 0; u < 2; ++u) v[u][j] = v[u][j] * rstd[u] * g + b; }
#pragma unroll
                for (int u = 0; u < 2; ++u) { if (u && !two) break; const int tok = tokp + u * NGW;
#pragma unroll
                    for (int j = 0; j < 4; ++j) {
                        *(unsigned long long*)(XBp + (size_t)tok * D + 4 * lane + 256 * j) = (unsigned long long)pk2(v[u][j].x, v[u][j].y) | ((unsigned long long)pk2(v[u][j].z, v[u][j].w) << 32); } }
                float p[2][32];
                typedef float f32x2r __attribute__((ext_vector_type(2)));
                f32x2r vv[4][4];
#pragma unroll
                for (int j = 0; j < 4; ++j) { vv[j][0] = (f32x2r){v[0][j].x, v[1][j].x}; vv[j][1] = (f32x2r){v[0][j].y, v[1][j].y}; vv[j][2] = (f32x2r){v[0][j].z, v[1][j].z}; vv[j][3] = (f32x2r){v[0][j].w, v[1][j].w}; }
#pragma unroll
                for (int e = 0; e < 32; ++e) { const LAS f32x4* w = (const LAS f32x4*)(WT + e * ROUTER_LD) + lane; f32x2r a01 = (f32x2r){0.f, 0.f}, b01 = (f32x2r){0.f, 0.f};
#pragma unroll
                    for (int j = 0; j < 4; ++j) { const f32x4 ww = w[64 * j];
                        a01 = vv[j][0] * (f32x2r){ww.x, ww.x} + a01; b01 = vv[j][1] * (f32x2r){ww.y, ww.y} + b01; a01 = vv[j][2] * (f32x2r){ww.z, ww.z} + a01; b01 = vv[j][3] * (f32x2r){ww.w, ww.w} + b01; }
                    a01 = a01 + b01; p[0][e] = a01.x; p[1][e] = a01.y; if ((e & 3) == 3) asm volatile("" ::: "memory"); }
#define RSTEP(N, B) _Pragma("unroll") for (int k = 0; k < (N) / 2; ++k) { _Pragma("unroll") for (int u = 0; u < 2; ++u) { const float send = (lane & (B)) ? p[u][k] : p[u][k + (N) / 2]; const float keep = (lane & (B)) ? p[u][k + (N) / 2] : p[u][k]; p[u][k] = keep + shx(send, (B), lane); } }
                RSTEP(32, 32) RSTEP(16, 16) RSTEP(8, 8) RSTEP(4, 4) RSTEP(2, 2)
#undef RSTEP
                const int e = lane & 31; const float rb_e = rbias[e]; const int gbase = lane & ~7;
#pragma unroll
                for (int u = 0; u < 2; ++u) {
                    p[u][0] += shx(p[u][0], 1, lane);
                    const float logit = shfl_f(p[u][0], 2 * (lane & 31));
                    const float aff = sigmoidf_(logit);
                    const float sel = aff + rb_e;
                    float t1 = -INFINITY, t2 = -INFINITY; int i1 = -1, i2 = -1;
#pragma unroll
                    for (int k = 0; k < 8; ++k) {
                        const float uu = shfl_f(sel, gbase + k); const int ui = (gbase + k) & 31;
                        if (uu > t1) { t2 = t1; i2 = i1; t1 = uu; i1 = ui; } else if (uu > t2) { t2 = uu; i2 = ui; }
                    }
                    const float gs = t1 + t2;
                    float best = -INFINITY; int bg = 0;
#pragma unroll
                    for (int g = 0; g < 4; ++g) { const float uu = shfl_f(gs, g * 8); if (uu > best) { best = uu; bg = g; } }
                    const int e0 = shfl_i(i1, bg * 8), e1 = shfl_i(i2, bg * 8);
                    const float w0 = shfl_f(aff, e0), w1 = shfl_f(aff, e1);
                    if (lane == kt + u && (u == 0 || two)) { me0 = e0; me1 = e1; mw0 = w0; mw1 = w1; }
                }
                if (!two) --kt;
            }
            LN1_FLUSH();
#undef LN1_FLUSH
        }
        if (IN(PH_LN1)) SEAM();
        if (IN(PH_DISPATCH)) { PHASE_IDS;
            unsigned char* ws = opaque_ptr(a.ws);
            LAS int* ltab = (LAS int*)(lds + LTAB_OFF);
            const unsigned* cnt = (const unsigned*)(ws + WS_CTL) + CW_CNT + 1024 * l;
            if (wave == 0) {
                const int c = (lane < 32) ? (int)__hip_atomic_load(cnt + (lane & 31) * CNT_STRIDE, __ATOMIC_RELAXED, __HIP_MEMORY_SCOPE_AGENT) : 0;
                const int nb = (c + 255) >> 8; int inc = nb;
#pragma unroll
                for (int o = 1; o < 64; o <<= 1) { const int u = shfl_i(inc, lane - o); if (lane >= o) inc += u; }
                const int exc = inc - nb;
                if (lane < 32) ltab[lane] = exc * 256;
                if (bx == 0) { int* tab = (int*)(ws + WS_TAB); if (lane == 31) tab[0] = inc; if (lane < 32) for (int b = 0; b < nb; ++b) tab[1 + exc + b] = lane; }
            }
            __syncthreads();
            int* pos = (int*)(ws + WS_POS); int* rowtok = (int*)(ws + WS_ROWTOK);
            for (int tok = gw * 64 + lane; tok < NTOK; tok += NGW * 64) {
                const int p0 = pos[(size_t)tok * 2], p1 = pos[(size_t)tok * 2 + 1];
                const int r0 = ltab[(p0 >> 16) & 31] + (p0 & 0xffff), r1 = ltab[(p1 >> 16) & 31] + (p1 & 0xffff);
                rowtok[r0] = tok; rowtok[r1] = tok; pos[(size_t)tok * 2] = r0; pos[(size_t)tok * 2 + 1] = r1;
            }
        }
        if (IN(PH_DISPATCH)) SEAM();
        if (IN(PH_GU) || IN(PH_DOWN)) { PHASE_IDS;
            unsigned char* ws = opaque_ptr(a.ws);
            LAS int* ltab = (LAS int*)(lds + LTAB_OFF);
            const int* tab = (const int*)(ws + WS_TAB);
            for (int i = tid; i < 1 + MPAD / 256; i += NWAVES * 64) ltab[i] = tab[i];
            __syncthreads();
            if (IN(PH_GU)) { PHASE_IDS;
                LAS int* ltok = (LAS int*)(lds + LTOK_OFF);
                pg8::GroupGatherOrder S; S.tab = ltab; S.ltok = ltok; S.A = (const char*)(ws + WS_XB); S.Bt = (const char*)(ws + WS_WEXP + WEXP_GU); S.tstepA = (size_t)256 * 1024 * 2; S.tstepB = (size_t)256 * 1024 * 2; S.estride = (size_t)1024 * 1024 * 2; S.nN = 4; S.G = G; S.c = bx;
                { const int* rowtok = (const int*)(ws + WS_ROWTOK);
                  const int nbk = __builtin_amdgcn_readfirstlane(ltab[0]);
#pragma unroll 1
                  for (int i = 0; i < LTOK_UNITS; ++i) { const int rb = ((G & 31) == 0) ? i * (G >> 2) + (bx & 7) * (G >> 5) + (bx >> 5) : (i * G + bx) >> 2;
                      if (rb >= nbk) break; if (tid < 256) ltok[256 * i + tid] = rowtok[256 * rb + tid]; }
                  __syncthreads(); }
                pg8::EpiSwiGLU E{(bf16*)(ws + WS_H)};
                pg8::gemm_phase<pg8::EpiSwiGLU, pg8::GroupGatherOrder, true, true>(lds + RING_OFF, D, S, E, wave0);
            }
        }
        if (IN(PH_GU)) SEAM();
        if (IN(PH_DOWN)) { PHASE_IDS;
            unsigned char* ws = opaque_ptr(a.ws);
            LAS int* ltab = (LAS int*)(lds + LTAB_OFF);
            pg8::GroupOrder S; S.tab = ltab; S.A = (const char*)(ws + WS_H); S.Bt = (const char*)(ws + WS_WEXP + WEXP_D); S.tstepA = (size_t)256 * 512 * 2; S.tstepB = (size_t)256 * 512 * 2; S.estride = (size_t)1024 * 512 * 2; S.nN = 4; S.G = G; S.c = bx;
            pg8::EpiBf16<1024> E{(bf16*)(ws + WS_YS)};
            pg8::gemm_phase<pg8::EpiBf16<1024>, pg8::GroupOrder, true, true>(lds + RING_OFF, DEXP, S, E, wave0);
        }
        if (IN(PH_DOWN)) SEAM();
        if (IN(PH_LN2)) { PHASE_IDS;
            unsigned char* ws = opaque_ptr(a.ws);
            const bf16* X1b = (const bf16*)(ws + WS_XB); const bf16* YS = (const bf16*)(ws + WS_YS); bf16* XBXp = (bf16*)a.out; const bool lastl = (l == DEPTH - 1);
            const float* gatew = (const float*)(ws + WS_GATEW); const int* pos = (const int*)(ws + WS_POS);
            const float* lg = a.in[opaque_int(I_L2G)] + (size_t)l * D; const float* lb = a.in[opaque_int(I_L2B)] + (size_t)l * D;
            for (int tokp = gw; tokp < NTOK; tokp += 4 * NGW) {
                f32x4 v[4][4]; float sm[4];
#pragma unroll
                for (int u = 0; u < 4; ++u) {
                    const int tok = (tokp + u * NGW < NTOK) ? tokp + u * NGW : tokp;
                    const float g0 = gatew[(size_t)tok * 2], g1 = gatew[(size_t)tok * 2 + 1];
                    const int r0 = pos[(size_t)tok * 2], r1 = pos[(size_t)tok * 2 + 1];
                    sm[u] = 0.f;
#pragma unroll
                    for (int j = 0; j < 4; ++j) {
                        const int c = 4 * lane + 256 * j;
                        const unsigned long long xw = *(const unsigned long long*)(X1b + (size_t)tok * D + c);
                        const f32x4 xv = (f32x4){__uint_as_float((unsigned)xw << 16), __uint_as_float((unsigned)xw & 0xffff0000u), __uint_as_float((unsigned)(xw >> 32) << 16), __uint_as_float((unsigned)(xw >> 32) & 0xffff0000u)};
                        const unsigned long long ya = *(const unsigned long long*)(YS + (size_t)r0 * D + c), yb = *(const unsigned long long*)(YS + (size_t)r1 * D + c);
                        const f32x4 y0 = (f32x4){__uint_as_float((unsigned)ya << 16), __uint_as_float((unsigned)ya & 0xffff0000u), __uint_as_float((unsigned)(ya >> 32) << 16), __uint_as_float((unsigned)(ya >> 32) & 0xffff0000u)};
                        const f32x4 y1 = (f32x4){__uint_as_float((unsigned)yb << 16), __uint_as_float((unsigned)yb & 0xffff0000u), __uint_as_float((unsigned)(yb >> 32) << 16), __uint_as_float((unsigned)(yb >> 32) & 0xffff0000u)};
                        v[u][j] = xv * ALPHA + (y0 * g0 + y1 * g1);
                        sm[u] += (v[u][j].x + v[u][j].y) + (v[u][j].z + v[u][j].w);
                    }
                }
                float mean[4], s2[4], rstd[4];
#pragma unroll
                for (int u = 0; u < 4; ++u) mean[u] = wsum(sm[u], lane) * (1.f / D);
#pragma unroll
                for (int u = 0; u < 4; ++u) { s2[u] = 0.f;
#pragma unroll
                    for (int j = 0; j < 4; ++j) { v[u][j] = v[u][j] - mean[u]; s2[u] += (v[u][j].x * v[u][j].x + v[u][j].y * v[u][j].y) + (v[u][j].z * v[u][j].z + v[u][j].w * v[u][j].w); } }
#pragma unroll
                for (int u = 0; u < 4; ++u) rstd[u] = rsqrtf(wsum(s2[u], lane) * (1.f / D) + LN_EPS);
#pragma unroll
                for (int u = 0; u < 4; ++u) {
                    const int tok = tokp + u * NGW; if (tok >= NTOK) break;
#pragma unroll
                    for (int j = 0; j < 4; ++j) {
                        const int c = 4 * lane + 256 * j;
                        const f32x4 g = *(const f32x4*)(lg + c), b = *(const f32x4*)(lb + c);
                        const f32x4 o = v[u][j] * rstd[u] * g + b;
                        if (lastl) *(f32x4*)(a.out + (size_t)tok * D + c) = o;
                        else *(unsigned long long*)(XBXp + (size_t)tok * D + c) = (unsigned long long)pk2(o.x, o.y) | ((unsigned long long)pk2(o.z, o.w) << 32);
                    }
                }
            }
        }
        if (IN(PH_LN2)) SEAM();
    }
#undef IN
}

#ifndef MK_ONE_LAUNCH
#define MK_ONE_LAUNCH 1
#endif
static void launch_mk(const Args& base, int grid, hipStream_t stream, int prologue, int l_lo, int l_hi, int ph_lo, int ph_hi) {
    Args a = base; a.prologue = prologue; a.l_lo = l_lo; a.l_hi = l_hi; a.ph_lo = ph_lo; a.ph_hi = ph_hi; a.pad = 0;
    hipLaunchKernelGGL(mk_fwd, dim3(grid), dim3(NWAVES * 64), LDS_BYTES, stream, a);
}
extern "C" void kernel_launch(void* const* d_in, const int* in_sizes, int n_in, void* d_out, int out_size, void* d_ws, size_t ws_size, hipStream_t stream) {
    static int grid = 0;
    if (grid == 0) {
        if (n_in != N_IN || ws_size < WS_END || out_size != NTOK * D) { fprintf(stderr, "kernel_launch: unexpected n_in %d, out_size %d or ws_size %zu\n", n_in, out_size, ws_size); grid = -1; return; }
        int dev = 0, cus = 0;
        if (hipGetDevice(&dev) != hipSuccess || hipDeviceGetAttribute(&cus, hipDeviceAttributeMultiprocessorCount, dev) != hipSuccess) { grid = -1; return; }
        if (hipFuncSetAttribute((const void*)mk_fwd, hipFuncAttributeMaxDynamicSharedMemorySize, LDS_BYTES) != hipSuccess) { fprintf(stderr, "kernel_launch: hipFuncSetAttribute failed\n"); grid = -1; return; }
        int per_cu = 0;
        if (hipOccupancyMaxActiveBlocksPerMultiprocessor(&per_cu, (const void*)mk_fwd, NWAVES * 64, LDS_BYTES) != hipSuccess || per_cu < 1) fprintf(stderr, "kernel_launch: occupancy query reports %d blocks per CU\n", per_cu);
        (void)hipGetLastError();
        grid = cus;
    }
    if (grid < 0) return;
    (void)hipMemsetAsync((char*)d_ws + WS_CTL, 0, CTL_ZERO_BYTES, stream);
    Args base{};
    for (int i = 0; i < N_IN; ++i) base.in[i] = (const float*)d_in[i];
    base.out = (float*)d_out; base.ws = (unsigned char*)d_ws;
#if MK_ONE_LAUNCH
    launch_mk(base, grid, stream, 1, 0, DEPTH, 0, PH_COUNT);
#else
    launch_mk(base, grid, stream, 1, 0, 0, 0, 0);
    for (int l = 0; l < DEPTH; ++l)
        for (int ph = 1; ph < PH_COUNT; ++ph) launch_mk(base, grid, stream, 0, l, l + 1, ph, ph + 1);
#endif
}
```
